# Optimizing an MI355X kernel written in HIP

```python
import jax, jax.numpy as jnp
from jax import lax
import numpy as np

D_MODEL = 2048
BATCH = 2
SEQ = 8192
DEPTH = 4

CTX_LEN = 256
GRID_W = 64
N_MIXERS = 3
EPS = 1e-6
N_HEADS = 16
N_KV_HEADS = 4
HEAD_DIM = D_MODEL // N_HEADS
KV_GROUP = N_HEADS // N_KV_HEADS
HQ = N_HEADS * HEAD_DIM
HKV = N_KV_HEADS * HEAD_DIM
WINDOW = 128
BLOCK = 128
ROPE_BASE = 10000.0
N_FOURIER_GROUPS = 8
FOURIER_GROUP_DIM = D_MODEL // N_FOURIER_GROUPS
SGU_CHUNK = 128
SGU_HALF = 3 * D_MODEL
N_SGU_GROUPS = 8
SGU_GROUP_DIM = SGU_HALF // N_SGU_GROUPS
D_FF = -(-8 * D_MODEL // (3 * 256)) * 256
N_ATTN_LAYERS = (DEPTH + N_MIXERS - 1) // N_MIXERS
N_FOURIER_LAYERS = (DEPTH + N_MIXERS - 2) // N_MIXERS
N_SGU_LAYERS = (DEPTH + N_MIXERS - 3) // N_MIXERS

kernel_name = 'hybrid_interleaved_swa_fourier_gmlp_dit'


def rms_norm(x, g):
    xf = x.astype(jnp.float32)
    y = xf * lax.rsqrt(jnp.mean(xf * xf, axis=-1, keepdims=True) + EPS)
    return (y * g.astype(jnp.float32)).astype(x.dtype)


def ada_params(cond, w, b):
    m = jax.nn.silu(cond) @ w + b
    return m.reshape(cond.shape[0], 6, 1, D_MODEL)


def modulated_norm(t, g, shift, scale):
    return rms_norm(t, g) * (1 + scale) + shift


def swiglu(h, w_gate, w_up, w_down):
    return (jax.nn.silu(h @ w_gate) * (h @ w_up)) @ w_down


def axial_rope_tables(n_rows, dtype):
    row, col = jnp.meshgrid(jnp.arange(n_rows), jnp.arange(GRID_W), indexing='ij')
    n_freq = HEAD_DIM // 4
    inv_freq = ROPE_BASE ** (-jnp.arange(n_freq, dtype=jnp.float32) / n_freq)
    ang = jnp.concatenate([row.reshape(-1, 1).astype(jnp.float32) * inv_freq,
                           col.reshape(-1, 1).astype(jnp.float32) * inv_freq], axis=-1)
    ang = jnp.concatenate([ang, ang], axis=-1)
    return jnp.cos(ang).astype(dtype), jnp.sin(ang).astype(dtype)


def apply_rope(t, cos, sin):
    t1, t2 = jnp.split(t, 2, axis=-1)
    rot = jnp.concatenate([-t2, t1], axis=-1)
    return t * cos[None, :, None, :] + rot * sin[None, :, None, :]


def windowed_gqa_mixer(hx, hc, w_qkv, w_o, q_g, k_g, sink, cos, sin, need_ctx):
    B, n, _ = hx.shape
    L = hc.shape[1]
    nb = n // BLOCK
    scale = HEAD_DIM ** -0.5
    neg = jnp.finfo(jnp.float32).min
    qkv = hx @ w_qkv
    q = rms_norm(qkv[..., :HQ].reshape(B, n, N_HEADS, HEAD_DIM), q_g)
    k = rms_norm(qkv[..., HQ:HQ + HKV].reshape(B, n, N_KV_HEADS, HEAD_DIM), k_g)
    v = qkv[..., HQ + HKV:].reshape(B, n, N_KV_HEADS, HEAD_DIM)
    q = apply_rope(q, cos, sin)
    k = apply_rope(k, cos, sin)
    kv_c = hc @ w_qkv[:, HQ:]
    kc = rms_norm(kv_c[..., :HKV].reshape(B, L, N_KV_HEADS, HEAD_DIM), k_g)
    vc = kv_c[..., HKV:].reshape(B, L, N_KV_HEADS, HEAD_DIM)
    sink_f = sink.astype(jnp.float32).reshape(N_KV_HEADS, KV_GROUP)

    qb = q.reshape(B, nb, BLOCK, N_KV_HEADS, KV_GROUP, HEAD_DIM)

    def band(t):
        tp = jnp.pad(t, ((0, 0), (BLOCK, BLOCK), (0, 0), (0, 0)))
        tp = tp.reshape(B, nb + 2, BLOCK, N_KV_HEADS, HEAD_DIM)
        return jnp.concatenate([tp[:, :-2], tp[:, 1:-1], tp[:, 2:]], axis=2)

    kw, vw = band(k), band(v)
    s_loc = jnp.einsum('bnqhgd,bnkhd->bhgnqk', qb, kw).astype(jnp.float32) * scale
    s_ctx = jnp.einsum('bnqhgd,bchd->bhgnqc', qb, kc).astype(jnp.float32) * scale
    blk = jnp.arange(nb)[:, None, None] * BLOCK
    qpos = blk + jnp.arange(BLOCK)[None, :, None]
    kpos = blk - BLOCK + jnp.arange(3 * BLOCK)[None, None, :]
    valid = (jnp.abs(kpos - qpos) <= WINDOW) & (kpos >= 0) & (kpos < n)
    s_loc = jnp.where(valid, s_loc, neg)
    sink_col = jnp.broadcast_to(sink_f[None, :, :, None, None, None], s_ctx.shape[:-1] + (1,))
    p = jax.nn.softmax(jnp.concatenate([sink_col, s_ctx, s_loc], axis=-1), axis=-1).astype(v.dtype)
    ox = (jnp.einsum('bhgnqc,bchd->bnqhgd', p[..., 1:1 + L], vc)
          + jnp.einsum('bhgnqk,bnkhd->bnqhgd', p[..., 1 + L:], vw))
    ox = ox.reshape(B, n, HQ) @ w_o
    if not need_ctx:
        return ox, None
    qc = rms_norm((hc @ w_qkv[:, :HQ]).reshape(B, L, N_KV_HEADS, KV_GROUP, HEAD_DIM), q_g)
    s_c = jnp.einsum('blhgd,bmhd->bhglm', qc, kc).astype(jnp.float32) * scale
    sink_c = jnp.broadcast_to(sink_f[None, :, :, None, None], s_c.shape[:-1] + (1,))
    pc = jax.nn.softmax(jnp.concatenate([sink_c, s_c], axis=-1), axis=-1).astype(vc.dtype)
    oc = jnp.einsum('bhglm,bmhd->blhgd', pc[..., 1:], vc).reshape(B, L, HQ) @ w_o
    return ox, oc


def fourier_mixer(h, w_f):
    B, n, _ = h.shape
    hg = h.astype(jnp.float32).reshape(B, n, N_FOURIER_GROUPS, FOURIER_GROUP_DIM)
    y = jnp.fft.fft2(hg, axes=(1, 3), norm='ortho').real.astype(h.dtype)
    return y.reshape(B, n, D_MODEL) @ w_f


def sgu_mixer(h, w_in, g_v, w_s, b_s, w_out):
    B, n, _ = h.shape
    z = jax.nn.gelu(h @ w_in, approximate=False)
    u, v = jnp.split(z, 2, axis=-1)
    v = rms_norm(v, g_v)
    vc = v.reshape(B, n // SGU_CHUNK, SGU_CHUNK, N_SGU_GROUPS, SGU_GROUP_DIM)
    s = jnp.einsum('gpq,bcqgd->bcpgd', w_s, vc) + b_s.T[:, :, None]
    return (u * s.reshape(B, n, SGU_HALF)) @ w_out


def setup_inputs(seed: int = 0) -> dict:
    key = jax.random.key(seed)
    ks = jax.random.split(key, 21)
    D = D_MODEL

    def nrm(k, shape, s):
        return jax.random.normal(k, shape, jnp.float32) * s

    return {
        'x': nrm(ks[0], (BATCH, SEQ, D), 1.0),
        'c': nrm(ks[1], (BATCH, D), 1.0),
        'ctx': nrm(ks[2], (BATCH, CTX_LEN, D), 1.0),
        'c_ctx': nrm(ks[3], (D,), 1.0),
        'w_ada': nrm(ks[4], (DEPTH, D, 6 * D), 0.5 * D ** -0.5),
        'b_ada': nrm(ks[5], (DEPTH, 6 * D), 0.01),
        'norm_g': 1.0 + nrm(ks[6], (DEPTH, 2, D), 0.02),
        'w_ffn_gate': nrm(ks[7], (DEPTH, D, D_FF), D ** -0.5),
        'w_ffn_up': nrm(ks[8], (DEPTH, D, D_FF), D ** -0.5),
        'w_ffn_down': nrm(ks[9], (DEPTH, D_FF, D), D_FF ** -0.5),
        'w_attn_qkv': nrm(ks[10], (N_ATTN_LAYERS, D, HQ + 2 * HKV), D ** -0.5),
        'w_attn_o': nrm(ks[11], (N_ATTN_LAYERS, HQ, D), HQ ** -0.5),
        'attn_q_g': 1.0 + nrm(ks[12], (N_ATTN_LAYERS, HEAD_DIM), 0.02),
        'attn_k_g': 1.0 + nrm(ks[13], (N_ATTN_LAYERS, HEAD_DIM), 0.02),
        'attn_sink': nrm(ks[14], (N_ATTN_LAYERS, N_HEADS), 0.5),
        'w_fourier': nrm(ks[15], (N_FOURIER_LAYERS, D, D), D ** -0.5),
        'w_sgu_in': nrm(ks[16], (N_SGU_LAYERS, D, 2 * SGU_HALF), D ** -0.5),
        'sgu_v_g': 1.0 + nrm(ks[17], (N_SGU_LAYERS, SGU_HALF), 0.02),
        'w_sgu_spatial': nrm(ks[18], (N_SGU_LAYERS, N_SGU_GROUPS, SGU_CHUNK, SGU_CHUNK), SGU_CHUNK ** -0.5),
        'b_sgu_spatial': 1.0 + nrm(ks[19], (N_SGU_LAYERS, N_SGU_GROUPS, SGU_CHUNK), 0.02),
        'w_sgu_out': nrm(ks[20], (N_SGU_LAYERS, SGU_HALF, D), SGU_HALF ** -0.5),
    }


def reference(x, c, ctx, c_ctx, w_ada, b_ada, norm_g, w_ffn_gate, w_ffn_up, w_ffn_down,
              w_attn_qkv, w_attn_o, attn_q_g, attn_k_g, attn_sink, w_fourier,
              w_sgu_in, sgu_v_g, w_sgu_spatial, b_sgu_spatial, w_sgu_out):
    n = x.shape[1]
    n_rows = n // GRID_W
    cos, sin = axial_rope_tables(n_rows, x.dtype)
    for i in range(DEPTH):
        kind = i % N_MIXERS
        j = i // N_MIXERS
        need_ctx = i < DEPTH - 1
        ctx_in = need_ctx or kind == 0
        mx = ada_params(c, w_ada[i], b_ada[i])
        hx = modulated_norm(x, norm_g[i, 0], mx[:, 0], mx[:, 1])
        if ctx_in:
            mc = ada_params(c_ctx[None], w_ada[i], b_ada[i])
            hc = modulated_norm(ctx, norm_g[i, 0], mc[:, 0], mc[:, 1])
        if kind == 0:
            ox, oc = windowed_gqa_mixer(hx, hc, w_attn_qkv[j], w_attn_o[j], attn_q_g[j],
                                        attn_k_g[j], attn_sink[j], cos, sin, need_ctx)
        elif kind == 1:
            ox = fourier_mixer(hx, w_fourier[j])
            oc = fourier_mixer(hc, w_fourier[j]) if need_ctx else None
        else:
            ox = sgu_mixer(hx, w_sgu_in[j], sgu_v_g[j], w_sgu_spatial[j], b_sgu_spatial[j], w_sgu_out[j])
            oc = (sgu_mixer(hc, w_sgu_in[j], sgu_v_g[j], w_sgu_spatial[j], b_sgu_spatial[j], w_sgu_out[j])
                  if need_ctx else None)
        x = x + mx[:, 2] * ox
        hx2 = modulated_norm(x, norm_g[i, 1], mx[:, 3], mx[:, 4])
        x = x + mx[:, 5] * swiglu(hx2, w_ffn_gate[i], w_ffn_up[i], w_ffn_down[i])
        if need_ctx:
            ctx = ctx + mc[:, 2] * oc
            hc2 = modulated_norm(ctx, norm_g[i, 1], mc[:, 3], mc[:, 4])
            ctx = ctx + mc[:, 5] * swiglu(hc2, w_ffn_gate[i], w_ffn_up[i], w_ffn_down[i])
    return x
```

```cpp
#include <hip/hip_runtime.h>
#include <cstdio>
#include <cstdint>

#ifndef MK_PER_PHASE
#define MK_PER_PHASE 1
#endif

constexpr int D = 2048, NBATCH = 2, SEQ = 8192, CTXL = 256, DEPTH = 4;
constexpr int ML = NBATCH * SEQ, MC = NBATCH * CTXL, MT = ML + MC;
constexpr int NH = 16, NKV = 4, HD = 128, HQ = 2048, HKV = 512, NQKV = HQ + 2 * HKV;
constexpr int DFF = 5632, SGH = 6144, SGG = 768, NADA = 6 * D;
constexpr float EPS = 1e-6f;

constexpr size_t MiB = 1u << 20;
constexpr size_t WS_CTL = 0, CTL_ZERO_BYTES = 2 * MiB;
constexpr size_t WS_MX = 2 * MiB;
constexpr size_t WS_ROPE = 3 * MiB;
constexpr size_t WS_DC2 = 7 * MiB;
constexpr size_t WS_FC = WS_DC2 + 512 * 1024;
constexpr size_t WS_WGU = 8 * MiB;
constexpr size_t WS_WDN = WS_WGU + 4 * 44 * MiB;
constexpr size_t WS_WQKV = WS_WDN + 4 * 22 * MiB;
constexpr size_t WS_WO = WS_WQKV + 2 * 12 * MiB;
constexpr size_t WS_WF = WS_WO + 2 * 8 * MiB;
constexpr size_t WS_WSI = WS_WF + 8 * MiB;
constexpr size_t WS_WSO = WS_WSI + 48 * MiB;
constexpr size_t WS_XR = WS_WSO + 24 * MiB;
constexpr size_t WS_H = WS_XR + 132 * MiB;
constexpr size_t WS_AR = WS_H + 66 * MiB;
constexpr size_t AR_QKV = 0, AR_AO = 99 * MiB;
constexpr size_t AR_G = 0;
constexpr size_t AR_Z = 0;
constexpr size_t AR_XT = 0, AR_XTC = 128 * MiB, AR_F = 182 * MiB, AR_Y = 438 * MiB;
constexpr size_t WS_END = WS_AR + 504 * MiB;
constexpr int CW_TMO = 0;
constexpr int CW_BAR = 4096;
constexpr int CW_SSQ = 16384;
static_assert((CW_SSQ + MT) * 4 <= (int)CTL_ZERO_BYTES, "ctl");

#define GAS __attribute__((address_space(1)))
#define LAS __attribute__((address_space(3)))
typedef unsigned short bf16;
typedef unsigned short bf16_t;
typedef short bf16x8 __attribute__((ext_vector_type(8)));
typedef short s16x4 __attribute__((ext_vector_type(4)));
typedef float f32x4 __attribute__((ext_vector_type(4)));
typedef float f32x2 __attribute__((ext_vector_type(2)));
typedef float f32x16 __attribute__((ext_vector_type(16)));
typedef unsigned u32x4 __attribute__((ext_vector_type(4)));
typedef unsigned u32x2 __attribute__((ext_vector_type(2)));

__device__ __forceinline__ unsigned cvt_pk_bf16(float lo, float hi) { unsigned r; asm volatile("v_cvt_pk_bf16_f32 %0, %1, %2" : "=v"(r) : "v"(lo), "v"(hi)); return r; }
__device__ __forceinline__ float bf2f(unsigned short b) { return __uint_as_float(((unsigned)b) << 16); }

namespace pg8 {
#define PG8_LAS __attribute__((address_space(3)))
constexpr int BM = 256, BK = 64, HALF = 128, HTB = HALF * BK * 2, STAGE_BYTES = 8 * HTB, NXCD = 8, WGM = 8;
__host__ __device__ __forceinline__ int lds_byte(int r, int c) { const int st = (r >> 4) * 2 + (c >> 5), rr = r & 15, cc = c & 31, ob = rr * 64 + cc * 2; return st * 1024 + (ob ^ (((ob >> 9) & 1) << 5)); }
__host__ __device__ __forceinline__ void stage_rc(int b, int& R, int& C) { const int st = b / 1024, sb = b % 1024, swz = sb ^ (((sb >> 9) & 1) << 5); R = (st >> 1) * 16 + swz / 64; C = (st & 1) * 32 + (swz % 64) / 2; }
__host__ __device__ __forceinline__ int perm32(int rho) { const int n = rho >> 4, i = rho & 15; return 8 * (i >> 2) + 4 * n + (i & 3); }

struct Unit { const char* a; const char* b; long o; int pm, pn; };
struct Gemm { int lda, ldb, K; };

__device__ __forceinline__ void tile_of(int L, int nM, int nN, int& pm, int& pn) {
    const int nwg = nM * nN; int wgid = L;
    { const int q = nwg / NXCD, r = nwg % NXCD, xcd = wgid % NXCD, off = wgid / NXCD; wgid = (xcd < r ? xcd * (q + 1) : r * (q + 1) + (xcd - r) * q) + off; }
    const int nig = WGM * nN, gid = wgid / nig, fm = gid * WGM, gsz = (nM - fm) < WGM ? (nM - fm) : WGM;
    pm = fm + ((wgid % nig) % gsz); pn = (wgid % nig) / gsz;
}

__device__ __forceinline__ f32x2 gelu_pk(f32x2 v) {
    const f32x2 av = __builtin_elementwise_abs(v), d = av * 0.2316418882f + 1.0f;
    f32x2 t; t.x = __builtin_amdgcn_rcpf(d.x); t.y = __builtin_amdgcn_rcpf(d.y);
    f32x2 q = t * 0.5307027145f + (-0.7265760135f); q = q * t + 0.7107068705f; q = q * t + (-0.142248368f); q = q * t + 0.127414796f; q = q * t;
    const f32x2 s = (v * v) * (-0.72134752044f);
    f32x2 e; e.x = __builtin_amdgcn_exp2f(s.x); e.y = __builtin_amdgcn_exp2f(s.y);
    const f32x2 m = v * (q * e), r = v - m;
    f32x2 o; o.x = v.x < 0.f ? m.x : r.x; o.y = v.y < 0.f ? m.y : r.y; return o;
}

template <class Epi, class Sched, bool ALIGN_EPI = true, bool SP2 = true>
__device__ __forceinline__ void gemm_phase(PG8_LAS unsigned char* lds, const Gemm g, const Sched& S, const Epi& E) {
    int tid = threadIdx.x; asm volatile("" : "+v"(tid));
    const int wid = __builtin_amdgcn_readfirstlane(tid >> 6), lane = tid & 63, wr = wid >> 2, wc = wid & 3, fr = lane & 15, fq = lane >> 4;
    const int K = g.K, nt = K / BK;
    unsigned voffA[2], voffB[2];
#pragma unroll
    for (int i = 0; i < 2; ++i) { int R, C; stage_rc(tid * 16 + i * 8192, R, C); const int Rb = Epi::PERM ? ((R & ~31) + perm32(R & 31)) : R;
        voffA[i] = (unsigned)(R * g.lda + C) * 2u; voffB[i] = (unsigned)(Rb * g.ldb + C) * 2u; }
    const size_t kstep = (size_t)(BK * 2);
    const size_t hstepA = (size_t)HALF * g.lda * 2, hstepB = (size_t)HALF * g.ldb * 2;
    const unsigned ldsw = (unsigned)wid * 1024u;
    const int aoff = lds_byte(wr * 64 + fr, fq * 8), boff = lds_byte(wc * 32 + fr, fq * 8);
#define PG8_SA(b, h) (((b) * 2 + (h)) * HTB)
#define PG8_SB(b, h) ((4 + (b) * 2 + (h)) * HTB)
#define PG8_STAGE(bufoff, gbase, voff) do { _Pragma("unroll") for (int _i = 0; _i < 2; ++_i) \
        __builtin_amdgcn_global_load_lds((const unsigned*)((const char*)(gbase) + (voff)[_i]), (PG8_LAS unsigned*)(lds + (bufoff) + ldsw + _i * 8192), 16, 0, 0); } while (0)
#define PG8_LDA(dst, b, h) do { _Pragma("unroll") for (int m = 0; m < 4; ++m) _Pragma("unroll") for (int k = 0; k < 2; ++k) dst[m][k] = *(const PG8_LAS bf16x8*)(lds + PG8_SA(b, h) + aoff + m * 2048 + k * 1024); } while (0)
#define PG8_LDB(dst, b, h) do { _Pragma("unroll") for (int n = 0; n < 2; ++n) _Pragma("unroll") for (int k = 0; k < 2; ++k) dst[n][k] = *(const PG8_LAS bf16x8*)(lds + PG8_SB(b, h) + boff + n * 2048 + k * 1024); } while (0)
#define PG8_MMA(ai, bj, At, Bt) do { __builtin_amdgcn_s_setprio(1); _Pragma("unroll") for (int m = 0; m < 4; ++m) _Pragma("unroll") for (int n = 0; n < 2; ++n) _Pragma("unroll") for (int k = 0; k < 2; ++k) \
        acc[ai][bj][m][n] = __builtin_amdgcn_mfma_f32_16x16x32_bf16(Bt[n][k], At[m][k], acc[ai][bj][m][n], 0, 0, 0); __builtin_amdgcn_s_setprio(0); } while (0)
#define PG8_WAIT_V(n) asm volatile("s_waitcnt vmcnt(" #n ")" ::: "memory")
#define PG8_WAIT_L(n) asm volatile("s_waitcnt lgkmcnt(" #n ")" ::: "memory")
#define PG8_BAR __builtin_amdgcn_s_barrier()
#define PG8_SCHED __builtin_amdgcn_sched_barrier(0)
    Unit cur, nxt; int ui = 0;
    if (!S.next(0, cur)) return;
    f32x4 acc[2][2][4][2];
#pragma unroll
    for (int a = 0; a < 2; ++a)
#pragma unroll
        for (int b = 0; b < 2; ++b)
#pragma unroll
            for (int m = 0; m < 4; ++m)
#pragma unroll
                for (int n = 0; n < 2; ++n) acc[a][b][m][n] = (f32x4){0.f, 0.f, 0.f, 0.f};
    bf16x8 At[4][2], B0[2][2], B1[2][2];
    const char* cA = cur.a; const char* cB = cur.b;
    if constexpr (SP2) {
        PG8_STAGE(PG8_SB(0, 0), cB, voffB); PG8_STAGE(PG8_SB(0, 1), cB + hstepB, voffB); PG8_STAGE(PG8_SA(0, 0), cA, voffA); PG8_STAGE(PG8_SA(0, 1), cA + hstepA, voffA);
        if (wr == 1) PG8_BAR;
        PG8_WAIT_V(2); PG8_BAR;
        PG8_STAGE(PG8_SB(1, 0), cB + kstep, voffB); PG8_STAGE(PG8_SA(1, 0), cA + kstep, voffA); PG8_STAGE(PG8_SB(1, 1), cB + hstepB + kstep, voffB);
        PG8_WAIT_V(6); PG8_BAR;
    } else {
        PG8_STAGE(PG8_SB(0, 0), cB, voffB); PG8_STAGE(PG8_SA(0, 0), cA, voffA); PG8_STAGE(PG8_SB(0, 1), cB + hstepB, voffB); PG8_STAGE(PG8_SA(0, 1), cA + hstepA, voffA);
        if (wr == 1) PG8_BAR;
        PG8_WAIT_V(4); PG8_BAR;
        PG8_STAGE(PG8_SB(1, 0), cB + kstep, voffB); PG8_STAGE(PG8_SA(1, 0), cA + kstep, voffA); PG8_STAGE(PG8_SB(1, 1), cB + hstepB + kstep, voffB);
        PG8_WAIT_V(6); PG8_BAR;
    }
    for (;;) {
        const bool has_next = S.next(ui + 1, nxt);
        const char* nA = has_next ? nxt.a : cA; const char* nB = has_next ? nxt.b : cB;
        for (int t = 0; t < nt; t += 2) {
            const bool last = (t == nt - 2);
            const char* a1 = cA + (size_t)(t + 1) * kstep;
            const char* a2 = last ? nA : cA + (size_t)(t + 2) * kstep; const char* b2 = last ? nB : cB + (size_t)(t + 2) * kstep;
            const char* a3 = a2 + kstep; const char* b3 = b2 + kstep;
            if constexpr (SP2) {
            PG8_LDB(B0, 0, 0); PG8_LDB(B1, 0, 1); PG8_SCHED; PG8_LDA(At, 0, 0); PG8_STAGE(PG8_SA(1, 1), a1 + hstepA, voffA);
            PG8_WAIT_V(8); PG8_WAIT_L(0); PG8_BAR; PG8_MMA(0, 0, At, B0); PG8_MMA(0, 1, At, B1); PG8_BAR; PG8_SCHED;
            PG8_LDA(At, 0, 1); PG8_STAGE(PG8_SB(0, 0), b2, voffB); PG8_STAGE(PG8_SB(0, 1), b2 + hstepB, voffB); PG8_STAGE(PG8_SA(0, 0), a2, voffA);
            PG8_WAIT_V(8); PG8_WAIT_L(0); PG8_BAR; PG8_MMA(1, 0, At, B0); PG8_MMA(1, 1, At, B1); PG8_BAR; PG8_SCHED;
            PG8_LDB(B0, 1, 0); PG8_LDB(B1, 1, 1); PG8_SCHED; PG8_LDA(At, 1, 0); PG8_STAGE(PG8_SA(0, 1), a2 + hstepA, voffA);
            PG8_WAIT_V(8); PG8_WAIT_L(0); PG8_BAR; PG8_MMA(0, 0, At, B0); PG8_MMA(0, 1, At, B1); PG8_BAR; PG8_SCHED;
            PG8_LDA(At, 1, 1); PG8_STAGE(PG8_SB(1, 0), b3, voffB); PG8_STAGE(PG8_SB(1, 1), b3 + hstepB, voffB); PG8_STAGE(PG8_SA(1, 0), a3, voffA);
            PG8_WAIT_V(8); PG8_WAIT_L(0); PG8_BAR; PG8_MMA(1, 0, At, B0); PG8_MMA(1, 1, At, B1); PG8_BAR; PG8_SCHED;
            } else {
            PG8_LDB(B0, 0, 0); PG8_SCHED; PG8_LDA(At, 0, 0); PG8_STAGE(PG8_SA(1, 1), a1 + hstepA, voffA);
            PG8_WAIT_L(8); PG8_BAR; PG8_WAIT_L(0); PG8_MMA(0, 0, At, B0); PG8_BAR; PG8_SCHED;
            PG8_LDB(B1, 0, 1); PG8_STAGE(PG8_SB(0, 0), b2, voffB);
            PG8_BAR; PG8_WAIT_L(0); PG8_MMA(0, 1, At, B1); PG8_BAR;
            PG8_LDA(At, 0, 1); PG8_STAGE(PG8_SA(0, 0), a2, voffA);
            PG8_BAR; PG8_WAIT_L(0); PG8_MMA(1, 0, At, B0); PG8_BAR; PG8_SCHED;
            PG8_STAGE(PG8_SB(0, 1), b2 + hstepB, voffB);
            PG8_WAIT_V(6); PG8_BAR; PG8_MMA(1, 1, At, B1); PG8_BAR;
            PG8_LDB(B0, 1, 0); PG8_SCHED; PG8_LDA(At, 1, 0); PG8_STAGE(PG8_SA(0, 1), a2 + hstepA, voffA);
            PG8_WAIT_L(8); PG8_BAR; PG8_WAIT_L(0); PG8_MMA(0, 0, At, B0); PG8_BAR; PG8_SCHED;
            PG8_LDB(B1, 1, 1); PG8_STAGE(PG8_SB(1, 0), b3, voffB);
            PG8_BAR; PG8_WAIT_L(0); PG8_MMA(0, 1, At, B1); PG8_BAR;
            PG8_LDA(At, 1, 1); PG8_STAGE(PG8_SA(1, 0), a3, voffA);
            PG8_BAR; PG8_WAIT_L(0); PG8_MMA(1, 0, At, B0); PG8_BAR; PG8_SCHED;
            PG8_STAGE(PG8_SB(1, 1), b3 + hstepB, voffB);
            PG8_WAIT_V(6); PG8_BAR; PG8_MMA(1, 1, At, B1); PG8_BAR;
            }
        }
        if constexpr (ALIGN_EPI) { if (wr == 0) PG8_BAR; }
        E(acc, cur, wr, wc, fr, fq);
        if (!has_next) break;
#pragma unroll
        for (int a = 0; a < 2; ++a)
#pragma unroll
            for (int b = 0; b < 2; ++b)
#pragma unroll
                for (int m = 0; m < 4; ++m)
#pragma unroll
                    for (int n = 0; n < 2; ++n) acc[a][b][m][n] = (f32x4){0.f, 0.f, 0.f, 0.f};
        cur = nxt; cA = nA; cB = nB; ++ui;
        if constexpr (ALIGN_EPI) { if (wr == 1) PG8_BAR; }
    }
    PG8_WAIT_V(0);
    if constexpr (!ALIGN_EPI) { if (wr == 0) PG8_BAR; }
    PG8_BAR;
#undef PG8_SA
#undef PG8_SB
#undef PG8_STAGE
#undef PG8_LDA
#undef PG8_LDB
#undef PG8_MMA
#undef PG8_WAIT_V
#undef PG8_WAIT_L
#undef PG8_BAR
#undef PG8_SCHED
}
}
namespace pg8 {
__device__ __forceinline__ int bsel_of(int pm) { return pm < 32 ? 0 : (pm < 64 ? 1 : 2); }

template <int ACT, bool SSQ> struct EpiBf16 {
    static constexpr bool PERM = true;
    bf16_t* O; int ldc; float* ssq; int ssq_pn0;
    __device__ __forceinline__ void operator()(const f32x4 (&acc)[2][2][4][2], const Unit& u, int wr, int wc, int fr, int fq) const {
        bf16_t* base = O + u.o + (size_t)(wr * 64 + fr) * ldc + wc * 32 + 8 * fq;
        const bool do_ssq = SSQ && (u.pn >= ssq_pn0);
#pragma unroll
        for (int ai = 0; ai < 2; ++ai)
#pragma unroll
            for (int m = 0; m < 4; ++m) { bf16_t* rowp = base + (size_t)(ai * HALF + m * 16) * ldc; float s = 0.f;
#pragma unroll
                for (int bj = 0; bj < 2; ++bj) { f32x4 v0 = acc[ai][bj][m][0], v1 = acc[ai][bj][m][1];
                    if (ACT == 1) { f32x2 a = gelu_pk((f32x2){v0[0], v0[1]}), b = gelu_pk((f32x2){v0[2], v0[3]}), c = gelu_pk((f32x2){v1[0], v1[1]}), d = gelu_pk((f32x2){v1[2], v1[3]});
                        v0 = (f32x4){a.x, a.y, b.x, b.y}; v1 = (f32x4){c.x, c.y, d.x, d.y}; }
                    if (SSQ) s += (v0[0] * v0[0] + v0[1] * v0[1]) + (v0[2] * v0[2] + v0[3] * v0[3]) + (v1[0] * v1[0] + v1[1] * v1[1]) + (v1[2] * v1[2] + v1[3] * v1[3]);
                    u32x4 w; w.x = cvt_pk_bf16(v0[0], v0[1]); w.y = cvt_pk_bf16(v0[2], v0[3]); w.z = cvt_pk_bf16(v1[0], v1[1]); w.w = cvt_pk_bf16(v1[2], v1[3]);
                    *(u32x4*)(rowp + bj * HALF) = w; }
                if (SSQ) { if (do_ssq) { s += __shfl_xor(s, 16); s += __shfl_xor(s, 32);
                    if (fq == 0) atomicAdd(ssq + u.pm * BM + ai * HALF + wr * 64 + m * 16 + fr, s); } }
            }
    }
};

struct EpiRes {
    static constexpr bool PERM = false;
    const float* rin; float* rout; const float* gmx; const float* gb;
    __device__ __forceinline__ void operator()(const f32x4 (&acc)[2][2][4][2], const Unit& u, int wr, int wc, int fr, int fq) const {
        const int bs = bsel_of(u.pm); const int col0 = u.pn * BM + wc * 32 + 4 * fq;
        f32x4 gv[2][2];
#pragma unroll
        for (int bj = 0; bj < 2; ++bj)
#pragma unroll
            for (int n = 0; n < 2; ++n) gv[bj][n] = *(const f32x4*)(gmx + bs * NADA + col0 + bj * HALF + n * 16) + *(const f32x4*)(gb + col0 + bj * HALF + n * 16);
#pragma unroll
        for (int ai = 0; ai < 2; ++ai)
#pragma unroll
            for (int m = 0; m < 4; ++m) { const size_t off = (size_t)(u.pm * BM + ai * HALF + wr * 64 + m * 16 + fr) * D + col0;
#pragma unroll
                for (int bj = 0; bj < 2; ++bj)
#pragma unroll
                    for (int n = 0; n < 2; ++n) { const f32x4 x = *(const f32x4*)(rin + off + bj * HALF + n * 16); *(f32x4*)(rout + off + bj * HALF + n * 16) = x + gv[bj][n] * acc[ai][bj][m][n]; }
                if (m & 1) asm volatile("" ::: "memory"); }
    }
};

struct EpiSwiGLU {
    static constexpr bool PERM = true;
    bf16_t* G; int ldg;
    __device__ __forceinline__ void operator()(const f32x4 (&acc)[2][2][4][2], const Unit& u, int wr, int wc, int fr, int fq) const {
        bf16_t* base = G + u.o + (size_t)(wr * 64 + fr) * ldg + wc * 16 + 4 * fq;
#pragma unroll
        for (int ai = 0; ai < 2; ++ai)
#pragma unroll
            for (int m = 0; m < 4; ++m) { bf16_t* rowp = base + (size_t)(ai * HALF + m * 16) * ldg;
#pragma unroll
                for (int bj = 0; bj < 2; ++bj) { const f32x4 g = acc[ai][bj][m][0], up = acc[ai][bj][m][1]; f32x4 o;
#pragma unroll
                    for (int e = 0; e < 4; ++e) { const float sg = __builtin_amdgcn_rcpf(1.f + __builtin_amdgcn_exp2f(-1.4426950408889634f * g[e])); o[e] = g[e] * sg * up[e]; }
                    u32x2 w; w.x = cvt_pk_bf16(o[0], o[1]); w.y = cvt_pk_bf16(o[2], o[3]);
                    *(u32x2*)(rowp + bj * 64) = w; } }
    }
};

struct SchedRC {
    const char* A; const char* B; size_t atile, btile; long ldo; int ow, nM, nN, G, c;
    __device__ __forceinline__ bool next(int i, Unit& u) const {
        const long L = (long)i * G + c; if (L >= (long)nM * nN) return false;
        int pm, pn; tile_of((int)L, nM, nN, pm, pn);
        u.a = A + (size_t)pm * atile; u.b = B + (size_t)pn * btile; u.o = (long)pm * BM * ldo + (long)pn * ow; u.pm = pm; u.pn = pn; return true;
    }
};
__device__ __forceinline__ SchedRC make_rc(const bf16_t* A, int lda, const bf16_t* B, int ldb, int nM, int nN, long ldo, int ow, int G, int c) {
    SchedRC s; s.A = (const char*)A; s.B = (const char*)B; s.atile = (size_t)BM * lda * 2; s.btile = (size_t)BM * ldb * 2; s.ldo = ldo; s.ow = ow; s.nM = nM; s.nN = nN; s.G = G; s.c = c; return s;
}
}
typedef GAS unsigned gu32;
#define RLX_AGENT __ATOMIC_RELAXED, __HIP_MEMORY_SCOPE_AGENT
#define XB_TMO      128
#define XB_XCNT(j)  (256  + 64 * (j))
#define XB_XSUB(j)  (1280 + 64 * (j))
#define XB_XGEN(j)  (2304 + 64 * (j))
#define XB_TOP      3328
#define XB_TOPGEN   3392
#define XCD_BAR_WORDS 3456
#define XB_SPIN_CAP (1u << 18)
__device__ __forceinline__ unsigned xb_ld(unsigned* p)              { return __hip_atomic_load(p, __ATOMIC_RELAXED, __HIP_MEMORY_SCOPE_AGENT); }
__device__ __forceinline__ unsigned xb_add(unsigned* p, unsigned v) { return __hip_atomic_fetch_add(p, v, __ATOMIC_RELAXED, __HIP_MEMORY_SCOPE_AGENT); }
__device__ __forceinline__ unsigned xb_xcc_id() { return (unsigned)__builtin_amdgcn_s_getreg((3 << 11) | 20) & 0xFu; }
#define XB_SPIN(cond, bar) do { unsigned _sp = 0; while (cond) { __builtin_amdgcn_s_sleep(1); \
    if ((++_sp & 255u) == 0u) { if (xb_ld(&(bar)[XB_TMO])) break; if (_sp > XB_SPIN_CAP) { atomicAdd(&(bar)[XB_TMO], 1u); break; } } } } while (0)
struct XcdBarrier { unsigned* bar; unsigned x; volatile LAS unsigned* st; };
__device__ __forceinline__ XcdBarrier xcd_barrier_post(unsigned* bar, volatile LAS unsigned* st) {
    XcdBarrier b; b.bar = bar; b.x = xb_xcc_id(); b.st = st;
    if (threadIdx.x == 0) (void)xb_add(&bar[XB_XCNT(b.x)], 1u);
    return b;
}
__device__ __forceinline__ void xcd_barrier_complete(unsigned* bar, unsigned x, unsigned& nloc, unsigned& nx) {
    const unsigned G = gridDim.x * gridDim.y * gridDim.z;
    unsigned sum, cnt, mine, sp = 0u;
    for (;;) {
        sum = 0u; cnt = 0u; mine = 0u;
#pragma unroll
        for (unsigned j = 0; j < 16; ++j) { const unsigned c = xb_ld(&bar[XB_XCNT(j)]); sum += c; cnt += (c > 0u) ? 1u : 0u; mine = (j == x) ? c : mine; }
        if (sum == G) break;
        __builtin_amdgcn_s_sleep(1);
        if ((++sp & 255u) == 0u) { if (xb_ld(&bar[XB_TMO])) break; if (sp > XB_SPIN_CAP) { atomicAdd(&bar[XB_TMO], 1u); break; } }
    }
    nloc = mine > 0u ? mine : 1u; nx = cnt > 0u ? cnt : 1u;
}
__device__ __forceinline__ void xcd_barrier(const XcdBarrier& b) {
    asm volatile("s_waitcnt vmcnt(0)" ::: "memory");
    __syncthreads();
    if (threadIdx.x == 0) {
        unsigned* bar = b.bar;
        __builtin_amdgcn_s_waitcnt(0);
        unsigned nloc = b.st[0], nx = b.st[1];
        if (nloc == 0u) { xcd_barrier_complete(bar, b.x, nloc, nx); b.st[0] = nloc; b.st[1] = nx; }
        const unsigned old = xb_add(&bar[XB_XSUB(b.x)], 1u);
        const unsigned gen = old / nloc;
        if (old + 1u == (gen + 1u) * nloc) {
            __builtin_amdgcn_fence(__ATOMIC_RELEASE, "agent");
            asm volatile("s_waitcnt vmcnt(0)" ::: "memory");
            const unsigned og = xb_add(&bar[XB_TOP], 1u);
            const unsigned tg = og / nx;
            if (og + 1u == (tg + 1u) * nx) xb_add(&bar[XB_TOPGEN], 1u);
            else XB_SPIN(xb_ld(&bar[XB_TOPGEN]) == tg, bar);
            __builtin_amdgcn_fence(__ATOMIC_ACQUIRE, "agent");
            xb_add(&bar[XB_XGEN(b.x)], 1u);
            asm volatile("s_waitcnt vmcnt(0)" ::: "memory");
        } else {
            XB_SPIN(xb_ld(&bar[XB_XGEN(b.x)]) == gen, bar);
            __builtin_amdgcn_fence(__ATOMIC_ACQUIRE, "agent");
            asm volatile("s_waitcnt vmcnt(0)" ::: "memory");
        }
    }
    __syncthreads();
}
#define LDS_WAIT() asm volatile("s_waitcnt lgkmcnt(0)" ::: "memory")
#define VM_WAIT() asm volatile("s_waitcnt vmcnt(0)" ::: "memory")
__device__ __forceinline__ float wave_sum(float v) {
#pragma unroll
    for (int o = 1; o < 64; o <<= 1) v += __shfl_xor(v, o);
    return v;
}
__device__ __forceinline__ float silu_f(float x) { return x / (1.f + __expf(-x)); }

__device__ __forceinline__ void modnorm_phase(const float* xlat, const float* xctx, float* xr_out, bf16* H, const float* g, const float* mxl, const float* bl,
                                              int which, int nrows, int gw, int NGW, int lane) {
    asm volatile("" : "+v"(lane));
    int cur_bs = -1; f32x4 gs[8], sh[8];
    const int csh = (which * 3) * D, csc = (which * 3 + 1) * D;
    for (int row = gw; row < nrows; row += NGW) {
        const int bs = row < SEQ ? 0 : (row < ML ? 1 : 2);
        if (bs != cur_bs) {
#pragma unroll
            for (int j = 0; j < 8; ++j) { const int col = 4 * lane + 256 * j;
                const f32x4 gg = *(const f32x4*)(g + col);
                const f32x4 sc = *(const f32x4*)(mxl + bs * NADA + csc + col) + *(const f32x4*)(bl + csc + col);
                sh[j] = *(const f32x4*)(mxl + bs * NADA + csh + col) + *(const f32x4*)(bl + csh + col);
                gs[j] = gg * (sc + 1.0f); }
            cur_bs = bs;
        }
        const float* src = row < ML ? xlat + (size_t)row * D : xctx + (size_t)(row - ML) * D;
        f32x4 v[8]; float s = 0.f;
#pragma unroll
        for (int j = 0; j < 8; ++j) { v[j] = *(const f32x4*)(src + 4 * lane + 256 * j); s += (v[j].x * v[j].x + v[j].y * v[j].y) + (v[j].z * v[j].z + v[j].w * v[j].w); }
        const float r = 1.0f / sqrtf(wave_sum(s) * (1.0f / D) + EPS);
        bf16* hrow = H + (size_t)row * D;
#pragma unroll
        for (int j = 0; j < 8; ++j) { const f32x4 o = v[j] * r * gs[j] + sh[j]; u32x2 w; w.x = cvt_pk_bf16(o.x, o.y); w.y = cvt_pk_bf16(o.z, o.w);
            *(u32x2*)(hrow + 4 * lane + 256 * j) = w; }
        if (xr_out) {
#pragma unroll
            for (int j = 0; j < 8; ++j) *(f32x4*)(xr_out + (size_t)row * D + 4 * lane + 256 * j) = v[j];
        }
    }
}

__device__ __forceinline__ void qknorm_rope_phase(bf16* QKV, const float* qg, const float* kg, const f32x2* rope, int nrows, int gw, int NGW, int lane) {
    asm volatile("" : "+v"(lane));
    const int hl = lane >> 4, dl = (lane & 15) * 8;
    for (int row = gw; row < nrows; row += NGW) {
        bf16* rp = QKV + (size_t)row * NQKV;
        const bool lat = row < ML; const int t = row & (SEQ - 1);
#pragma unroll
        for (int it = 0; it < 5; ++it) {
            const int head = it * 4 + hl; bf16* p = rp + head * HD + dl;
            const u32x4 raw = *(const u32x4*)p; float v[8];
#pragma unroll
            for (int e = 0; e < 4; ++e) { v[2 * e] = __uint_as_float(raw[e] << 16); v[2 * e + 1] = __uint_as_float(raw[e] & 0xffff0000u); }
            float s = 0.f;
#pragma unroll
            for (int e = 0; e < 8; ++e) s += v[e] * v[e];
            s += __shfl_xor(s, 1); s += __shfl_xor(s, 2); s += __shfl_xor(s, 4); s += __shfl_xor(s, 8);
            const float r = 1.0f / sqrtf(s * (1.0f / HD) + EPS);
            const float* gp = (it < 4 ? qg : kg) + dl;
            const f32x4 g0 = *(const f32x4*)gp, g1 = *(const f32x4*)(gp + 4);
#pragma unroll
            for (int e = 0; e < 4; ++e) { v[e] *= r * g0[e]; v[4 + e] *= r * g1[e]; }
            float o[8];
            if (lat) {
                const f32x2* cs = rope + (size_t)t * 64 + (dl & 63);
#pragma unroll
                for (int e = 0; e < 8; ++e) { const float pr = __shfl_xor(v[e], 8); const f32x2 c = cs[e]; o[e] = v[e] * c.x + ((lane & 8) ? pr : -pr) * c.y; }
            } else {
#pragma unroll
                for (int e = 0; e < 8; ++e) o[e] = v[e];
            }
            u32x4 w; w.x = cvt_pk_bf16(o[0], o[1]); w.y = cvt_pk_bf16(o[2], o[3]); w.z = cvt_pk_bf16(o[4], o[5]); w.w = cvt_pk_bf16(o[6], o[7]);
            *(u32x4*)p = w;
        }
    }
}

__device__ __forceinline__ int dst_row_map(int n, int mode) { return mode == 0 ? n : ((n >> 2) * 8 + (n & 3) + (mode == 2 ? 4 : 0)); }
__device__ __forceinline__ void transpose_item(const float* W, int K, int N, bf16* WT, int mode, LAS float* scr, int item, int lane) {
    const int nblk = N / 32, kb = item / nblk, nb = item % nblk, k0 = 64 * kb, n0 = 32 * nb;
    const int lr = lane >> 3, lc = (lane & 7) * 4;
    f32x4 t[8];
#pragma unroll
    for (int i = 0; i < 8; ++i) t[i] = *(const f32x4*)(W + (size_t)(k0 + 8 * i + lr) * N + n0 + lc);
#pragma unroll
    for (int i = 0; i < 8; ++i) { LAS float* s = scr + (8 * i + lr) * 33 + lc; s[0] = t[i].x; s[1] = t[i].y; s[2] = t[i].z; s[3] = t[i].w; }
    LDS_WAIT(); asm volatile("" ::: "memory");
    const int c = lane & 7;
#pragma unroll
    for (int j = 0; j < 4; ++j) { const int n = (lane >> 3) + 8 * j; const LAS float* s = scr + (8 * c) * 33 + n;
        u32x4 o; o.x = cvt_pk_bf16(s[0 * 33], s[1 * 33]); o.y = cvt_pk_bf16(s[2 * 33], s[3 * 33]); o.z = cvt_pk_bf16(s[4 * 33], s[5 * 33]); o.w = cvt_pk_bf16(s[6 * 33], s[7 * 33]);
        *(u32x4*)(WT + (size_t)dst_row_map(n0 + n, mode) * K + k0 + 8 * c) = o; }
    LDS_WAIT(); asm volatile("" ::: "memory");
}
struct TrJob { const float* W; bf16* WT; int K, N, mode, nitems; };
struct KArgs { const float* in[21]; float* out; unsigned char* ws; int ph_lo, ph_hi; };
enum { I_X = 0, I_C, I_CTX, I_CCTX, I_WADA, I_BADA, I_NORMG, I_WG, I_WU, I_WD, I_WQKV, I_WO, I_QG, I_KG, I_SINK, I_WF, I_WSI, I_SVG, I_WSS, I_BSS, I_WSOUT };
constexpr int CW_QUEUE = 64;
constexpr int TR_FFN = 5632, TR_TOTAL = 98304, IT_F = 16384, IT_DC = 256, IT_FC = 256, IT_ROPE = 1024, IT_TOTAL = TR_TOTAL + IT_F + IT_DC + IT_FC + IT_ROPE;
constexpr float F_SCALE_LAT = 0.00069053396600248786f;
constexpr float F_SCALE_CTX = 0.00390625f;

__device__ __forceinline__ void prologue_item(const KArgs& a, int r, LAS float* scr, int lane) {
    unsigned char* ws = a.ws;
    if (r < TR_TOTAL) {
        if (r < 12 * TR_FFN) { const int kind = r / (4 * TR_FFN), l = (r / TR_FFN) & 3, it = r % TR_FFN;
            if (kind == 0)      transpose_item(a.in[I_WG] + (size_t)l * D * DFF, D, DFF, (bf16*)(ws + WS_WGU + (size_t)l * 44 * MiB), 1, scr, it, lane);
            else if (kind == 1) transpose_item(a.in[I_WU] + (size_t)l * D * DFF, D, DFF, (bf16*)(ws + WS_WGU + (size_t)l * 44 * MiB), 2, scr, it, lane);
            else                transpose_item(a.in[I_WD] + (size_t)l * DFF * D, DFF, D, (bf16*)(ws + WS_WDN + (size_t)l * 22 * MiB), 0, scr, it, lane);
            return; }
        r -= 12 * TR_FFN;
        if (r < 6144) { const int j = r / 3072; transpose_item(a.in[I_WQKV] + (size_t)j * D * NQKV, D, NQKV, (bf16*)(ws + WS_WQKV + (size_t)j * 12 * MiB), 0, scr, r % 3072, lane); return; }
        r -= 6144;
        if (r < 4096) { const int j = r / 2048; transpose_item(a.in[I_WO] + (size_t)j * HQ * D, HQ, D, (bf16*)(ws + WS_WO + (size_t)j * 8 * MiB), 0, scr, r % 2048, lane); return; }
        r -= 4096;
        if (r < 2048) { transpose_item(a.in[I_WF], D, D, (bf16*)(ws + WS_WF), 0, scr, r, lane); return; }
        r -= 2048;
        if (r < 12288) { transpose_item(a.in[I_WSI], D, 2 * SGH, (bf16*)(ws + WS_WSI), 0, scr, r, lane); return; }
        r -= 12288;
        transpose_item(a.in[I_WSOUT], SGH, D, (bf16*)(ws + WS_WSO), 0, scr, r, lane); return;
    }
    r -= TR_TOTAL;
    if (r < IT_F) {
        const int k = r >> 1, reim = r & 1; bf16* dst = (bf16*)(ws + WS_AR + AR_F) + (size_t)k * 16384 + reim * 8192;
        for (int it = 0; it < 16; ++it) { const int t0 = it * 512 + lane * 8; float v[8];
#pragma unroll
            for (int e = 0; e < 8; ++e) { const int idx = ((k * (t0 + e)) + reim * 2048) & 8191; v[e] = F_SCALE_LAT * __builtin_amdgcn_cosf((float)idx * (1.0f / 8192.0f)); }
            u32x4 w; w.x = cvt_pk_bf16(v[0], v[1]); w.y = cvt_pk_bf16(v[2], v[3]); w.z = cvt_pk_bf16(v[4], v[5]); w.w = cvt_pk_bf16(v[6], v[7]);
            *(u32x4*)(dst + t0) = w; }
        return; }
    r -= IT_F;
    if (r < IT_DC) {
        const int e0 = r * 512 + lane * 8, row = e0 >> 8, c0 = e0 & 255, m = row & 255, reim = row >> 8; float v[8];
#pragma unroll
        for (int e = 0; e < 8; ++e) { const float fr = (float)((m * (c0 + e)) & 255) * (1.0f / 256.0f); v[e] = reim ? __builtin_amdgcn_sinf(fr) : __builtin_amdgcn_cosf(fr); }
        u32x4 w; w.x = cvt_pk_bf16(v[0], v[1]); w.y = cvt_pk_bf16(v[2], v[3]); w.z = cvt_pk_bf16(v[4], v[5]); w.w = cvt_pk_bf16(v[6], v[7]);
        *(u32x4*)((bf16*)(ws + WS_DC2) + e0) = w; return; }
    r -= IT_DC;
    if (r < IT_FC) {
        const int e0 = r * 512 + lane * 8, k = e0 >> 9, c0 = e0 & 511, reim = c0 >> 8, l0 = c0 & 255; float v[8];
#pragma unroll
        for (int e = 0; e < 8; ++e) { const int idx = ((k * (l0 + e)) + reim * 64) & 255; v[e] = F_SCALE_CTX * __builtin_amdgcn_cosf((float)idx * (1.0f / 256.0f)); }
        u32x4 w; w.x = cvt_pk_bf16(v[0], v[1]); w.y = cvt_pk_bf16(v[2], v[3]); w.z = cvt_pk_bf16(v[4], v[5]); w.w = cvt_pk_bf16(v[6], v[7]);
        *(u32x4*)((bf16*)(ws + WS_FC) + e0) = w; return; }
    r -= IT_FC;
    {
        f32x2* dst = (f32x2*)(ws + WS_ROPE) + (size_t)r * 512 + lane * 8;
#pragma unroll
        for (int e = 0; e < 8; ++e) { const int idx = r * 512 + lane * 8 + e, t = idx >> 6, f = idx & 63;
            const float inv = __builtin_amdgcn_exp2f(-(float)(f & 31) * (13.287712379549449f / 32.0f));
            const float ang = (float)(f < 32 ? (t >> 6) : (t & 63)) * inv, rev = ang * 0.15915494309189535f;
            dst[e] = (f32x2){__builtin_amdgcn_cosf(rev), __builtin_amdgcn_sinf(rev)}; }
    }
}

__device__ __forceinline__ void prologue_phase(const KArgs& a, LAS unsigned char* lds, gu32* ctl, int tid, int lane, int wave) {
    asm volatile("" : "+v"(tid), "+v"(lane));
    if (blockIdx.x < 192) {
        const int l = blockIdx.x / 48, jb = blockIdx.x % 48;
        LAS float* sl = (LAS float*)lds;
        LAS float* part = (LAS float*)(lds + 24576);
        for (int i = tid; i < 3 * D; i += 512) { const int r = i / D, k = i % D; const float cv = r < 2 ? a.in[I_C][r * D + k] : a.in[I_CCTX][k]; sl[i] = silu_f(cv); }
        __syncthreads();
        const float* wp = a.in[I_WADA] + ((size_t)l * D + wave * 256) * NADA + jb * 256 + 4 * lane;
        f32x4 a0 = {0.f, 0.f, 0.f, 0.f}, a1 = a0, a2 = a0;
        for (int k = 0; k < 256; k += 8) { f32x4 w[8];
#pragma unroll
            for (int e = 0; e < 8; ++e) w[e] = *(const f32x4*)(wp + (size_t)(k + e) * NADA);
#pragma unroll
            for (int e = 0; e < 8; ++e) { const int kk = wave * 256 + k + e; a0 += w[e] * sl[kk]; a1 += w[e] * sl[D + kk]; a2 += w[e] * sl[2 * D + kk]; } }
        *(LAS f32x4*)(part + (wave * 3 + 0) * 256 + 4 * lane) = a0; *(LAS f32x4*)(part + (wave * 3 + 1) * 256 + 4 * lane) = a1; *(LAS f32x4*)(part + (wave * 3 + 2) * 256 + 4 * lane) = a2;
        __syncthreads();
        for (int i = tid; i < 768; i += 512) { const int r = i >> 8, j = i & 255; float s = 0.f;
#pragma unroll
            for (int w = 0; w < 8; ++w) s += part[(w * 3 + r) * 256 + j];
            ((float*)(a.ws + WS_MX))[((size_t)l * 3 + r) * NADA + jb * 256 + j] = s; }
        __syncthreads();
    }
    LAS float* scr = (LAS float*)(lds + wave * 16384);
    for (;;) {
        unsigned base = 0; if (lane == 0) base = __hip_atomic_fetch_add((unsigned*)(ctl + CW_QUEUE), 8u, RLX_AGENT);
        base = (unsigned)__builtin_amdgcn_readfirstlane((int)base);
        if (base >= (unsigned)IT_TOTAL) break;
        for (int i = 0; i < 8; ++i) { const int it = (int)base + i; if (it < IT_TOTAL) prologue_item(a, it, scr, lane); }
    }
}
namespace attn {
constexpr float SCALE = 0.08838834764831845f;
constexpr float THR = 8.f;
constexpr int SHM_K = 64 * 128 * 2, SHM_V = 64 * 128 * 2;
constexpr int OFF_V = 0, OFF_K = 2 * SHM_V, OFF_WS = 2 * SHM_V + 2 * SHM_K, LDS_BYTES = OFF_WS + 8 * 64 * 4;
#define KSWZ(row, colB) ((row) * 256 + ((colB) ^ (((row) & 7) << 4)))
#define SBAR() __builtin_amdgcn_sched_barrier(0)
__device__ __forceinline__ int v_st(int k, int c) { const int kk = (k & ~0xC) | ((k & 4) << 1) | ((k & 8) >> 1); return ((kk >> 3) * 4 + (c >> 5)) * 512 + ((kk & 7) * 32 + (c & 31)) * 2; }
__device__ __forceinline__ int v_rd_base(int lane) { return ((lane & 3) << 3) | (((lane >> 2) & 3) << 6) | (((lane >> 4) & 1) << 5) | (((lane >> 5) & 1) << 8); }
__device__ __forceinline__ int crow(int r, int hi) { return (r & 3) + 8 * (r >> 2) + 4 * hi; }
__device__ __forceinline__ void mask_tile(f32x16& p0, f32x16& p1, int dq, unsigned W) {
    const float NEG = -__builtin_inff();
#pragma unroll
    for (int r = 0; r < 16; ++r) { const int c = (r & 3) + 8 * (r >> 2);
        if ((unsigned)(dq - c) >= W) p0[r] = NEG;
        if ((unsigned)(dq - c - 32) >= W) p1[r] = NEG; }
}
__device__ __forceinline__ void partialSM(f32x16& p0, f32x16& p1, float& m_reg, float& mn, float& alpha) {
    float pmax = p0[0];
#pragma unroll
    for (int r = 1; r < 16; ++r) pmax = fmaxf(pmax, p0[r]);
#pragma unroll
    for (int r = 0; r < 16; ++r) pmax = fmaxf(pmax, p1[r]);
    { auto rr = __builtin_amdgcn_permlane32_swap(__float_as_uint(pmax), __float_as_uint(pmax), false, false);
      pmax = fmaxf(__uint_as_float(rr[0]), __uint_as_float(rr[1])); }
    constexpr float C2 = 1.4426950408889634f * SCALE;
    if (__builtin_expect(__all((pmax - m_reg) * SCALE <= THR), 1)) { mn = m_reg; alpha = 1.f; }
    else { mn = fmaxf(m_reg, pmax); alpha = __builtin_amdgcn_exp2f((m_reg - mn) * C2); m_reg = mn; }
    const float mnL = -mn * C2;
#pragma unroll
    for (int r = 0; r < 16; ++r) p0[r] = fmaf(p0[r], C2, mnL);
#pragma unroll
    for (int r = 0; r < 16; ++r) p1[r] = fmaf(p1[r], C2, mnL);
#pragma unroll
    for (int r = 0; r < 16; ++r) p0[r] = __builtin_amdgcn_exp2f(p0[r]);
}
__device__ __forceinline__ void finishSM(f32x16& p0, f32x16& p1, float alpha, float& l_reg, bf16x8& pa0, bf16x8& pa1, bf16x8& pa2, bf16x8& pa3) {
#pragma unroll
    for (int r = 0; r < 16; ++r) p1[r] = __builtin_amdgcn_exp2f(p1[r]);
    float ps = 0;
#pragma unroll
    for (int r = 0; r < 16; ++r) ps += p0[r];
#pragma unroll
    for (int r = 0; r < 16; ++r) ps += p1[r];
    { auto rr = __builtin_amdgcn_permlane32_swap(__float_as_uint(ps), __float_as_uint(ps), false, false);
      ps = __uint_as_float(rr[0]) + __uint_as_float(rr[1]); }
    l_reg = l_reg * alpha + ps;
#define PK4(P, B_, OUT) do { unsigned a0 = cvt_pk_bf16(P[B_+0], P[B_+1]), a1 = cvt_pk_bf16(P[B_+2], P[B_+3]);                          \
        unsigned b0 = cvt_pk_bf16(P[B_+4], P[B_+5]), b1 = cvt_pk_bf16(P[B_+6], P[B_+7]);                                             \
        auto r0 = __builtin_amdgcn_permlane32_swap(a0, b0, false, false); auto r1 = __builtin_amdgcn_permlane32_swap(a1, b1, false, false); \
        u32x4 w = {r0[0], r1[0], r0[1], r1[1]}; OUT = *reinterpret_cast<bf16x8*>(&w); } while (0)
    PK4(p0, 0, pa0); PK4(p0, 8, pa1); PK4(p1, 0, pa2); PK4(p1, 8, pa3);
#undef PK4
}
template <int KB>
__device__ __forceinline__ void qkt(f32x16& p0, f32x16& p1, const char* K_lds, int r32, int hi, const bf16x8* qr) {
    p0 = f32x16{}; p1 = f32x16{};
    const char* kb[4];
#pragma unroll
    for (int dd = 0; dd < 4; ++dd) kb[dd] = K_lds + KB * SHM_K + KSWZ(r32, (dd * 16 + hi * 8) * 2);
#pragma unroll
    for (int d0 = 0; d0 < 8; ++d0) { const char* a = kb[d0 & 3] + (d0 >> 2) * 128;
        bf16x8 b0 = *reinterpret_cast<const bf16x8*>(a);
        bf16x8 b1 = *reinterpret_cast<const bf16x8*>(a + 32 * 256);
        p0 = __builtin_amdgcn_mfma_f32_32x32x16_bf16(b0, qr[d0], p0, 0, 0, 0);
        p1 = __builtin_amdgcn_mfma_f32_32x32x16_bf16(b1, qr[d0], p1, 0, 0, 0); }
}
#define TRRD(dst, off) asm volatile("ds_read_b64_tr_b16 %0, %1 offset:%2" : "=&v"(dst) : "v"(vb0), "i"(off) : "memory")
#define PV_D0(oacc, vbuf, d0, pa0, pa1, pa2, pa3) do { s16x4 l0, l1, l2, l3, h0, h1, h2, h3; constexpr int b_ = (vbuf) + (d0) * 512; \
        TRRD(l0, b_); TRRD(h0, b_ + 2048); TRRD(l1, b_ + 4096); TRRD(h1, b_ + 6144); TRRD(l2, b_ + 8192); TRRD(h2, b_ + 10240); TRRD(l3, b_ + 12288); TRRD(h3, b_ + 14336); \
        asm volatile("s_waitcnt lgkmcnt(0)" ::: "memory"); SBAR(); \
        oacc = __builtin_amdgcn_mfma_f32_32x32x16_bf16(pa0, (bf16x8){l0[0], l0[1], l0[2], l0[3], h0[0], h0[1], h0[2], h0[3]}, oacc, 0, 0, 0);   \
        oacc = __builtin_amdgcn_mfma_f32_32x32x16_bf16(pa1, (bf16x8){l1[0], l1[1], l1[2], l1[3], h1[0], h1[1], h1[2], h1[3]}, oacc, 0, 0, 0);   \
        oacc = __builtin_amdgcn_mfma_f32_32x32x16_bf16(pa2, (bf16x8){l2[0], l2[1], l2[2], l2[3], h2[0], h2[1], h2[2], h2[3]}, oacc, 0, 0, 0);   \
        oacc = __builtin_amdgcn_mfma_f32_32x32x16_bf16(pa3, (bf16x8){l3[0], l3[1], l3[2], l3[3], h3[0], h3[1], h3[2], h3[3]}, oacc, 0, 0, 0); } while (0)
template <int VB>
__device__ __forceinline__ void pv_tile(f32x16* o, int vb0, bf16x8 pa0, bf16x8 pa1, bf16x8 pa2, bf16x8 pa3) {
    PV_D0(o[0], VB * SHM_V, 0, pa0, pa1, pa2, pa3); PV_D0(o[1], VB * SHM_V, 1, pa0, pa1, pa2, pa3);
    PV_D0(o[2], VB * SHM_V, 2, pa0, pa1, pa2, pa3); PV_D0(o[3], VB * SHM_V, 3, pa0, pa1, pa2, pa3);
}

struct AUnit { int qrow0, klat0, kctx0, kh, tb; };

__device__ __forceinline__ void attn_unit(const bf16* QKV, bf16* AO, const float* sink, const AUnit u, char* lds) {
    int tid = threadIdx.x; asm volatile("" : "+v"(tid));
    const int wid = __builtin_amdgcn_readfirstlane(tid >> 6), lane = tid & 63, r32 = lane & 31, hi = lane >> 5;
    const int hq = u.kh * 4 + (wid >> 1), half = wid & 1;
    char* V_lds = lds + OFF_V; char* K_lds = lds + OFF_K;
    float* wsc = (float*)(lds + OFF_WS) + wid * 64; float* li_l = wsc; float* al_l = wsc + 32;
    const int sr = tid >> 4, sc = (tid & 15) * 8, vst0 = v_st(sr, sc), vst1 = v_st(32 + sr, sc), kws = KSWZ(sr, sc * 2);
    const int vb0 = (int)(uintptr_t)V_lds + v_rd_base(lane);
    int jlo = 0, nwin = 0;
    if (u.tb >= 0) { jlo = u.tb - 2 < 0 ? 0 : u.tb - 2; const int jhi = u.tb + 2 > SEQ / 64 - 1 ? SEQ / 64 - 1 : u.tb + 2; nwin = jhi - jlo + 1; }
    const int NT = 4 + nwin;
    const bf16* kvbase = QKV + HQ + u.kh * HD + sc;
    bf16x8 st_k0, st_k1, st_v0, st_v1;
#define A_KROW(t) ((t) < 4 ? u.kctx0 + 64 * (t) : u.klat0 + 64 * (jlo + (t) - 4))
#define A_LOAD(t) do { const bf16* p_ = kvbase + (size_t)(A_KROW(t) + sr) * NQKV; st_k0 = *(const bf16x8*)p_; st_k1 = *(const bf16x8*)(p_ + (size_t)32 * NQKV); \
                       st_v0 = *(const bf16x8*)(p_ + HKV); st_v1 = *(const bf16x8*)(p_ + (size_t)32 * NQKV + HKV); } while (0)
#define A_WRITE(bf) do { *(bf16x8*)(K_lds + (bf) * SHM_K + kws) = st_k0; *(bf16x8*)(K_lds + (bf) * SHM_K + kws + 32 * 256) = st_k1; \
                         *(bf16x8*)(V_lds + (bf) * SHM_V + vst0) = st_v0; *(bf16x8*)(V_lds + (bf) * SHM_V + vst1) = st_v1; } while (0)
    A_LOAD(0);
    bf16x8 qr[8];
    { const bf16* qp = QKV + (size_t)(u.qrow0 + 32 * half + r32) * NQKV + hq * HD + hi * 8;
#pragma unroll
      for (int d0 = 0; d0 < 8; ++d0) qr[d0] = *(const bf16x8*)(qp + d0 * 16); }
    float m_reg = sink[hq] * (1.0f / SCALE), l_reg = 1.0f; f32x16 o[4] = {};
    const int qpos128 = 64 * u.tb + 32 * half + r32 + 128 - 4 * hi;
    VM_WAIT(); A_WRITE(0);
    __syncthreads();
#define A_RESC(a) do { if (__any((a) < 1.f)) { if (hi == 0) al_l[r32] = (a); asm volatile("s_waitcnt lgkmcnt(0)" ::: "memory");              \
                     _Pragma("unroll") for (int d_ = 0; d_ < 4; ++d_) _Pragma("unroll") for (int r = 0; r < 16; ++r) o[d_][r] *= al_l[crow(r, hi)]; } } while (0)
#define A_COMPUTE(BUF, t) do { f32x16 p0, p1; float mn, alpha; bf16x8 pa0, pa1, pa2, pa3; \
        qkt<BUF>(p0, p1, K_lds, r32, hi, qr); \
        if ((t) >= 4) { const int blk = jlo + (t) - 4; if (blk == u.tb - 2 || blk == u.tb + 2) mask_tile(p0, p1, qpos128 - 64 * blk, 257u); } \
        partialSM(p0, p1, m_reg, mn, alpha); A_RESC(alpha); finishSM(p0, p1, alpha, l_reg, pa0, pa1, pa2, pa3); SBAR(); \
        pv_tile<BUF>(o, vb0, pa0, pa1, pa2, pa3); } while (0)
    for (int t = 0; t < NT; t += 2) {
        if (t + 1 < NT) A_LOAD(t + 1);
        A_COMPUTE(0, t);
        if (t + 1 < NT) { VM_WAIT(); A_WRITE(1); }
        __syncthreads();
        if (t + 1 >= NT) break;
        if (t + 2 < NT) A_LOAD(t + 2);
        A_COMPUTE(1, t + 1);
        if (t + 2 < NT) { VM_WAIT(); A_WRITE(0); }
        __syncthreads();
    }
    if (hi == 0) li_l[r32] = l_reg; asm volatile("s_waitcnt lgkmcnt(0)" ::: "memory");
    bf16* Ow = AO + (size_t)(u.qrow0 + 32 * half) * D + hq * HD;
#pragma unroll
    for (int r = 0; r < 16; ++r) { const int orow = crow(r, hi); const float rl = __builtin_amdgcn_rcpf(li_l[orow]);
#pragma unroll
        for (int d0 = 0; d0 < 4; ++d0) { const float v = o[d0][r] * rl; const float vn = __shfl_xor(v, 1);
            if ((r32 & 1) == 0) *(unsigned*)(Ow + (size_t)orow * D + d0 * 32 + r32) = cvt_pk_bf16(v, vn); } }
    asm volatile("s_waitcnt lgkmcnt(0)" ::: "memory");
    __syncthreads();
#undef A_KROW
#undef A_LOAD
#undef A_WRITE
#undef A_RESC
#undef A_COMPUTE
}

__device__ __forceinline__ void attn_phase(const bf16* QKV, bf16* AO, const float* sink, bool with_ctx, int vcu, int G, char* lds) {
    for (int uid = vcu * 4; uid < 1024; uid += G * 4) {
        for (int i = 0; i < 4; ++i) { const int id = uid + i, bk = id >> 7, b = bk >> 2; AUnit u; u.kh = bk & 3; u.tb = id & 127;
            u.qrow0 = b * SEQ + 64 * u.tb; u.klat0 = b * SEQ; u.kctx0 = ML + b * CTXL; attn_unit(QKV, AO, sink, u, lds); }
    }
    if (with_ctx) for (int id = vcu; id < 32; id += G) { AUnit u; const int b = id >> 4; u.kh = (id >> 2) & 3; u.tb = -1; u.qrow0 = ML + b * CTXL + 64 * (id & 3); u.klat0 = 0; u.kctx0 = ML + b * CTXL;
        attn_unit(QKV, AO, sink, u, lds); }
}

__device__ __forceinline__ void sgu_unit(bf16* Z, const float* ssq, const float* wsp, const float* bsp, const float* gvv, int chunk, int g, char* lds) {
    int tid = threadIdx.x; asm volatile("" : "+v"(tid));
    const int wid = __builtin_amdgcn_readfirstlane(tid >> 6), lane = tid & 63, r32 = lane & 31, hi = lane >> 5;
    const int pb = wid & 3, dh = wid >> 2, R0 = chunk * 128;
    char* V_lds = lds;
    const int sr = tid >> 4, sc = (tid & 15) * 8, vst0 = v_st(sr, sc), vst1 = v_st(32 + sr, sc);
    const int vb0 = (int)(uintptr_t)V_lds + v_rd_base(lane);
    bf16x8 pa[8];
    { const float* wrow = wsp + ((size_t)(g * 128 + pb * 32 + r32)) * 128 + 8 * hi; const float* sq = ssq + R0 + 8 * hi;
#pragma unroll
      for (int ks = 0; ks < 8; ++ks) { const f32x4 w0 = *(const f32x4*)(wrow + ks * 16), w1 = *(const f32x4*)(wrow + ks * 16 + 4); const f32x4 s0 = *(const f32x4*)(sq + ks * 16), s1 = *(const f32x4*)(sq + ks * 16 + 4);
          float v[8];
#pragma unroll
          for (int e = 0; e < 4; ++e) { v[e] = w0[e] / sqrtf(s0[e] * (1.0f / SGH) + EPS); v[4 + e] = w1[e] / sqrtf(s1[e] * (1.0f / SGH) + EPS); }
          u32x4 w; w.x = cvt_pk_bf16(v[0], v[1]); w.y = cvt_pk_bf16(v[2], v[3]); w.z = cvt_pk_bf16(v[4], v[5]); w.w = cvt_pk_bf16(v[6], v[7]); pa[ks] = *reinterpret_cast<bf16x8*>(&w); } }
    float bias[16];
#pragma unroll
    for (int r = 0; r < 16; ++r) bias[r] = bsp[g * 128 + pb * 32 + crow(r, hi)];
    const bf16* vsrc = Z + (size_t)(R0 + sr) * (2 * SGH) + SGH + g * SGG + sc;
    bf16x8 s00, s01, s10, s11;
#define S_LOAD(db) do { const bf16* p_ = vsrc + (db) * 128; s00 = *(const bf16x8*)p_; s01 = *(const bf16x8*)(p_ + (size_t)32 * 2 * SGH); \
                        s10 = *(const bf16x8*)(p_ + (size_t)64 * 2 * SGH); s11 = *(const bf16x8*)(p_ + (size_t)96 * 2 * SGH); } while (0)
#define S_WRITE() do { *(bf16x8*)(V_lds + vst0) = s00; *(bf16x8*)(V_lds + vst1) = s01; *(bf16x8*)(V_lds + SHM_V + vst0) = s10; *(bf16x8*)(V_lds + SHM_V + vst1) = s11; } while (0)
    S_LOAD(0);
    for (int db = 0; db < 6; ++db) {
        VM_WAIT(); S_WRITE();
        __syncthreads();
        if (db + 1 < 6) S_LOAD(db + 1);
        f32x16 o0 = {}, o1 = {};
        if (dh == 0) { PV_D0(o0, 0, 0, pa[0], pa[1], pa[2], pa[3]); PV_D0(o0, SHM_V, 0, pa[4], pa[5], pa[6], pa[7]); PV_D0(o1, 0, 1, pa[0], pa[1], pa[2], pa[3]); PV_D0(o1, SHM_V, 1, pa[4], pa[5], pa[6], pa[7]); }
        else         { PV_D0(o0, 0, 2, pa[0], pa[1], pa[2], pa[3]); PV_D0(o0, SHM_V, 2, pa[4], pa[5], pa[6], pa[7]); PV_D0(o1, 0, 3, pa[0], pa[1], pa[2], pa[3]); PV_D0(o1, SHM_V, 3, pa[4], pa[5], pa[6], pa[7]); }
        const int colb = g * SGG + db * 128 + dh * 64 + r32; const float gv0 = gvv[colb], gv1 = gvv[colb + 32];
        bf16* up = Z + (size_t)(R0 + pb * 32) * (2 * SGH) + colb;
#pragma unroll
        for (int r = 0; r < 16; ++r) { const int p = crow(r, hi); const float t0 = gv0 * o0[r] + bias[r], t1 = gv1 * o1[r] + bias[r];
            const float t0n = __shfl_xor(t0, 1), t1n = __shfl_xor(t1, 1);
            if ((r32 & 1) == 0) { unsigned* q0 = (unsigned*)(up + (size_t)p * (2 * SGH)); unsigned* q1 = (unsigned*)(up + (size_t)p * (2 * SGH) + 32);
                const unsigned ua = *q0, ub = *q1;
                *q0 = cvt_pk_bf16(__uint_as_float(ua << 16) * t0, __uint_as_float(ua & 0xffff0000u) * t0n);
                *q1 = cvt_pk_bf16(__uint_as_float(ub << 16) * t1, __uint_as_float(ub & 0xffff0000u) * t1n); } }
        __syncthreads();
    }
#undef S_LOAD
#undef S_WRITE
}
#undef TRRD
}
constexpr int NWAVES = 8;
constexpr int RING_BYTES = 131072, LDSCTL_OFF = RING_BYTES, LDS_BYTES = 147456;
constexpr int NPH = 31;

struct Ctx { KArgs a; LAS unsigned char* lds; gu32* ctl; XcdBarrier bar; int tid, lane, wave, vcu, G, gw, NGW, lo, hi; };
#define PH_IN(k) (C.lo <= (k) && (k) < C.hi)
#define PH_SEAM(k) do { if (!MK_PER_PHASE && (k) + 1 < C.hi) xcd_barrier(C.bar); } while (0)
#define WSP(T, off) ((T*)(C.a.ws + (off)))

struct SchedF {
    const char* A; const char* B; int mode, G, c;
    __device__ __forceinline__ bool next(int i, pg8::Unit& u) const {
        const int L = i * G + c; u.pm = 0; u.pn = 0;
        if (mode == 0) { if (L >= 1024) return false; const int b = L >> 9, rem = L & 511, gr = rem >> 5, tt = rem & 31, g = gr >> 1, reim = gr & 1;
            u.a = A + (size_t)reim * 256 * 256 * 2; u.b = B + ((size_t)(b * SEQ + tt * 256) * D + g * 256) * 2; u.o = (long)(b * D + g * 256) * 16384 + reim * 8192 + tt * 256; return true; }
        if (mode == 1) { if (L >= 32) return false; const int b = L >> 4, gr = L & 15, g = gr >> 1, reim = gr & 1;
            u.a = A + (size_t)reim * 256 * 256 * 2; u.b = B + ((size_t)(ML + b * CTXL) * D + g * 256) * 2; u.o = (long)(b * D + g * 256) * 512 + reim * 256; return true; }
        if (mode == 2) { if (L >= 512) return false; const int b = L >> 8; int pm, pn; pg8::tile_of(L & 255, 32, 8, pm, pn);
            u.a = A + (size_t)pm * 256 * 16384 * 2; u.b = B + (size_t)(b * D + pn * 256) * 16384 * 2; u.o = (long)(b * SEQ + pm * 256) * D + pn * 256; return true; }
        if (L >= 16) return false; { const int b = L >> 3, pn = L & 7;
            u.a = A; u.b = B + (size_t)(b * D + pn * 256) * 512 * 2; u.o = (long)(ML + b * CTXL) * D + pn * 256; return true; }
    }
};

template <int PH0> __device__ __forceinline__ void ffn_block(Ctx& C, int l, int nM) {
    const float* mxl = WSP(const float, WS_MX) + (size_t)l * 3 * NADA; const float* bl = C.a.in[I_BADA] + (size_t)l * NADA;
    float* XR = WSP(float, WS_XR); bf16* H = WSP(bf16, WS_H); bf16* Gb = WSP(bf16, WS_AR + AR_G);
    if (PH_IN(PH0)) { modnorm_phase(XR, XR + (size_t)ML * D, nullptr, H, C.a.in[I_NORMG] + (size_t)(l * 2 + 1) * D, mxl, bl, 1, nM * 256, C.gw, C.NGW, C.lane); PH_SEAM(PH0); }
    if (PH_IN(PH0 + 1)) { const pg8::SchedRC S = pg8::make_rc(H, D, WSP(const bf16, WS_WGU + (size_t)l * 44 * MiB), D, nM, 44, DFF, 128, C.G, (int)blockIdx.x);
        const pg8::EpiSwiGLU E{Gb, DFF};
        pg8::gemm_phase<pg8::EpiSwiGLU, pg8::SchedRC>(C.lds, pg8::Gemm{D, D, D}, S, E); PH_SEAM(PH0 + 1); }
    if (PH_IN(PH0 + 2)) { const pg8::SchedRC S = pg8::make_rc(Gb, DFF, WSP(const bf16, WS_WDN + (size_t)l * 22 * MiB), DFF, nM, 8, D, 256, C.G, (int)blockIdx.x);
        const pg8::EpiRes E{XR, l == DEPTH - 1 ? C.a.out : XR, mxl + 5 * D, bl + 5 * D};
        pg8::gemm_phase<pg8::EpiRes, pg8::SchedRC>(C.lds, pg8::Gemm{DFF, DFF, DFF}, S, E); PH_SEAM(PH0 + 2); }
}

template <int PH0> __device__ __forceinline__ void attn_block(Ctx& C, int l, int j, bool first, bool ctx_out) {
    const float* mxl = WSP(const float, WS_MX) + (size_t)l * 3 * NADA; const float* bl = C.a.in[I_BADA] + (size_t)l * NADA;
    float* XR = WSP(float, WS_XR); bf16* H = WSP(bf16, WS_H); bf16* QKV = WSP(bf16, WS_AR + AR_QKV); bf16* AO = WSP(bf16, WS_AR + AR_AO);
    if (PH_IN(PH0)) { modnorm_phase(first ? C.a.in[I_X] : XR, first ? C.a.in[I_CTX] : XR + (size_t)ML * D, first ? XR : nullptr, H, C.a.in[I_NORMG] + (size_t)(l * 2) * D, mxl, bl, 0, MT, C.gw, C.NGW, C.lane); PH_SEAM(PH0); }
    if (PH_IN(PH0 + 1)) { const pg8::SchedRC S = pg8::make_rc(H, D, WSP(const bf16, WS_WQKV + (size_t)j * 12 * MiB), D, 66, 12, NQKV, 256, C.G, (int)blockIdx.x);
        const pg8::EpiBf16<0, false> E{QKV, NQKV, nullptr, 0};
        pg8::gemm_phase<pg8::EpiBf16<0, false>, pg8::SchedRC>(C.lds, pg8::Gemm{D, D, D}, S, E); PH_SEAM(PH0 + 1); }
    if (PH_IN(PH0 + 2)) { qknorm_rope_phase(QKV, C.a.in[I_QG] + j * HD, C.a.in[I_KG] + j * HD, WSP(const f32x2, WS_ROPE), MT, C.gw, C.NGW, C.lane); PH_SEAM(PH0 + 2); }
    if (PH_IN(PH0 + 3)) { attn::attn_phase(QKV, AO, C.a.in[I_SINK] + j * NH, ctx_out, C.vcu, C.G, (char*)C.lds); PH_SEAM(PH0 + 3); }
    if (PH_IN(PH0 + 4)) { const pg8::SchedRC S = pg8::make_rc(AO, D, WSP(const bf16, WS_WO + (size_t)j * 8 * MiB), D, ctx_out ? 66 : 64, 8, D, 256, C.G, (int)blockIdx.x);
        const pg8::EpiRes E{XR, XR, mxl + 2 * D, bl + 2 * D};
        pg8::gemm_phase<pg8::EpiRes, pg8::SchedRC>(C.lds, pg8::Gemm{D, D, D}, S, E); PH_SEAM(PH0 + 4); }
}

__global__ void __launch_bounds__(NWAVES * 64, 2) mega(KArgs args) {
    extern __shared__ __attribute__((aligned(16))) unsigned char lds_raw[];
    Ctx C; C.a = args; C.lds = (LAS unsigned char*)lds_raw; C.ctl = (gu32*)(args.ws + WS_CTL);
    C.tid = threadIdx.x; C.lane = C.tid & 63; C.wave = __builtin_amdgcn_readfirstlane(C.tid >> 6);
    C.G = gridDim.x; { const int bx = blockIdx.x; C.vcu = (C.G % 8 == 0) ? (bx % 8) * (C.G / 8) + bx / 8 : bx; }
    C.gw = C.vcu * NWAVES + C.wave; C.NGW = C.G * NWAVES; C.lo = args.ph_lo; C.hi = args.ph_hi;
    volatile LAS unsigned* MISC = (volatile LAS unsigned*)(C.lds + LDSCTL_OFF);
    for (int u = C.tid; u < (LDS_BYTES - LDSCTL_OFF) / 4; u += NWAVES * 64) ((LAS unsigned*)(C.lds + LDSCTL_OFF))[u] = 0u;
    __syncthreads();
    C.bar.bar = (unsigned*)(C.ctl + CW_BAR); C.bar.x = 0; C.bar.st = nullptr;
    if (!MK_PER_PHASE) C.bar = xcd_barrier_post((unsigned*)(C.ctl + CW_BAR), MISC + 8);

    float* XR = WSP(float, WS_XR); bf16* H = WSP(bf16, WS_H);
    if (PH_IN(0)) { prologue_phase(C.a, C.lds, C.ctl, C.tid, C.lane, C.wave); PH_SEAM(0); }
    attn_block<1>(C, 0, 0, true, true);
    ffn_block<6>(C, 0, 66);
    {
        const int l = 1; const float* mxl = WSP(const float, WS_MX) + (size_t)l * 3 * NADA; const float* bl = C.a.in[I_BADA] + (size_t)l * NADA;
        bf16* XT = WSP(bf16, WS_AR + AR_XT); bf16* XTC = WSP(bf16, WS_AR + AR_XTC); bf16* Fm = WSP(bf16, WS_AR + AR_F); bf16* Y = WSP(bf16, WS_AR + AR_Y);
        if (PH_IN(9)) { modnorm_phase(XR, XR + (size_t)ML * D, nullptr, H, C.a.in[I_NORMG] + (size_t)(l * 2) * D, mxl, bl, 0, MT, C.gw, C.NGW, C.lane); PH_SEAM(9); }
        if (PH_IN(10)) {
            { const SchedF S{(const char*)WSP(bf16, WS_DC2), (const char*)H, 0, C.G, (int)blockIdx.x}; const pg8::EpiBf16<0, false> E{XT, 16384, nullptr, 0};
              pg8::gemm_phase<pg8::EpiBf16<0, false>, SchedF>(C.lds, pg8::Gemm{256, D, 256}, S, E); }
            { const SchedF S{(const char*)WSP(bf16, WS_DC2), (const char*)H, 1, C.G, C.G - 1 - (int)blockIdx.x}; const pg8::EpiBf16<0, false> E{XTC, 512, nullptr, 0};
              pg8::gemm_phase<pg8::EpiBf16<0, false>, SchedF>(C.lds, pg8::Gemm{256, D, 256}, S, E); }
            PH_SEAM(10); }
        if (PH_IN(11)) {
            { const SchedF S{(const char*)Fm, (const char*)XT, 2, C.G, (int)blockIdx.x}; const pg8::EpiBf16<0, false> E{Y, D, nullptr, 0};
              pg8::gemm_phase<pg8::EpiBf16<0, false>, SchedF>(C.lds, pg8::Gemm{16384, 16384, 16384}, S, E); }
            { const SchedF S{(const char*)WSP(bf16, WS_FC), (const char*)XTC, 3, C.G, C.G - 1 - (int)blockIdx.x}; const pg8::EpiBf16<0, false> E{Y, D, nullptr, 0};
              pg8::gemm_phase<pg8::EpiBf16<0, false>, SchedF>(C.lds, pg8::Gemm{512, 512, 512}, S, E); }
            PH_SEAM(11); }
        if (PH_IN(12)) { const pg8::SchedRC S = pg8::make_rc(Y, D, WSP(const bf16, WS_WF), D, 66, 8, D, 256, C.G, (int)blockIdx.x);
            const pg8::EpiRes E{XR, XR, mxl + 2 * D, bl + 2 * D};
            pg8::gemm_phase<pg8::EpiRes, pg8::SchedRC>(C.lds, pg8::Gemm{D, D, D}, S, E); PH_SEAM(12); }
    }
    ffn_block<13>(C, 1, 66);
    {
        const int l = 2; const float* mxl = WSP(const float, WS_MX) + (size_t)l * 3 * NADA; const float* bl = C.a.in[I_BADA] + (size_t)l * NADA;
        bf16* Z = WSP(bf16, WS_AR + AR_Z); float* SSQ = (float*)(C.a.ws + WS_CTL) + CW_SSQ;
        if (PH_IN(16)) { modnorm_phase(XR, XR + (size_t)ML * D, nullptr, H, C.a.in[I_NORMG] + (size_t)(l * 2) * D, mxl, bl, 0, MT, C.gw, C.NGW, C.lane); PH_SEAM(16); }
        if (PH_IN(17)) { const pg8::SchedRC S = pg8::make_rc(H, D, WSP(const bf16, WS_WSI), D, 66, 48, 2 * SGH, 256, C.G, (int)blockIdx.x);
            const pg8::EpiBf16<1, true> E{Z, 2 * SGH, SSQ, 24};
            pg8::gemm_phase<pg8::EpiBf16<1, true>, pg8::SchedRC>(C.lds, pg8::Gemm{D, D, D}, S, E); PH_SEAM(17); }
        if (PH_IN(18)) { for (int uid = C.vcu; uid < (MT / 128) * 8; uid += C.G) attn::sgu_unit(Z, SSQ, C.a.in[I_WSS], C.a.in[I_BSS], C.a.in[I_SVG], uid >> 3, uid & 7, (char*)C.lds); PH_SEAM(18); }
        if (PH_IN(19)) { const pg8::SchedRC S = pg8::make_rc(Z, 2 * SGH, WSP(const bf16, WS_WSO), SGH, 66, 8, D, 256, C.G, (int)blockIdx.x);
            const pg8::EpiRes E{XR, XR, mxl + 2 * D, bl + 2 * D};
            pg8::gemm_phase<pg8::EpiRes, pg8::SchedRC>(C.lds, pg8::Gemm{2 * SGH, SGH, SGH}, S, E); PH_SEAM(19); }
    }
    ffn_block<20>(C, 2, 66);
    attn_block<23>(C, 3, 1, false, false);
    ffn_block<28>(C, 3, 64);
}

extern "C" void kernel_launch(void* const* d_in, const int* in_sizes, int n_in, void* d_out, int out_size, void* d_ws, size_t ws_size, hipStream_t stream) {
    static int grid = 0;
    if (grid == 0) {
        if (n_in != 21 || in_sizes[0] != ML * D || out_size != ML * D || ws_size < WS_END) { fprintf(stderr, "kernel_launch: unexpected shapes (n_in %d, in0 %d, out %d, ws %zu < %zu)\n", n_in, n_in > 0 ? in_sizes[0] : -1, out_size, ws_size, (size_t)WS_END); grid = -1; return; }
        int dev = 0, cus = 0, per_cu = 0;
        if (hipGetDevice(&dev) != hipSuccess || hipDeviceGetAttribute(&cus, hipDeviceAttributeMultiprocessorCount, dev) != hipSuccess) { grid = -1; return; }
        if (hipFuncSetAttribute((const void*)mega, hipFuncAttributeMaxDynamicSharedMemorySize, LDS_BYTES) != hipSuccess) { fprintf(stderr, "kernel_launch: hipFuncSetAttribute failed\n"); grid = -1; return; }
        if (hipOccupancyMaxActiveBlocksPerMultiprocessor(&per_cu, (const void*)mega, NWAVES * 64, LDS_BYTES) != hipSuccess || per_cu < 1) fprintf(stderr, "kernel_launch: occupancy query says %d\n", per_cu);
        (void)hipGetLastError();
        grid = cus;
    }
    if (grid < 0) return;
    if (hipMemsetAsync((char*)d_ws + WS_CTL, 0, CTL_ZERO_BYTES, stream) != hipSuccess) return;
    KArgs a{};
    for (int i = 0; i < 21; ++i) a.in[i] = (const float*)d_in[i];
    a.out = (float*)d_out; a.ws = (unsigned char*)d_ws;
#if MK_PER_PHASE
    for (int ph = 0; ph < NPH; ++ph) { a.ph_lo = ph; a.ph_hi = ph + 1; hipLaunchKernelGGL(mega, dim3(grid), dim3(NWAVES * 64), LDS_BYTES, stream, a); }
#else
    a.ph_lo = 0; a.ph_hi = NPH; hipLaunchKernelGGL(mega, dim3(grid), dim3(NWAVES * 64), LDS_BYTES, stream, a);
#endif
}
```

```cpp
#include <hip/hip_runtime.h>
#include <cstdio>
#include <cstdint>

#ifndef MK_PER_PHASE
#define MK_PER_PHASE 0
#endif

constexpr int D = 2048, NBATCH = 2, SEQ = 8192, CTXL = 256, DEPTH = 4;
constexpr int ML = NBATCH * SEQ, MC = NBATCH * CTXL, MT = ML + MC;
constexpr int NH = 16, NKV = 4, HD = 128, HQ = 2048, HKV = 512, NQKV = HQ + 2 * HKV;
constexpr int DFF = 5632, SGH = 6144, SGG = 768, NADA = 6 * D;
constexpr float EPS = 1e-6f;

constexpr size_t MiB = 1u << 20;
constexpr size_t WS_CTL = 0, CTL_ZERO_BYTES = 2 * MiB;
constexpr size_t WS_MX = 2 * MiB;
constexpr size_t WS_ROPE = 3 * MiB;
constexpr size_t WS_DC2 = 7 * MiB;
constexpr size_t WS_FC = WS_DC2 + 512 * 1024;
constexpr size_t WS_WGU = 8 * MiB;
constexpr size_t WS_WDN = WS_WGU + 4 * 44 * MiB;
constexpr size_t WS_WQKV = WS_WDN + 4 * 22 * MiB;
constexpr size_t WS_WO = WS_WQKV + 2 * 12 * MiB;
constexpr size_t WS_WF = WS_WO + 2 * 8 * MiB;
constexpr size_t WS_WSI = WS_WF + 8 * MiB;
constexpr size_t WS_WSO = WS_WSI + 48 * MiB;
constexpr size_t WS_XR = WS_WSO + 24 * MiB;
constexpr size_t WS_H = WS_XR + 132 * MiB;
constexpr size_t WS_AR = WS_H + 66 * MiB;
constexpr size_t AR_QKV = 0, AR_AO = 99 * MiB;
constexpr size_t AR_G = 0;
constexpr size_t AR_Z = 0;
constexpr size_t AR_XT = 0, AR_XTC = 128 * MiB, AR_F = 182 * MiB, AR_Y = 438 * MiB;
constexpr size_t WS_END = WS_AR + 504 * MiB;
constexpr int CW_TMO = 0;
constexpr int CW_BAR = 4096;
constexpr int CW_SSQ = 16384;
static_assert((CW_SSQ + MT) * 4 <= (int)CTL_ZERO_BYTES, "ctl");

#define GAS __attribute__((address_space(1)))
#define LAS __attribute__((address_space(3)))
typedef unsigned short bf16;
typedef unsigned short bf16_t;
typedef short bf16x8 __attribute__((ext_vector_type(8)));
typedef short s16x4 __attribute__((ext_vector_type(4)));
typedef float f32x4 __attribute__((ext_vector_type(4)));
typedef float f32x2 __attribute__((ext_vector_type(2)));
typedef float f32x16 __attribute__((ext_vector_type(16)));
typedef unsigned u32x4 __attribute__((ext_vector_type(4)));
typedef unsigned u32x2 __attribute__((ext_vector_type(2)));

__device__ __forceinline__ unsigned cvt_pk_bf16(float lo, float hi) { unsigned r; asm volatile("v_cvt_pk_bf16_f32 %0, %1, %2" : "=v"(r) : "v"(lo), "v"(hi)); return r; }
__device__ __forceinline__ float bf2f(unsigned short b) { return __uint_as_float(((unsigned)b) << 16); }

namespace pg8 {
#define PG8_LAS __attribute__((address_space(3)))
constexpr int BM = 256, BK = 64, HALF = 128, HTB = HALF * BK * 2, STAGE_BYTES = 8 * HTB, NXCD = 8, WGM = 8;
__host__ __device__ __forceinline__ int lds_byte(int r, int c) { const int st = (r >> 4) * 2 + (c >> 5), rr = r & 15, cc = c & 31, ob = rr * 64 + cc * 2; return st * 1024 + (ob ^ (((ob >> 9) & 1) << 5)); }
__host__ __device__ __forceinline__ void stage_rc(int b, int& R, int& C) { const int st = b / 1024, sb = b % 1024, swz = sb ^ (((sb >> 9) & 1) << 5); R = (st >> 1) * 16 + swz / 64; C = (st & 1) * 32 + (swz % 64) / 2; }
__host__ __device__ __forceinline__ int perm32(int rho) { const int n = rho >> 4, i = rho & 15; return 8 * (i >> 2) + 4 * n + (i & 3); }

struct Unit { const char* a; const char* b; long o; int pm, pn; };
struct Gemm { int lda, ldb, K; };

__device__ __forceinline__ void tile_of(int L, int nM, int nN, int& pm, int& pn) {
    const int nwg = nM * nN; int wgid = L;
    { const int q = nwg / NXCD, r = nwg % NXCD, xcd = wgid % NXCD, off = wgid / NXCD; wgid = (xcd < r ? xcd * (q + 1) : r * (q + 1) + (xcd - r) * q) + off; }
    const int nig = WGM * nN, gid = wgid / nig, fm = gid * WGM, gsz = (nM - fm) < WGM ? (nM - fm) : WGM;
    pm = fm + ((wgid % nig) % gsz); pn = (wgid % nig) / gsz;
}

__device__ __forceinline__ f32x2 gelu_pk(f32x2 v) {
    const f32x2 av = __builtin_elementwise_abs(v), d = av * 0.2316418882f + 1.0f;
    f32x2 t; t.x = __builtin_amdgcn_rcpf(d.x); t.y = __builtin_amdgcn_rcpf(d.y);
    f32x2 q = t * 0.5307027145f + (-0.7265760135f); q = q * t + 0.7107068705f; q = q * t + (-0.142248368f); q = q * t + 0.127414796f; q = q * t;
    const f32x2 s = (v * v) * (-0.72134752044f);
    f32x2 e; e.x = __builtin_amdgcn_exp2f(s.x); e.y = __builtin_amdgcn_exp2f(s.y);
    const f32x2 m = v * (q * e), r = v - m;
    f32x2 o; o.x = v.x < 0.f ? m.x : r.x; o.y = v.y < 0.f ? m.y : r.y; return o;
}

template <class Epi, class Sched, bool ALIGN_EPI = true, bool SP2 = true>
__device__ __forceinline__ void gemm_phase(PG8_LAS unsigned char* lds, const Gemm g, const Sched& S, const Epi& E) {
    int tid = threadIdx.x; asm volatile("" : "+v"(tid));
    const int wid = __builtin_amdgcn_readfirstlane(tid >> 6), lane = tid & 63, wr = wid >> 2, wc = wid & 3, fr = lane & 15, fq = lane >> 4;
    const int K = g.K, nt = K / BK;
    unsigned voffA[2], voffB[2];
#pragma unroll
    for (int i = 0; i < 2; ++i) { int R, C; stage_rc(tid * 16 + i * 8192, R, C); const int Rb = Epi::PERM ? ((R & ~31) + perm32(R & 31)) : R;
        voffA[i] = (unsigned)(R * g.lda + C) * 2u; voffB[i] = (unsigned)(Rb * g.ldb + C) * 2u; }
    const size_t kstep = (size_t)(BK * 2);
    const size_t hstepA = (size_t)HALF * g.lda * 2, hstepB = (size_t)HALF * g.ldb * 2;
    const unsigned ldsw = (unsigned)wid * 1024u;
    const int aoff = lds_byte(wr * 64 + fr, fq * 8), boff = lds_byte(wc * 32 + fr, fq * 8);
#define PG8_SA(b, h) (((b) * 2 + (h)) * HTB)
#define PG8_SB(b, h) ((4 + (b) * 2 + (h)) * HTB)
#define PG8_STAGE(bufoff, gbase, voff) do { _Pragma("unroll") for (int _i = 0; _i < 2; ++_i) \
        __builtin_amdgcn_global_load_lds((const unsigned*)((const char*)(gbase) + (voff)[_i]), (PG8_LAS unsigned*)(lds + (bufoff) + ldsw + _i * 8192), 16, 0, 0); } while (0)
#define PG8_LDA(dst, b, h) do { _Pragma("unroll") for (int m = 0; m < 4; ++m) _Pragma("unroll") for (int k = 0; k < 2; ++k) dst[m][k] = *(const PG8_LAS bf16x8*)(lds + PG8_SA(b, h) + aoff + m * 2048 + k * 1024); } while (0)
#define PG8_LDB(dst, b, h) do { _Pragma("unroll") for (int n = 0; n < 2; ++n) _Pragma("unroll") for (int k = 0; k < 2; ++k) dst[n][k] = *(const PG8_LAS bf16x8*)(lds + PG8_SB(b, h) + boff + n * 2048 + k * 1024); } while (0)
#define PG8_MMA(ai, bj, At, Bt) do { __builtin_amdgcn_s_setprio(1); _Pragma("unroll") for (int m = 0; m < 4; ++m) _Pragma("unroll") for (int n = 0; n < 2; ++n) _Pragma("unroll") for (int k = 0; k < 2; ++k) \
        acc[ai][bj][m][n] = __builtin_amdgcn_mfma_f32_16x16x32_bf16(Bt[n][k], At[m][k], acc[ai][bj][m][n], 0, 0, 0); __builtin_amdgcn_s_setprio(0); } while (0)
#define PG8_WAIT_V(n) asm volatile("s_waitcnt vmcnt(" #n ")" ::: "memory")
#define PG8_WAIT_L(n) asm volatile("s_waitcnt lgkmcnt(" #n ")" ::: "memory")
#define PG8_BAR __builtin_amdgcn_s_barrier()
#define PG8_SCHED __builtin_amdgcn_sched_barrier(0)
    Unit cur, nxt; int ui = 0;
    if (!S.next(0, cur)) return;
    f32x4 acc[2][2][4][2];
#pragma unroll
    for (int a = 0; a < 2; ++a)
#pragma unroll
        for (int b = 0; b < 2; ++b)
#pragma unroll
            for (int m = 0; m < 4; ++m)
#pragma unroll
                for (int n = 0; n < 2; ++n) acc[a][b][m][n] = (f32x4){0.f, 0.f, 0.f, 0.f};
    bf16x8 At[4][2], B0[2][2], B1[2][2];
    const char* cA = cur.a; const char* cB = cur.b;
    if constexpr (SP2) {
        PG8_STAGE(PG8_SB(0, 0), cB, voffB); PG8_STAGE(PG8_SB(0, 1), cB + hstepB, voffB); PG8_STAGE(PG8_SA(0, 0), cA, voffA); PG8_STAGE(PG8_SA(0, 1), cA + hstepA, voffA);
        if (wr == 1) PG8_BAR;
        PG8_WAIT_V(2); PG8_BAR;
        PG8_STAGE(PG8_SB(1, 0), cB + kstep, voffB); PG8_STAGE(PG8_SA(1, 0), cA + kstep, voffA); PG8_STAGE(PG8_SB(1, 1), cB + hstepB + kstep, voffB);
        PG8_WAIT_V(6); PG8_BAR;
    } else {
        PG8_STAGE(PG8_SB(0, 0), cB, voffB); PG8_STAGE(PG8_SA(0, 0), cA, voffA); PG8_STAGE(PG8_SB(0, 1), cB + hstepB, voffB); PG8_STAGE(PG8_SA(0, 1), cA + hstepA, voffA);
        if (wr == 1) PG8_BAR;
        PG8_WAIT_V(4); PG8_BAR;
        PG8_STAGE(PG8_SB(1, 0), cB + kstep, voffB); PG8_STAGE(PG8_SA(1, 0), cA + kstep, voffA); PG8_STAGE(PG8_SB(1, 1), cB + hstepB + kstep, voffB);
        PG8_WAIT_V(6); PG8_BAR;
    }
    for (;;) {
        const bool has_next = S.next(ui + 1, nxt);
        const char* nA = has_next ? nxt.a : cA; const char* nB = has_next ? nxt.b : cB;
        for (int t = 0; t < nt; t += 2) {
            const bool last = (t == nt - 2);
            const char* a1 = cA + (size_t)(t + 1) * kstep;
            const char* a2 = last ? nA : cA + (size_t)(t + 2) * kstep; const char* b2 = last ? nB : cB + (size_t)(t + 2) * kstep;
            const char* a3 = a2 + kstep; const char* b3 = b2 + kstep;
            if constexpr (SP2) {
            PG8_LDB(B0, 0, 0); PG8_LDB(B1, 0, 1); PG8_SCHED; PG8_LDA(At, 0, 0); PG8_STAGE(PG8_SA(1, 1), a1 + hstepA, voffA);
            PG8_WAIT_V(8); PG8_WAIT_L(0); PG8_BAR; PG8_MMA(0, 0, At, B0); PG8_MMA(0, 1, At, B1); PG8_BAR; PG8_SCHED;
            PG8_LDA(At, 0, 1); PG8_STAGE(PG8_SB(0, 0), b2, voffB); PG8_STAGE(PG8_SB(0, 1), b2 + hstepB, voffB); PG8_STAGE(PG8_SA(0, 0), a2, voffA);
            PG8_WAIT_V(8); PG8_WAIT_L(0); PG8_BAR; PG8_MMA(1, 0, At, B0); PG8_MMA(1, 1, At, B1); PG8_BAR; PG8_SCHED;
            PG8_LDB(B0, 1, 0); PG8_LDB(B1, 1, 1); PG8_SCHED; PG8_LDA(At, 1, 0); PG8_STAGE(PG8_SA(0, 1), a2 + hstepA, voffA);
            PG8_WAIT_V(8); PG8_WAIT_L(0); PG8_BAR; PG8_MMA(0, 0, At, B0); PG8_MMA(0, 1, At, B1); PG8_BAR; PG8_SCHED;
            PG8_LDA(At, 1, 1); PG8_STAGE(PG8_SB(1, 0), b3, voffB); PG8_STAGE(PG8_SB(1, 1), b3 + hstepB, voffB); PG8_STAGE(PG8_SA(1, 0), a3, voffA);
            PG8_WAIT_V(8); PG8_WAIT_L(0); PG8_BAR; PG8_MMA(1, 0, At, B0); PG8_MMA(1, 1, At, B1); PG8_BAR; PG8_SCHED;
            } else {
            PG8_LDB(B0, 0, 0); PG8_SCHED; PG8_LDA(At, 0, 0); PG8_STAGE(PG8_SA(1, 1), a1 + hstepA, voffA);
            PG8_WAIT_L(8); PG8_BAR; PG8_WAIT_L(0); PG8_MMA(0, 0, At, B0); PG8_BAR; PG8_SCHED;
            PG8_LDB(B1, 0, 1); PG8_STAGE(PG8_SB(0, 0), b2, voffB);
            PG8_BAR; PG8_WAIT_L(0); PG8_MMA(0, 1, At, B1); PG8_BAR;
            PG8_LDA(At, 0, 1); PG8_STAGE(PG8_SA(0, 0), a2, voffA);
            PG8_BAR; PG8_WAIT_L(0); PG8_MMA(1, 0, At, B0); PG8_BAR; PG8_SCHED;
            PG8_STAGE(PG8_SB(0, 1), b2 + hstepB, voffB);
            PG8_WAIT_V(6); PG8_BAR; PG8_MMA(1, 1, At, B1); PG8_BAR;
            PG8_LDB(B0, 1, 0); PG8_SCHED; PG8_LDA(At, 1, 0); PG8_STAGE(PG8_SA(0, 1), a2 + hstepA, voffA);
            PG8_WAIT_L(8); PG8_BAR; PG8_WAIT_L(0); PG8_MMA(0, 0, At, B0); PG8_BAR; PG8_SCHED;
            PG8_LDB(B1, 1, 1); PG8_STAGE(PG8_SB(1, 0), b3, voffB);
            PG8_BAR; PG8_WAIT_L(0); PG8_MMA(0, 1, At, B1); PG8_BAR;
            PG8_LDA(At, 1, 1); PG8_STAGE(PG8_SA(1, 0), a3, voffA);
            PG8_BAR; PG8_WAIT_L(0); PG8_MMA(1, 0, At, B0); PG8_BAR; PG8_SCHED;
            PG8_STAGE(PG8_SB(1, 1), b3 + hstepB, voffB);
            PG8_WAIT_V(6); PG8_BAR; PG8_MMA(1, 1, At, B1); PG8_BAR;
            }
        }
        if constexpr (ALIGN_EPI) { if (wr == 0) PG8_BAR; }
        E(acc, cur, wr, wc, fr, fq);
        if (!has_next) break;
#pragma unroll
        for (int a = 0; a < 2; ++a)
#pragma unroll
            for (int b = 0; b < 2; ++b)
#pragma unroll
                for (int m = 0; m < 4; ++m)
#pragma unroll
                    for (int n = 0; n < 2; ++n) acc[a][b][m][n] = (f32x4){0.f, 0.f, 0.f, 0.f};
        cur = nxt; cA = nA; cB = nB; ++ui;
        if constexpr (ALIGN_EPI) { if (wr == 1) PG8_BAR; }
    }
    PG8_WAIT_V(0);
    if constexpr (!ALIGN_EPI) { if (wr == 0) PG8_BAR; }
    PG8_BAR;
#undef PG8_SA
#undef PG8_SB
#undef PG8_STAGE
#undef PG8_LDA
#undef PG8_LDB
#undef PG8_MMA
#undef PG8_WAIT_V
#undef PG8_WAIT_L
#undef PG8_BAR
#undef PG8_SCHED
}
}
namespace pg8 {
__device__ __forceinline__ int bsel_of(int pm) { return pm < 32 ? 0 : (pm < 64 ? 1 : 2); }

template <int ACT, bool SSQ> struct EpiBf16 {
    static constexpr bool PERM = true;
    bf16_t* O; int ldc; float* ssq; int ssq_pn0;
    __device__ __forceinline__ void operator()(const f32x4 (&acc)[2][2][4][2], const Unit& u, int wr, int wc, int fr, int fq) const {
        bf16_t* base = O + u.o + (size_t)(wr * 64 + fr) * ldc + wc * 32 + 8 * fq;
        const bool do_ssq = SSQ && (u.pn >= ssq_pn0);
#pragma unroll
        for (int ai = 0; ai < 2; ++ai)
#pragma unroll
            for (int m = 0; m < 4; ++m) { bf16_t* rowp = base + (size_t)(ai * HALF + m * 16) * ldc; float s = 0.f;
#pragma unroll
                for (int bj = 0; bj < 2; ++bj) { f32x4 v0 = acc[ai][bj][m][0], v1 = acc[ai][bj][m][1];
                    if (ACT == 1) { f32x2 a = gelu_pk((f32x2){v0[0], v0[1]}), b = gelu_pk((f32x2){v0[2], v0[3]}), c = gelu_pk((f32x2){v1[0], v1[1]}), d = gelu_pk((f32x2){v1[2], v1[3]});
                        v0 = (f32x4){a.x, a.y, b.x, b.y}; v1 = (f32x4){c.x, c.y, d.x, d.y}; }
                    if (SSQ) s += (v0[0] * v0[0] + v0[1] * v0[1]) + (v0[2] * v0[2] + v0[3] * v0[3]) + (v1[0] * v1[0] + v1[1] * v1[1]) + (v1[2] * v1[2] + v1[3] * v1[3]);
                    u32x4 w; w.x = cvt_pk_bf16(v0[0], v0[1]); w.y = cvt_pk_bf16(v0[2], v0[3]); w.z = cvt_pk_bf16(v1[0], v1[1]); w.w = cvt_pk_bf16(v1[2], v1[3]);
                    *(u32x4*)(rowp + bj * HALF) = w; }
                if (SSQ) { if (do_ssq) { s += __shfl_xor(s, 16); s += __shfl_xor(s, 32);
                    if (fq == 0) atomicAdd(ssq + u.pm * BM + ai * HALF + wr * 64 + m * 16 + fr, s); } }
            }
    }
};

struct EpiRes {
    static constexpr bool PERM = false;
    const float* rin; float* rout; const float* gmx; const float* gb;
    __device__ __forceinline__ void operator()(const f32x4 (&acc)[2][2][4][2], const Unit& u, int wr, int wc, int fr, int fq) const {
        const int bs = bsel_of(u.pm); const int col0 = u.pn * BM + wc * 32 + 4 * fq;
        f32x4 gv[2][2];
#pragma unroll
        for (int bj = 0; bj < 2; ++bj)
#pragma unroll
            for (int n = 0; n < 2; ++n) gv[bj][n] = *(const f32x4*)(gmx + bs * NADA + col0 + bj * HALF + n * 16) + *(const f32x4*)(gb + col0 + bj * HALF + n * 16);
#pragma unroll
        for (int ai = 0; ai < 2; ++ai)
#pragma unroll
            for (int m = 0; m < 4; ++m) { const size_t off = (size_t)(u.pm * BM + ai * HALF + wr * 64 + m * 16 + fr) * D + col0;
#pragma unroll
                for (int bj = 0; bj < 2; ++bj)
#pragma unroll
                    for (int n = 0; n < 2; ++n) { const f32x4 x = *(const f32x4*)(rin + off + bj * HALF + n * 16); *(f32x4*)(rout + off + bj * HALF + n * 16) = x + gv[bj][n] * acc[ai][bj][m][n]; }
                if (m & 1) asm volatile("" ::: "memory"); }
    }
};

struct EpiSwiGLU {
    static constexpr bool PERM = true;
    bf16_t* G; int ldg;
    __device__ __forceinline__ void operator()(const f32x4 (&acc)[2][2][4][2], const Unit& u, int wr, int wc, int fr, int fq) const {
        bf16_t* base = G + u.o + (size_t)(wr * 64 + fr) * ldg + wc * 16 + 4 * fq;
#pragma unroll
        for (int ai = 0; ai < 2; ++ai)
#pragma unroll
            for (int m = 0; m < 4; ++m) { bf16_t* rowp = base + (size_t)(ai * HALF + m * 16) * ldg;
#pragma unroll
                for (int bj = 0; bj < 2; ++bj) { const f32x4 g = acc[ai][bj][m][0], up = acc[ai][bj][m][1]; f32x4 o;
#pragma unroll
                    for (int e = 0; e < 4; ++e) { const float sg = __builtin_amdgcn_rcpf(1.f + __builtin_amdgcn_exp2f(-1.4426950408889634f * g[e])); o[e] = g[e] * sg * up[e]; }
                    u32x2 w; w.x = cvt_pk_bf16(o[0], o[1]); w.y = cvt_pk_bf16(o[2], o[3]);
                    *(u32x2*)(rowp + bj * 64) = w; } }
    }
};

struct SchedRC {
    const char* A; const char* B; size_t atile, btile; long ldo; int ow, nM, nN, G, c;
    __device__ __forceinline__ bool next(int i, Unit& u) const {
        const long L = (long)i * G + c; if (L >= (long)nM * nN) return false;
        int pm, pn; tile_of((int)L, nM, nN, pm, pn);
        u.a = A + (size_t)pm * atile; u.b = B + (size_t)pn * btile; u.o = (long)pm * BM * ldo + (long)pn * ow; u.pm = pm; u.pn = pn; return true;
    }
};
__device__ __forceinline__ SchedRC make_rc(const bf16_t* A, int lda, const bf16_t* B, int ldb, int nM, int nN, long ldo, int ow, int G, int c) {
    SchedRC s; s.A = (const char*)A; s.B = (const char*)B; s.atile = (size_t)BM * lda * 2; s.btile = (size_t)BM * ldb * 2; s.ldo = ldo; s.ow = ow; s.nM = nM; s.nN = nN; s.G = G; s.c = c; return s;
}
}
typedef GAS unsigned gu32;
#define RLX_AGENT __ATOMIC_RELAXED, __HIP_MEMORY_SCOPE_AGENT
#define XB_TMO      128
#define XB_XCNT(j)  (256  + 64 * (j))
#define XB_XSUB(j)  (1280 + 64 * (j))
#define XB_XGEN(j)  (2304 + 64 * (j))
#define XB_TOP      3328
#define XB_TOPGEN   3392
#define XCD_BAR_WORDS 3456
#define XB_SPIN_CAP (1u << 18)
__device__ __forceinline__ unsigned xb_ld(unsigned* p)              { return __hip_atomic_load(p, __ATOMIC_RELAXED, __HIP_MEMORY_SCOPE_AGENT); }
__device__ __forceinline__ unsigned xb_add(unsigned* p, unsigned v) { return __hip_atomic_fetch_add(p, v, __ATOMIC_RELAXED, __HIP_MEMORY_SCOPE_AGENT); }
__device__ __forceinline__ unsigned xb_xcc_id() { return (unsigned)__builtin_amdgcn_s_getreg((3 << 11) | 20) & 0xFu; }
#define XB_SPIN(cond, bar) do { unsigned _sp = 0; while (cond) { __builtin_amdgcn_s_sleep(1); \
    if ((++_sp & 255u) == 0u) { if (xb_ld(&(bar)[XB_TMO])) break; if (_sp > XB_SPIN_CAP) { atomicAdd(&(bar)[XB_TMO], 1u); break; } } } } while (0)
struct XcdBarrier { unsigned* bar; unsigned x; volatile LAS unsigned* st; };
__device__ __forceinline__ XcdBarrier xcd_barrier_post(unsigned* bar, volatile LAS unsigned* st) {
    XcdBarrier b; b.bar = bar; b.x = xb_xcc_id(); b.st = st;
    if (threadIdx.x == 0) (void)xb_add(&bar[XB_XCNT(b.x)], 1u);
    return b;
}
__device__ __forceinline__ void xcd_barrier_complete(unsigned* bar, unsigned x, unsigned& nloc, unsigned& nx) {
    const unsigned G = gridDim.x * gridDim.y * gridDim.z;
    unsigned sum, cnt, mine, sp = 0u;
    for (;;) {
        sum = 0u; cnt = 0u; mine = 0u;
#pragma unroll
        for (unsigned j = 0; j < 16; ++j) { const unsigned c = xb_ld(&bar[XB_XCNT(j)]); sum += c; cnt += (c > 0u) ? 1u : 0u; mine = (j == x) ? c : mine; }
        if (sum == G) break;
        __builtin_amdgcn_s_sleep(1);
        if ((++sp & 255u) == 0u) { if (xb_ld(&bar[XB_TMO])) break; if (sp > XB_SPIN_CAP) { atomicAdd(&bar[XB_TMO], 1u); break; } }
    }
    nloc = mine > 0u ? mine : 1u; nx = cnt > 0u ? cnt : 1u;
}
__device__ __forceinline__ void xcd_barrier(const XcdBarrier& b) {
    asm volatile("s_waitcnt vmcnt(0)" ::: "memory");
    __syncthreads();
    if (threadIdx.x == 0) {
        unsigned* bar = b.bar;
        __builtin_amdgcn_s_waitcnt(0);
        unsigned nloc = b.st[0], nx = b.st[1];
        if (nloc == 0u) { xcd_barrier_complete(bar, b.x, nloc, nx); b.st[0] = nloc; b.st[1] = nx; }
        const unsigned old = xb_add(&bar[XB_XSUB(b.x)], 1u);
        const unsigned gen = old / nloc;
        if (old + 1u == (gen + 1u) * nloc) {
            __builtin_amdgcn_fence(__ATOMIC_RELEASE, "agent");
            asm volatile("s_waitcnt vmcnt(0)" ::: "memory");
            const unsigned og = xb_add(&bar[XB_TOP], 1u);
            const unsigned tg = og / nx;
            if (og + 1u == (tg + 1u) * nx) xb_add(&bar[XB_TOPGEN], 1u);
            else XB_SPIN(xb_ld(&bar[XB_TOPGEN]) == tg, bar);
            __builtin_amdgcn_fence(__ATOMIC_ACQUIRE, "agent");
            xb_add(&bar[XB_XGEN(b.x)], 1u);
            asm volatile("s_waitcnt vmcnt(0)" ::: "memory");
        } else {
            XB_SPIN(xb_ld(&bar[XB_XGEN(b.x)]) == gen, bar);
            __builtin_amdgcn_fence(__ATOMIC_ACQUIRE, "agent");
            asm volatile("s_waitcnt vmcnt(0)" ::: "memory");
        }
    }
    __syncthreads();
}
#define LDS_WAIT() asm volatile("s_waitcnt lgkmcnt(0)" ::: "memory")
#define VM_WAIT() asm volatile("s_waitcnt vmcnt(0)" ::: "memory")
__device__ __forceinline__ float wave_sum(float v) {
#pragma unroll
    for (int o = 1; o < 64; o <<= 1) v += __shfl_xor(v, o);
    return v;
}
__device__ __forceinline__ float silu_f(float x) { return x / (1.f + __expf(-x)); }

__device__ __forceinline__ void modnorm_phase(const float* xlat, const float* xctx, float* xr_out, bf16* H, const float* g, const float* mxl, const float* bl,
                                              int which, int nrows, int gw, int NGW, int lane) {
    asm volatile("" : "+v"(lane));
    int cur_bs = -1; f32x4 gs[8], sh[8];
    const int csh = (which * 3) * D, csc = (which * 3 + 1) * D;
    for (int row = gw; row < nrows; row += NGW) {
        const int bs = row < SEQ ? 0 : (row < ML ? 1 : 2);
        if (bs != cur_bs) {
#pragma unroll
            for (int j = 0; j < 8; ++j) { const int col = 4 * lane + 256 * j;
                const f32x4 gg = *(const f32x4*)(g + col);
                const f32x4 sc = *(const f32x4*)(mxl + bs * NADA + csc + col) + *(const f32x4*)(bl + csc + col);
                sh[j] = *(const f32x4*)(mxl + bs * NADA + csh + col) + *(const f32x4*)(bl + csh + col);
                gs[j] = gg * (sc + 1.0f); }
            cur_bs = bs;
        }
        const float* src = row < ML ? xlat + (size_t)row * D : xctx + (size_t)(row - ML) * D;
        f32x4 v[8]; float s = 0.f;
#pragma unroll
        for (int j = 0; j < 8; ++j) { v[j] = *(const f32x4*)(src + 4 * lane + 256 * j); s += (v[j].x * v[j].x + v[j].y * v[j].y) + (v[j].z * v[j].z + v[j].w * v[j].w); }
        const float r = 1.0f / sqrtf(wave_sum(s) * (1.0f / D) + EPS);
        bf16* hrow = H + (size_t)row * D;
#pragma unroll
        for (int j = 0; j < 8; ++j) { const f32x4 o = v[j] * r * gs[j] + sh[j]; u32x2 w; w.x = cvt_pk_bf16(o.x, o.y); w.y = cvt_pk_bf16(o.z, o.w);
            *(u32x2*)(hrow + 4 * lane + 256 * j) = w; }
        if (xr_out) {
#pragma unroll
            for (int j = 0; j < 8; ++j) *(f32x4*)(xr_out + (size_t)row * D + 4 * lane + 256 * j) = v[j];
        }
    }
}

__device__ __forceinline__ void qknorm_rope_phase(bf16* QKV, const float* qg, const float* kg, const f32x2* rope, int nrows, int gw, int NGW, int lane) {
    asm volatile("" : "+v"(lane));
    const int hl = lane >> 4, dl = (lane & 15) * 8;
    for (int row = gw; row < nrows; row += NGW) {
        bf16* rp = QKV + (size_t)row * NQKV;
        const bool lat = row < ML; const int t = row & (SEQ - 1);
#pragma unroll
        for (int it = 0; it < 5; ++it) {
            const int head = it * 4 + hl; bf16* p = rp + head * HD + dl;
            const u32x4 raw = *(const u32x4*)p; float v[8];
#pragma unroll
            for (int e = 0; e < 4; ++e) { v[2 * e] = __uint_as_float(raw[e] << 16); v[2 * e + 1] = __uint_as_float(raw[e] & 0xffff0000u); }
            float s = 0.f;
#pragma unroll
            for (int e = 0; e < 8; ++e) s += v[e] * v[e];
            s += __shfl_xor(s, 1); s += __shfl_xor(s, 2); s += __shfl_xor(s, 4); s += __shfl_xor(s, 8);
            const float r = 1.0f / sqrtf(s * (1.0f / HD) + EPS);
            const float* gp = (it < 4 ? qg : kg) + dl;
            const f32x4 g0 = *(const f32x4*)gp, g1 = *(const f32x4*)(gp + 4);
#pragma unroll
            for (int e = 0; e < 4; ++e) { v[e] *= r * g0[e]; v[4 + e] *= r * g1[e]; }
            float o[8];
            if (lat) {
                const f32x2* cs = rope + (size_t)t * 64 + (dl & 63);
#pragma unroll
                for (int e = 0; e < 8; ++e) { const float pr = __shfl_xor(v[e], 8); const f32x2 c = cs[e]; o[e] = v[e] * c.x + ((lane & 8) ? pr : -pr) * c.y; }
            } else {
#pragma unroll
                for (int e = 0; e < 8; ++e) o[e] = v[e];
            }
            u32x4 w; w.x = cvt_pk_bf16(o[0], o[1]); w.y = cvt_pk_bf16(o[2], o[3]); w.z = cvt_pk_bf16(o[4], o[5]); w.w = cvt_pk_bf16(o[6], o[7]);
            *(u32x4*)p = w;
        }
    }
}

__device__ __forceinline__ int dst_row_map(int n, int mode) { return mode == 0 ? n : ((n >> 2) * 8 + (n & 3) + (mode == 2 ? 4 : 0)); }
__device__ __forceinline__ void transpose_item(const float* W, int K, int N, bf16* WT, int mode, LAS float* scr, int item, int lane) {
    const int nblk = N / 32, kb = item / nblk, nb = item % nblk, k0 = 64 * kb, n0 = 32 * nb;
    const int lr = lane >> 3, lc = (lane & 7) * 4;
    f32x4 t[8];
#pragma unroll
    for (int i = 0; i < 8; ++i) t[i] = *(const f32x4*)(W + (size_t)(k0 + 8 * i + lr) * N + n0 + lc);
#pragma unroll
    for (int i = 0; i < 8; ++i) { LAS float* s = scr + (8 * i + lr) * 33 + lc; s[0] = t[i].x; s[1] = t[i].y; s[2] = t[i].z; s[3] = t[i].w; }
    LDS_WAIT(); asm volatile("" ::: "memory");
    const int c = lane & 7;
#pragma unroll
    for (int j = 0; j < 4; ++j) { const int n = (lane >> 3) + 8 * j; const LAS float* s = scr + (8 * c) * 33 + n;
        u32x4 o; o.x = cvt_pk_bf16(s[0 * 33], s[1 * 33]); o.y = cvt_pk_bf16(s[2 * 33], s[3 * 33]); o.z = cvt_pk_bf16(s[4 * 33], s[5 * 33]); o.w = cvt_pk_bf16(s[6 * 33], s[7 * 33]);
        *(u32x4*)(WT + (size_t)dst_row_map(n0 + n, mode) * K + k0 + 8 * c) = o; }
    LDS_WAIT(); asm volatile("" ::: "memory");
}
struct TrJob { const float* W; bf16* WT; int K, N, mode, nitems; };
struct KArgs { const float* in[21]; float* out; unsigned char* ws; int ph_lo, ph_hi; };
enum { I_X = 0, I_C, I_CTX, I_CCTX, I_WADA, I_BADA, I_NORMG, I_WG, I_WU, I_WD, I_WQKV, I_WO, I_QG, I_KG, I_SINK, I_WF, I_WSI, I_SVG, I_WSS, I_BSS, I_WSOUT };
constexpr int CW_QUEUE = 64;
constexpr int TR_FFN = 5632, TR_TOTAL = 98304, IT_F = 16384, IT_DC = 256, IT_FC = 256, IT_ROPE = 1024, IT_TOTAL = TR_TOTAL + IT_F + IT_DC + IT_FC + IT_ROPE;
constexpr float F_SCALE_LAT = 0.00069053396600248786f;
constexpr float F_SCALE_CTX = 0.00390625f;

__device__ __forceinline__ void prologue_item(const KArgs& a, int r, LAS float* scr, int lane) {
    unsigned char* ws = a.ws;
    if (r < TR_TOTAL) {
        if (r < 12 * TR_FFN) { const int kind = r / (4 * TR_FFN), l = (r / TR_FFN) & 3, it = r % TR_FFN;
            if (kind == 0)      transpose_item(a.in[I_WG] + (size_t)l * D * DFF, D, DFF, (bf16*)(ws + WS_WGU + (size_t)l * 44 * MiB), 1, scr, it, lane);
            else if (kind == 1) transpose_item(a.in[I_WU] + (size_t)l * D * DFF, D, DFF, (bf16*)(ws + WS_WGU + (size_t)l * 44 * MiB), 2, scr, it, lane);
            else                transpose_item(a.in[I_WD] + (size_t)l * DFF * D, DFF, D, (bf16*)(ws + WS_WDN + (size_t)l * 22 * MiB), 0, scr, it, lane);
            return; }
        r -= 12 * TR_FFN;
        if (r < 6144) { const int j = r / 3072; transpose_item(a.in[I_WQKV] + (size_t)j * D * NQKV, D, NQKV, (bf16*)(ws + WS_WQKV + (size_t)j * 12 * MiB), 0, scr, r % 3072, lane); return; }
        r -= 6144;
        if (r < 4096) { const int j = r / 2048; transpose_item(a.in[I_WO] + (size_t)j * HQ * D, HQ, D, (bf16*)(ws + WS_WO + (size_t)j * 8 * MiB), 0, scr, r % 2048, lane); return; }
        r -= 4096;
        if (r < 2048) { transpose_item(a.in[I_WF], D, D, (bf16*)(ws + WS_WF), 0, scr, r, lane); return; }
        r -= 2048;
        if (r < 12288) { transpose_item(a.in[I_WSI], D, 2 * SGH, (bf16*)(ws + WS_WSI), 0, scr, r, lane); return; }
        r -= 12288;
        transpose_item(a.in[I_WSOUT], SGH, D, (bf16*)(ws + WS_WSO), 0, scr, r, lane); return;
    }
    r -= TR_TOTAL;
    if (r < IT_F) {
        const int k = r >> 1, reim = r & 1; bf16* dst = (bf16*)(ws + WS_AR + AR_F) + (size_t)k * 16384 + reim * 8192;
        for (int it = 0; it < 16; ++it) { const int t0 = it * 512 + lane * 8; float v[8];
#pragma unroll
            for (int e = 0; e < 8; ++e) { const int idx = ((k * (t0 + e)) + reim * 2048) & 8191; v[e] = F_SCALE_LAT * __builtin_amdgcn_cosf((float)idx * (1.0f / 8192.0f)); }
            u32x4 w; w.x = cvt_pk_bf16(v[0], v[1]); w.y = cvt_pk_bf16(v[2], v[3]); w.z = cvt_pk_bf16(v[4], v[5]); w.w = cvt_pk_bf16(v[6], v[7]);
            *(u32x4*)(dst + t0) = w; }
        return; }
    r -= IT_F;
    if (r < IT_DC) {
        const int e0 = r * 512 + lane * 8, row = e0 >> 8, c0 = e0 & 255, m = row & 255, reim = row >> 8; float v[8];
#pragma unroll
        for (int e = 0; e < 8; ++e) { const float fr = (float)((m * (c0 + e)) & 255) * (1.0f / 256.0f); v[e] = reim ? __builtin_amdgcn_sinf(fr) : __builtin_amdgcn_cosf(fr); }
        u32x4 w; w.x = cvt_pk_bf16(v[0], v[1]); w.y = cvt_pk_bf16(v[2], v[3]); w.z = cvt_pk_bf16(v[4], v[5]); w.w = cvt_pk_bf16(v[6], v[7]);
        *(u32x4*)((bf16*)(ws + WS_DC2) + e0) = w; return; }
    r -= IT_DC;
    if (r < IT_FC) {
        const int e0 = r * 512 + lane * 8, k = e0 >> 9, c0 = e0 & 511, reim = c0 >> 8, l0 = c0 & 255; float v[8];
#pragma unroll
        for (int e = 0; e < 8; ++e) { const int idx = ((k * (l0 + e)) + reim * 64) & 255; v[e] = F_SCALE_CTX * __builtin_amdgcn_cosf((float)idx * (1.0f / 256.0f)); }
        u32x4 w; w.x = cvt_pk_bf16(v[0], v[1]); w.y = cvt_pk_bf16(v[2], v[3]); w.z = cvt_pk_bf16(v[4], v[5]); w.w = cvt_pk_bf16(v[6], v[7]);
        *(u32x4*)((bf16*)(ws + WS_FC) + e0) = w; return; }
    r -= IT_FC;
    {
        f32x2* dst = (f32x2*)(ws + WS_ROPE) + (size_t)r * 512 + lane * 8;
#pragma unroll
        for (int e = 0; e < 8; ++e) { const int idx = r * 512 + lane * 8 + e, t = idx >> 6, f = idx & 63;
            const float inv = __builtin_amdgcn_exp2f(-(float)(f & 31) * (13.287712379549449f / 32.0f));
            const float ang = (float)(f < 32 ? (t >> 6) : (t & 63)) * inv, rev = ang * 0.15915494309189535f;
            dst[e] = (f32x2){__builtin_amdgcn_cosf(rev), __builtin_amdgcn_sinf(rev)}; }
    }
}

__device__ __forceinline__ void prologue_phase(const KArgs& a, LAS unsigned char* lds, gu32* ctl, int tid, int lane, int wave) {
    asm volatile("" : "+v"(tid), "+v"(lane));
    if (blockIdx.x < 192) {
        const int l = blockIdx.x / 48, jb = blockIdx.x % 48;
        LAS float* sl = (LAS float*)lds;
        LAS float* part = (LAS float*)(lds + 24576);
        for (int i = tid; i < 3 * D; i += 512) { const int r = i / D, k = i % D; const float cv = r < 2 ? a.in[I_C][r * D + k] : a.in[I_CCTX][k]; sl[i] = silu_f(cv); }
        __syncthreads();
        const float* wp = a.in[I_WADA] + ((size_t)l * D + wave * 256) * NADA + jb * 256 + 4 * lane;
        f32x4 a0 = {0.f, 0.f, 0.f, 0.f}, a1 = a0, a2 = a0;
        for (int k = 0; k < 256; k += 8) { f32x4 w[8];
#pragma unroll
            for (int e = 0; e < 8; ++e) w[e] = *(const f32x4*)(wp + (size_t)(k + e) * NADA);
#pragma unroll
            for (int e = 0; e < 8; ++e) { const int kk = wave * 256 + k + e; a0 += w[e] * sl[kk]; a1 += w[e] * sl[D + kk]; a2 += w[e] * sl[2 * D + kk]; } }
        *(LAS f32x4*)(part + (wave * 3 + 0) * 256 + 4 * lane) = a0; *(LAS f32x4*)(part + (wave * 3 + 1) * 256 + 4 * lane) = a1; *(LAS f32x4*)(part + (wave * 3 + 2) * 256 + 4 * lane) = a2;
        __syncthreads();
        for (int i = tid; i < 768; i += 512) { const int r = i >> 8, j = i & 255; float s = 0.f;
#pragma unroll
            for (int w = 0; w < 8; ++w) s += part[(w * 3 + r) * 256 + j];
            ((float*)(a.ws + WS_MX))[((size_t)l * 3 + r) * NADA + jb * 256 + j] = s; }
        __syncthreads();
    }
    LAS float* scr = (LAS float*)(lds + wave * 16384);
    for (;;) {
        unsigned base = 0; if (lane == 0) base = __hip_atomic_fetch_add((unsigned*)(ctl + CW_QUEUE), 8u, RLX_AGENT);
        base = (unsigned)__builtin_amdgcn_readfirstlane((int)base);
        if (base >= (unsigned)IT_TOTAL) break;
        for (int i = 0; i < 8; ++i) { const int it = (int)base + i; if (it < IT_TOTAL) prologue_item(a, it, scr, lane); }
    }
}
namespace attn {
constexpr float SCALE = 0.08838834764831845f;
constexpr float THR = 8.f;
constexpr int SHM_K = 64 * 128 * 2, SHM_V = 64 * 128 * 2;
constexpr int OFF_V = 0, OFF_K = 2 * SHM_V, OFF_WS = 2 * SHM_V + 2 * SHM_K, LDS_BYTES = OFF_WS + 8 * 64 * 4;
#define KSWZ(row, colB) ((row) * 256 + ((colB) ^ (((row) & 7) << 4)))
#define SBAR() __builtin_amdgcn_sched_barrier(0)
__device__ __forceinline__ int v_st(int k, int c) { const int kk = (k & ~0xC) | ((k & 4) << 1) | ((k & 8) >> 1); return ((kk >> 3) * 4 + (c >> 5)) * 512 + ((kk & 7) * 32 + (c & 31)) * 2; }
__device__ __forceinline__ int v_rd_base(int lane) { return ((lane & 3) << 3) | (((lane >> 2) & 3) << 6) | (((lane >> 4) & 1) << 5) | (((lane >> 5) & 1) << 8); }
__device__ __forceinline__ int crow(int r, int hi) { return (r & 3) + 8 * (r >> 2) + 4 * hi; }
__device__ __forceinline__ void mask_tile(f32x16& p0, f32x16& p1, int dq, unsigned W) {
    const float NEG = -__builtin_inff();
#pragma unroll
    for (int r = 0; r < 16; ++r) { const int c = (r & 3) + 8 * (r >> 2);
        if ((unsigned)(dq - c) >= W) p0[r] = NEG;
        if ((unsigned)(dq - c - 32) >= W) p1[r] = NEG; }
}
__device__ __forceinline__ void partialSM(f32x16& p0, f32x16& p1, float& m_reg, float& mn, float& alpha) {
    float pmax = p0[0];
#pragma unroll
    for (int r = 1; r < 16; ++r) pmax = fmaxf(pmax, p0[r]);
#pragma unroll
    for (int r = 0; r < 16; ++r) pmax = fmaxf(pmax, p1[r]);
    { auto rr = __builtin_amdgcn_permlane32_swap(__float_as_uint(pmax), __float_as_uint(pmax), false, false);
      pmax = fmaxf(__uint_as_float(rr[0]), __uint_as_float(rr[1])); }
    constexpr float C2 = 1.4426950408889634f * SCALE;
    if (__builtin_expect(__all((pmax - m_reg) * SCALE <= THR), 1)) { mn = m_reg; alpha = 1.f; }
    else { mn = fmaxf(m_reg, pmax); alpha = __builtin_amdgcn_exp2f((m_reg - mn) * C2); m_reg = mn; }
    const float mnL = -mn * C2;
#pragma unroll
    for (int r = 0; r < 16; ++r) p0[r] = fmaf(p0[r], C2, mnL);
#pragma unroll
    for (int r = 0; r < 16; ++r) p1[r] = fmaf(p1[r], C2, mnL);
#pragma unroll
    for (int r = 0; r < 16; ++r) p0[r] = __builtin_amdgcn_exp2f(p0[r]);
}
__device__ __forceinline__ void finishSM(f32x16& p0, f32x16& p1, float alpha, float& l_reg, bf16x8& pa0, bf16x8& pa1, bf16x8& pa2, bf16x8& pa3) {
#pragma unroll
    for (int r = 0; r < 16; ++r) p1[r] = __builtin_amdgcn_exp2f(p1[r]);
    float ps = 0;
#pragma unroll
    for (int r = 0; r < 16; ++r) ps += p0[r];
#pragma unroll
    for (int r = 0; r < 16; ++r) ps += p1[r];
    { auto rr = __builtin_amdgcn_permlane32_swap(__float_as_uint(ps), __float_as_uint(ps), false, false);
      ps = __uint_as_float(rr[0]) + __uint_as_float(rr[1]); }
    l_reg = l_reg * alpha + ps;
#define PK4(P, B_, OUT) do { unsigned a0 = cvt_pk_bf16(P[B_+0], P[B_+1]), a1 = cvt_pk_bf16(P[B_+2], P[B_+3]);                          \
        unsigned b0 = cvt_pk_bf16(P[B_+4], P[B_+5]), b1 = cvt_pk_bf16(P[B_+6], P[B_+7]);                                             \
        auto r0 = __builtin_amdgcn_permlane32_swap(a0, b0, false, false); auto r1 = __builtin_amdgcn_permlane32_swap(a1, b1, false, false); \
        u32x4 w = {r0[0], r1[0], r0[1], r1[1]}; OUT = *reinterpret_cast<bf16x8*>(&w); } while (0)
    PK4(p0, 0, pa0); PK4(p0, 8, pa1); PK4(p1, 0, pa2); PK4(p1, 8, pa3);
#undef PK4
}
template <int KB>
__device__ __forceinline__ void qkt(f32x16& p0, f32x16& p1, const char* K_lds, int r32, int hi, const bf16x8* qr) {
    p0 = f32x16{}; p1 = f32x16{};
    const char* kb[4];
#pragma unroll
    for (int dd = 0; dd < 4; ++dd) kb[dd] = K_lds + KB * SHM_K + KSWZ(r32, (dd * 16 + hi * 8) * 2);
#pragma unroll
    for (int d0 = 0; d0 < 8; ++d0) { const char* a = kb[d0 & 3] + (d0 >> 2) * 128;
        bf16x8 b0 = *reinterpret_cast<const bf16x8*>(a);
        bf16x8 b1 = *reinterpret_cast<const bf16x8*>(a + 32 * 256);
        p0 = __builtin_amdgcn_mfma_f32_32x32x16_bf16(b0, qr[d0], p0, 0, 0, 0);
        p1 = __builtin_amdgcn_mfma_f32_32x32x16_bf16(b1, qr[d0], p1, 0, 0, 0); }
}
#define TRRD(dst, off) asm volatile("ds_read_b64_tr_b16 %0, %1 offset:%2" : "=&v"(dst) : "v"(vb0), "i"(off) : "memory")
#define PV_D0(oacc, vbuf, d0, pa0, pa1, pa2, pa3) do { s16x4 l0, l1, l2, l3, h0, h1, h2, h3; constexpr int b_ = (vbuf) + (d0) * 512; \
        TRRD(l0, b_); TRRD(h0, b_ + 2048); TRRD(l1, b_ + 4096); TRRD(h1, b_ + 6144); TRRD(l2, b_ + 8192); TRRD(h2, b_ + 10240); TRRD(l3, b_ + 12288); TRRD(h3, b_ + 14336); \
        asm volatile("s_waitcnt lgkmcnt(0)" ::: "memory"); SBAR(); \
        oacc = __builtin_amdgcn_mfma_f32_32x32x16_bf16(pa0, (bf16x8){l0[0], l0[1], l0[2], l0[3], h0[0], h0[1], h0[2], h0[3]}, oacc, 0, 0, 0);   \
        oacc = __builtin_amdgcn_mfma_f32_32x32x16_bf16(pa1, (bf16x8){l1[0], l1[1], l1[2], l1[3], h1[0], h1[1], h1[2], h1[3]}, oacc, 0, 0, 0);   \
        oacc = __builtin_amdgcn_mfma_f32_32x32x16_bf16(pa2, (bf16x8){l2[0], l2[1], l2[2], l2[3], h2[0], h2[1], h2[2], h2[3]}, oacc, 0, 0, 0);   \
        oacc = __builtin_amdgcn_mfma_f32_32x32x16_bf16(pa3, (bf16x8){l3[0], l3[1], l3[2], l3[3], h3[0], h3[1], h3[2], h3[3]}, oacc, 0, 0, 0); } while (0)
template <int VB>
__device__ __forceinline__ void pv_tile(f32x16* o, int vb0, bf16x8 pa0, bf16x8 pa1, bf16x8 pa2, bf16x8 pa3) {
    PV_D0(o[0], VB * SHM_V, 0, pa0, pa1, pa2, pa3); PV_D0(o[1], VB * SHM_V, 1, pa0, pa1, pa2, pa3);
    PV_D0(o[2], VB * SHM_V, 2, pa0, pa1, pa2, pa3); PV_D0(o[3], VB * SHM_V, 3, pa0, pa1, pa2, pa3);
}

struct AUnit { int qrow0, klat0, kctx0, kh, tb; };

__device__ __forceinline__ void attn_unit(const bf16* QKV, bf16* AO, const float* sink, const AUnit u, char* lds) {
    int tid = threadIdx.x; asm volatile("" : "+v"(tid));
    const int wid = __builtin_amdgcn_readfirstlane(tid >> 6), lane = tid & 63, r32 = lane & 31, hi = lane >> 5;
    const int hq = u.kh * 4 + (wid >> 1), half = wid & 1;
    char* V_lds = lds + OFF_V; char* K_lds = lds + OFF_K;
    float* wsc = (float*)(lds + OFF_WS) + wid * 64; float* li_l = wsc; float* al_l = wsc + 32;
    const int sr = tid >> 4, sc = (tid & 15) * 8, vst0 = v_st(sr, sc), vst1 = v_st(32 + sr, sc), kws = KSWZ(sr, sc * 2);
    const int vb0 = (int)(uintptr_t)V_lds + v_rd_base(lane);
    int jlo = 0, nwin = 0;
    if (u.tb >= 0) { jlo = u.tb - 2 < 0 ? 0 : u.tb - 2; const int jhi = u.tb + 2 > SEQ / 64 - 1 ? SEQ / 64 - 1 : u.tb + 2; nwin = jhi - jlo + 1; }
    const int NT = 4 + nwin;
    const bf16* kvbase = QKV + HQ + u.kh * HD + sc;
    bf16x8 st_k0, st_k1, st_v0, st_v1;
#define A_KROW(t) ((t) < 4 ? u.kctx0 + 64 * (t) : u.klat0 + 64 * (jlo + (t) - 4))
#define A_LOAD(t) do { const bf16* p_ = kvbase + (size_t)(A_KROW(t) + sr) * NQKV; st_k0 = *(const bf16x8*)p_; st_k1 = *(const bf16x8*)(p_ + (size_t)32 * NQKV); \
                       st_v0 = *(const bf16x8*)(p_ + HKV); st_v1 = *(const bf16x8*)(p_ + (size_t)32 * NQKV + HKV); } while (0)
#define A_WRITE(bf) do { *(bf16x8*)(K_lds + (bf) * SHM_K + kws) = st_k0; *(bf16x8*)(K_lds + (bf) * SHM_K + kws + 32 * 256) = st_k1; \
                         *(bf16x8*)(V_lds + (bf) * SHM_V + vst0) = st_v0; *(bf16x8*)(V_lds + (bf) * SHM_V + vst1) = st_v1; } while (0)
    A_LOAD(0);
    bf16x8 qr[8];
    { const bf16* qp = QKV + (size_t)(u.qrow0 + 32 * half + r32) * NQKV + hq * HD + hi * 8;
#pragma unroll
      for (int d0 = 0; d0 < 8; ++d0) qr[d0] = *(const bf16x8*)(qp + d0 * 16); }
    float m_reg = sink[hq] * (1.0f / SCALE), l_reg = 1.0f; f32x16 o[4] = {};
    const int qpos128 = 64 * u.tb + 32 * half + r32 + 128 - 4 * hi;
    VM_WAIT(); A_WRITE(0);
    __syncthreads();
#define A_RESC(a) do { if (__any((a) < 1.f)) { if (hi == 0) al_l[r32] = (a); asm volatile("s_waitcnt lgkmcnt(0)" ::: "memory");              \
                     _Pragma("unroll") for (int d_ = 0; d_ < 4; ++d_) _Pragma("unroll") for (int r = 0; r < 16; ++r) o[d_][r] *= al_l[crow(r, hi)]; } } while (0)
#define A_COMPUTE(BUF, t) do { f32x16 p0, p1; float mn, alpha; bf16x8 pa0, pa1, pa2, pa3; \
        qkt<BUF>(p0, p1, K_lds, r32, hi, qr); \
        if ((t) >= 4) { const int blk = jlo + (t) - 4; if (blk == u.tb - 2 || blk == u.tb + 2) mask_tile(p0, p1, qpos128 - 64 * blk, 257u); } \
        partialSM(p0, p1, m_reg, mn, alpha); A_RESC(alpha); finishSM(p0, p1, alpha, l_reg, pa0, pa1, pa2, pa3); SBAR(); \
        pv_tile<BUF>(o, vb0, pa0, pa1, pa2, pa3); } while (0)
    for (int t = 0; t < NT; t += 2) {
        if (t + 1 < NT) A_LOAD(t + 1);
        A_COMPUTE(0, t);
        if (t + 1 < NT) { VM_WAIT(); A_WRITE(1); }
        __syncthreads();
        if (t + 1 >= NT) break;
        if (t + 2 < NT) A_LOAD(t + 2);
        A_COMPUTE(1, t + 1);
        if (t + 2 < NT) { VM_WAIT(); A_WRITE(0); }
        __syncthreads();
    }
    if (hi == 0) li_l[r32] = l_reg; asm volatile("s_waitcnt lgkmcnt(0)" ::: "memory");
    bf16* Ow = AO + (size_t)(u.qrow0 + 32 * half) * D + hq * HD;
#pragma unroll
    for (int r = 0; r < 16; ++r) { const int orow = crow(r, hi); const float rl = __builtin_amdgcn_rcpf(li_l[orow]);
#pragma unroll
        for (int d0 = 0; d0 < 4; ++d0) { const float v = o[d0][r] * rl; const float vn = __shfl_xor(v, 1);
            if ((r32 & 1) == 0) *(unsigned*)(Ow + (size_t)orow * D + d0 * 32 + r32) = cvt_pk_bf16(v, vn); } }
    asm volatile("s_waitcnt lgkmcnt(0)" ::: "memory");
    __syncthreads();
#undef A_KROW
#undef A_LOAD
#undef A_WRITE
#undef A_RESC
#undef A_COMPUTE
}

__device__ __forceinline__ void attn_phase(const bf16* QKV, bf16* AO, const float* sink, bool with_ctx, int vcu, int G, char* lds) {
    for (int uid = vcu * 4; uid < 1024; uid += G * 4) {
        for (int i = 0; i < 4; ++i) { const int id = uid + i, bk = id >> 7, b = bk >> 2; AUnit u; u.kh = bk & 3; u.tb = id & 127;
            u.qrow0 = b * SEQ + 64 * u.tb; u.klat0 = b * SEQ; u.kctx0 = ML + b * CTXL; attn_unit(QKV, AO, sink, u, lds); }
    }
    if (with_ctx) for (int id = vcu; id < 32; id += G) { AUnit u; const int b = id >> 4; u.kh = (id >> 2) & 3; u.tb = -1; u.qrow0 = ML + b * CTXL + 64 * (id & 3); u.klat0 = 0; u.kctx0 = ML + b * CTXL;
        attn_unit(QKV, AO, sink, u, lds); }
}

__device__ __forceinline__ void sgu_unit(bf16* Z, const float* ssq, const float* wsp, const float* bsp, const float* gvv, int chunk, int g, char* lds) {
    int tid = threadIdx.x; asm volatile("" : "+v"(tid));
    const int wid = __builtin_amdgcn_readfirstlane(tid >> 6), lane = tid & 63, r32 = lane & 31, hi = lane >> 5;
    const int pb = wid & 3, dh = wid >> 2, R0 = chunk * 128;
    char* V_lds = lds;
    const int sr = tid >> 4, sc = (tid & 15) * 8, vst0 = v_st(sr, sc), vst1 = v_st(32 + sr, sc);
    const int vb0 = (int)(uintptr_t)V_lds + v_rd_base(lane);
    bf16x8 pa[8];
    { const float* wrow = wsp + ((size_t)(g * 128 + pb * 32 + r32)) * 128 + 8 * hi; const float* sq = ssq + R0 + 8 * hi;
#pragma unroll
      for (int ks = 0; ks < 8; ++ks) { const f32x4 w0 = *(const f32x4*)(wrow + ks * 16), w1 = *(const f32x4*)(wrow + ks * 16 + 4); const f32x4 s0 = *(const f32x4*)(sq + ks * 16), s1 = *(const f32x4*)(sq + ks * 16 + 4);
          float v[8];
#pragma unroll
          for (int e = 0; e < 4; ++e) { v[e] = w0[e] / sqrtf(s0[e] * (1.0f / SGH) + EPS); v[4 + e] = w1[e] / sqrtf(s1[e] * (1.0f / SGH) + EPS); }
          u32x4 w; w.x = cvt_pk_bf16(v[0], v[1]); w.y = cvt_pk_bf16(v[2], v[3]); w.z = cvt_pk_bf16(v[4], v[5]); w.w = cvt_pk_bf16(v[6], v[7]); pa[ks] = *reinterpret_cast<bf16x8*>(&w); } }
    float bias[16];
#pragma unroll
    for (int r = 0; r < 16; ++r) bias[r] = bsp[g * 128 + pb * 32 + crow(r, hi)];
    const bf16* vsrc = Z + (size_t)(R0 + sr) * (2 * SGH) + SGH + g * SGG + sc;
    bf16x8 s00, s01, s10, s11;
#define S_LOAD(db) do { const bf16* p_ = vsrc + (db) * 128; s00 = *(const bf16x8*)p_; s01 = *(const bf16x8*)(p_ + (size_t)32 * 2 * SGH); \
                        s10 = *(const bf16x8*)(p_ + (size_t)64 * 2 * SGH); s11 = *(const bf16x8*)(p_ + (size_t)96 * 2 * SGH); } while (0)
#define S_WRITE() do { *(bf16x8*)(V_lds + vst0) = s00; *(bf16x8*)(V_lds + vst1) = s01; *(bf16x8*)(V_lds + SHM_V + vst0) = s10; *(bf16x8*)(V_lds + SHM_V + vst1) = s11; } while (0)
    S_LOAD(0);
    for (int db = 0; db < 6; ++db) {
        VM_WAIT(); S_WRITE();
        __syncthreads();
        if (db + 1 < 6) S_LOAD(db + 1);
        f32x16 o0 = {}, o1 = {};
        if (dh == 0) { PV_D0(o0, 0, 0, pa[0], pa[1], pa[2], pa[3]); PV_D0(o0, SHM_V, 0, pa[4], pa[5], pa[6], pa[7]); PV_D0(o1, 0, 1, pa[0], pa[1], pa[2], pa[3]); PV_D0(o1, SHM_V, 1, pa[4], pa[5], pa[6], pa[7]); }
        else         { PV_D0(o0, 0, 2, pa[0], pa[1], pa[2], pa[3]); PV_D0(o0, SHM_V, 2, pa[4], pa[5], pa[6], pa[7]); PV_D0(o1, 0, 3, pa[0], pa[1], pa[2], pa[3]); PV_D0(o1, SHM_V, 3, pa[4], pa[5], pa[6], pa[7]); }
        const int colb = g * SGG + db * 128 + dh * 64 + r32; const float gv0 = gvv[colb], gv1 = gvv[colb + 32];
        bf16* up = Z + (size_t)(R0 + pb * 32) * (2 * SGH) + colb;
#pragma unroll
        for (int r = 0; r < 16; ++r) { const int p = crow(r, hi); const float t0 = gv0 * o0[r] + bias[r], t1 = gv1 * o1[r] + bias[r];
            const float t0n = __shfl_xor(t0, 1), t1n = __shfl_xor(t1, 1);
            if ((r32 & 1) == 0) { unsigned* q0 = (unsigned*)(up + (size_t)p * (2 * SGH)); unsigned* q1 = (unsigned*)(up + (size_t)p * (2 * SGH) + 32);
                const unsigned ua = *q0, ub = *q1;
                *q0 = cvt_pk_bf16(__uint_as_float(ua << 16) * t0, __uint_as_float(ua & 0xffff0000u) * t0n);
                *q1 = cvt_pk_bf16(__uint_as_float(ub << 16) * t1, __uint_as_float(ub & 0xffff0000u) * t1n); } }
        __syncthreads();
    }
#undef S_LOAD
#undef S_WRITE
}
#undef TRRD
}
constexpr int NWAVES = 8;
constexpr int RING_BYTES = 131072, LDSCTL_OFF = RING_BYTES, LDS_BYTES = 147456;
constexpr int NPH = 31;

struct Ctx { KArgs a; LAS unsigned char* lds; gu32* ctl; XcdBarrier bar; int tid, lane, wave, vcu, G, gw, NGW, lo, hi; };
#define PH_IN(k) (C.lo <= (k) && (k) < C.hi)
#define PH_SEAM(k) do { if (!MK_PER_PHASE && (k) + 1 < C.hi) xcd_barrier(C.bar); } while (0)
#define WSP(T, off) ((T*)(C.a.ws + (off)))

struct SchedF {
    const char* A; const char* B; int mode, G, c;
    __device__ __forceinline__ bool next(int i, pg8::Unit& u) const {
        const int L = i * G + c; u.pm = 0; u.pn = 0;
        if (mode == 0) { if (L >= 1024) return false; const int b = L >> 9, rem = L & 511, gr = rem >> 5, tt = rem & 31, g = gr >> 1, reim = gr & 1;
            u.a = A + (size_t)reim * 256 * 256 * 2; u.b = B + ((size_t)(b * SEQ + tt * 256) * D + g * 256) * 2; u.o = (long)(b * D + g * 256) * 16384 + reim * 8192 + tt * 256; return true; }
        if (mode == 1) { if (L >= 32) return false; const int b = L >> 4, gr = L & 15, g = gr >> 1, reim = gr & 1;
            u.a = A + (size_t)reim * 256 * 256 * 2; u.b = B + ((size_t)(ML + b * CTXL) * D + g * 256) * 2; u.o = (long)(b * D + g * 256) * 512 + reim * 256; return true; }
        if (mode == 2) { if (L >= 512) return false; const int b = L >> 8; int pm, pn; pg8::tile_of(L & 255, 32, 8, pm, pn);
            u.a = A + (size_t)pm * 256 * 16384 * 2; u.b = B + (size_t)(b * D + pn * 256) * 16384 * 2; u.o = (long)(b * SEQ + pm * 256) * D + pn * 256; return true; }
        if (L >= 16) return false; { const int b = L >> 3, pn = L & 7;
            u.a = A; u.b = B + (size_t)(b * D + pn * 256) * 512 * 2; u.o = (long)(ML + b * CTXL) * D + pn * 256; return true; }
    }
};

template <int PH0> __device__ __forceinline__ void ffn_block(Ctx& C, int l, int nM) {
    const float* mxl = WSP(const float, WS_MX) + (size_t)l * 3 * NADA; const float* bl = C.a.in[I_BADA] + (size_t)l * NADA;
    float* XR = WSP(float, WS_XR); bf16* H = WSP(bf16, WS_H); bf16* Gb = WSP(bf16, WS_AR + AR_G);
    if (PH_IN(PH0)) { modnorm_phase(XR, XR + (size_t)ML * D, nullptr, H, C.a.in[I_NORMG] + (size_t)(l * 2 + 1) * D, mxl, bl, 1, nM * 256, C.gw, C.NGW, C.lane); PH_SEAM(PH0); }
    if (PH_IN(PH0 + 1)) { const pg8::SchedRC S = pg8::make_rc(H, D, WSP(const bf16, WS_WGU + (size_t)l * 44 * MiB), D, nM, 44, DFF, 128, C.G, (int)blockIdx.x);
        const pg8::EpiSwiGLU E{Gb, DFF};
        pg8::gemm_phase<pg8::EpiSwiGLU, pg8::SchedRC>(C.lds, pg8::Gemm{D, D, D}, S, E); PH_SEAM(PH0 + 1); }
    if (PH_IN(PH0 + 2)) { const pg8::SchedRC S = pg8::make_rc(Gb, DFF, WSP(const bf16, WS_WDN + (size_t)l * 22 * MiB), DFF, nM, 8, D, 256, C.G, (int)blockIdx.x);
        const pg8::EpiRes E{XR, l == DEPTH - 1 ? C.a.out : XR, mxl + 5 * D, bl + 5 * D};
        pg8::gemm_phase<pg8::EpiRes, pg8::SchedRC>(C.lds, pg8::Gemm{DFF, DFF, DFF}, S, E); PH_SEAM(PH0 + 2); }
}

template <int PH0> __device__ __forceinline__ void attn_block(Ctx& C, int l, int j, bool first, bool ctx_out) {
    const float* mxl = WSP(const float, WS_MX) + (size_t)l * 3 * NADA; const float* bl = C.a.in[I_BADA] + (size_t)l * NADA;
    float* XR = WSP(float, WS_XR); bf16* H = WSP(bf16, WS_H); bf16* QKV = WSP(bf16, WS_AR + AR_QKV); bf16* AO = WSP(bf16, WS_AR + AR_AO);
    if (PH_IN(PH0)) { modnorm_phase(first ? C.a.in[I_X] : XR, first ? C.a.in[I_CTX] : XR + (size_t)ML * D, first ? XR : nullptr, H, C.a.in[I_NORMG] + (size_t)(l * 2) * D, mxl, bl, 0, MT, C.gw, C.NGW, C.lane); PH_SEAM(PH0); }
    if (PH_IN(PH0 + 1)) { const pg8::SchedRC S = pg8::make_rc(H, D, WSP(const bf16, WS_WQKV + (size_t)j * 12 * MiB), D, 66, 12, NQKV, 256, C.G, (int)blockIdx.x);
        const pg8::EpiBf16<0, false> E{QKV, NQKV, nullptr, 0};
        pg8::gemm_phase<pg8::EpiBf16<0, false>, pg8::SchedRC>(C.lds, pg8::Gemm{D, D, D}, S, E); PH_SEAM(PH0 + 1); }
    if (PH_IN(PH0 + 2)) { qknorm_rope_phase(QKV, C.a.in[I_QG] + j * HD, C.a.in[I_KG] + j * HD, WSP(const f32x2, WS_ROPE), MT, C.gw, C.NGW, C.lane); PH_SEAM(PH0 + 2); }
    if (PH_IN(PH0 + 3)) { attn::attn_phase(QKV, AO, C.a.in[I_SINK] + j * NH, ctx_out, C.vcu, C.G, (char*)C.lds); PH_SEAM(PH0 + 3); }
    if (PH_IN(PH0 + 4)) { const pg8::SchedRC S = pg8::make_rc(AO, D, WSP(const bf16, WS_WO + (size_t)j * 8 * MiB), D, ctx_out ? 66 : 64, 8, D, 256, C.G, (int)blockIdx.x);
        const pg8::EpiRes E{XR, XR, mxl + 2 * D, bl + 2 * D};
        pg8::gemm_phase<pg8::EpiRes, pg8::SchedRC>(C.lds, pg8::Gemm{D, D, D}, S, E); PH_SEAM(PH0 + 4); }
}

__global__ void __launch_bounds__(NWAVES * 64, 2) mega(KArgs args) {
    extern __shared__ __attribute__((aligned(16))) unsigned char lds_raw[];
    Ctx C; C.a = args; C.lds = (LAS unsigned char*)lds_raw; C.ctl = (gu32*)(args.ws + WS_CTL);
    C.tid = threadIdx.x; C.lane = C.tid & 63; C.wave = __builtin_amdgcn_readfirstlane(C.tid >> 6);
    C.G = gridDim.x; { const int bx = blockIdx.x; C.vcu = (C.G % 8 == 0) ? (bx % 8) * (C.G / 8) + bx / 8 : bx; }
    C.gw = C.vcu * NWAVES + C.wave; C.NGW = C.G * NWAVES; C.lo = args.ph_lo; C.hi = args.ph_hi;
    volatile LAS unsigned* MISC = (volatile LAS unsigned*)(C.lds + LDSCTL_OFF);
    for (int u = C.tid; u < (LDS_BYTES - LDSCTL_OFF) / 4; u += NWAVES * 64) ((LAS unsigned*)(C.lds + LDSCTL_OFF))[u] = 0u;
    __syncthreads();
    C.bar.bar = (unsigned*)(C.ctl + CW_BAR); C.bar.x = 0; C.bar.st = nullptr;
    if (!MK_PER_PHASE) C.bar = xcd_barrier_post((unsigned*)(C.ctl + CW_BAR), MISC + 8);

    float* XR = WSP(float, WS_XR); bf16* H = WSP(bf16, WS_H);
    if (PH_IN(0)) { prologue_phase(C.a, C.lds, C.ctl, C.tid, C.lane, C.wave); PH_SEAM(0); }
    attn_block<1>(C, 0, 0, true, true);
    ffn_block<6>(C, 0, 66);
    {
        const int l = 1; const float* mxl = WSP(const float, WS_MX) + (size_t)l * 3 * NADA; const float* bl = C.a.in[I_BADA] + (size_t)l * NADA;
        bf16* XT = WSP(bf16, WS_AR + AR_XT); bf16* XTC = WSP(bf16, WS_AR + AR_XTC); bf16* Fm = WSP(bf16, WS_AR + AR_F); bf16* Y = WSP(bf16, WS_AR + AR_Y);
        if (PH_IN(9)) { modnorm_phase(XR, XR + (size_t)ML * D, nullptr, H, C.a.in[I_NORMG] + (size_t)(l * 2) * D, mxl, bl, 0, MT, C.gw, C.NGW, C.lane); PH_SEAM(9); }
        if (PH_IN(10)) {
            { const SchedF S{(const char*)WSP(bf16, WS_DC2), (const char*)H, 0, C.G, (int)blockIdx.x}; const pg8::EpiBf16<0, false> E{XT, 16384, nullptr, 0};
              pg8::gemm_phase<pg8::EpiBf16<0, false>, SchedF>(C.lds, pg8::Gemm{256, D, 256}, S, E); }
            { const SchedF S{(const char*)WSP(bf16, WS_DC2), (const char*)H, 1, C.G, C.G - 1 - (int)blockIdx.x}; const pg8::EpiBf16<0, false> E{XTC, 512, nullptr, 0};
              pg8::gemm_phase<pg8::EpiBf16<0, false>, SchedF>(C.lds, pg8::Gemm{256, D, 256}, S, E); }
            PH_SEAM(10); }
        if (PH_IN(11)) {
            { const SchedF S{(const char*)Fm, (const char*)XT, 2, C.G, (int)blockIdx.x}; const pg8::EpiBf16<0, false> E{Y, D, nullptr, 0};
              pg8::gemm_phase<pg8::EpiBf16<0, false>, SchedF>(C.lds, pg8::Gemm{16384, 16384, 16384}, S, E); }
            { const SchedF S{(const char*)WSP(bf16, WS_FC), (const char*)XTC, 3, C.G, C.G - 1 - (int)blockIdx.x}; const pg8::EpiBf16<0, false> E{Y, D, nullptr, 0};
              pg8::gemm_phase<pg8::EpiBf16<0, false>, SchedF>(C.lds, pg8::Gemm{512, 512, 512}, S, E); }
            PH_SEAM(11); }
        if (PH_IN(12)) { const pg8::SchedRC S = pg8::make_rc(Y, D, WSP(const bf16, WS_WF), D, 66, 8, D, 256, C.G, (int)blockIdx.x);
            const pg8::EpiRes E{XR, XR, mxl + 2 * D, bl + 2 * D};
            pg8::gemm_phase<pg8::EpiRes, pg8::SchedRC>(C.lds, pg8::Gemm{D, D, D}, S, E); PH_SEAM(12); }
    }
    ffn_block<13>(C, 1, 66);
    {
        const int l = 2; const float* mxl = WSP(const float, WS_MX) + (size_t)l * 3 * NADA; const float* bl = C.a.in[I_BADA] + (size_t)l * NADA;
        bf16* Z = WSP(bf16, WS_AR + AR_Z); float* SSQ = (float*)(C.a.ws + WS_CTL) + CW_SSQ;
        if (PH_IN(16)) { modnorm_phase(XR, XR + (size_t)ML * D, nullptr, H, C.a.in[I_NORMG] + (size_t)(l * 2) * D, mxl, bl, 0, MT, C.gw, C.NGW, C.lane); PH_SEAM(16); }
        if (PH_IN(17)) { const pg8::SchedRC S = pg8::make_rc(H, D, WSP(const bf16, WS_WSI), D, 66, 48, 2 * SGH, 256, C.G, (int)blockIdx.x);
            const pg8::EpiBf16<1, true> E{Z, 2 * SGH, SSQ, 24};
            pg8::gemm_phase<pg8::EpiBf16<1, true>, pg8::SchedRC>(C.lds, pg8::Gemm{D, D, D}, S, E); PH_SEAM(17); }
        if (PH_IN(18)) { for (int uid = C.vcu; uid < (MT / 128) * 8; uid += C.G) attn::sgu_unit(Z, SSQ, C.a.in[I_WSS], C.a.in[I_BSS], C.a.in[I_SVG], uid >> 3, uid & 7, (char*)C.lds); PH_SEAM(18); }
        if (PH_IN(19)) { const pg8::SchedRC S = pg8::make_rc(Z, 2 * SGH, WSP(const bf16, WS_WSO), SGH, 66, 8, D, 256, C.G, (int)blockIdx.x);
            const pg8::EpiRes E{XR, XR, mxl + 2 * D, bl + 2 * D};
            pg8::gemm_phase<pg8::EpiRes, pg8::SchedRC>(C.lds, pg8::Gemm{2 * SGH, SGH, SGH}, S, E); PH_SEAM(19); }
    }
    ffn_block<20>(C, 2, 66);
    attn_block<23>(C, 3, 1, false, false);
    ffn_block<28>(C, 3, 64);
}

extern "C" void kernel_launch(void* const* d_in, const int* in_sizes, int n_in, void* d_out, int out_size, void* d_ws, size_t ws_size, hipStream_t stream) {
    static int grid = 0;
    if (grid == 0) {
        if (n_in != 21 || in_sizes[0] != ML * D || out_size != ML * D || ws_size < WS_END) { fprintf(stderr, "kernel_launch: unexpected shapes (n_in %d, in0 %d, out %d, ws %zu < %zu)\n", n_in, n_in > 0 ? in_sizes[0] : -1, out_size, ws_size, (size_t)WS_END); grid = -1; return; }
        int dev = 0, cus = 0, per_cu = 0;
        if (hipGetDevice(&dev) != hipSuccess || hipDeviceGetAttribute(&cus, hipDeviceAttributeMultiprocessorCount, dev) != hipSuccess) { grid = -1; return; }
        if (hipFuncSetAttribute((const void*)mega, hipFuncAttributeMaxDynamicSharedMemorySize, LDS_BYTES) != hipSuccess) { fprintf(stderr, "kernel_launch: hipFuncSetAttribute failed\n"); grid = -1; return; }
        if (hipOccupancyMaxActiveBlocksPerMultiprocessor(&per_cu, (const void*)mega, NWAVES * 64, LDS_BYTES) != hipSuccess || per_cu < 1) fprintf(stderr, "kernel_launch: occupancy query says %d\n", per_cu);
        (void)hipGetLastError();
        grid = cus;
    }
    if (grid < 0) return;
    if (hipMemsetAsync((char*)d_ws + WS_CTL, 0, CTL_ZERO_BYTES, stream) != hipSuccess) return;
    KArgs a{};
    for (int i = 0; i < 21; ++i) a.in[i] = (const float*)d_in[i];
    a.out = (float*)d_out; a.ws = (unsigned char*)d_ws;
#if MK_PER_PHASE
    for (int ph = 0; ph < NPH; ++ph) { a.ph_lo = ph; a.ph_hi = ph + 1; hipLaunchKernelGGL(mega, dim3(grid), dim3(NWAVES * 64), LDS_BYTES, stream, a); }
#else
    a.ph_lo = 0; a.ph_hi = NPH; hipLaunchKernelGGL(mega, dim3(grid), dim3(NWAVES * 64), LDS_BYTES, stream, a);
#endif
}
```

```cpp
#include <hip/hip_runtime.h>
#include <cstdio>
#include <cstdint>

#ifndef MK_PER_PHASE
#define MK_PER_PHASE 0
#endif

constexpr int D = 2048, NBATCH = 2, SEQ = 8192, CTXL = 256, DEPTH = 4;
constexpr int ML = NBATCH * SEQ, MC = NBATCH * CTXL, MT = ML + MC;
constexpr int NH = 16, NKV = 4, HD = 128, HQ = 2048, HKV = 512, NQKV = HQ + 2 * HKV;
constexpr int DFF = 5632, SGH = 6144, SGG = 768, NADA = 6 * D;
constexpr float EPS = 1e-6f;

constexpr size_t MiB = 1u << 20;
constexpr size_t WS_CTL = 0, CTL_ZERO_BYTES = 2 * MiB;
constexpr size_t WS_MX = 2 * MiB;
constexpr size_t WS_ROPE = 3 * MiB;
constexpr size_t WS_DC2 = 7 * MiB;
constexpr size_t WS_DB = WS_DC2 + 256 * 1024;
constexpr size_t WS_FC = WS_DC2 + 512 * 1024;
constexpr size_t WS_DA = WS_DC2 + 768 * 1024;
constexpr size_t WS_WGU = 8 * MiB;
constexpr size_t WS_WDN = WS_WGU + 4 * 44 * MiB;
constexpr size_t WS_WQKV = WS_WDN + 4 * 22 * MiB;
constexpr size_t WS_WO = WS_WQKV + 2 * 12 * MiB;
constexpr size_t WS_WF = WS_WO + 2 * 8 * MiB;
constexpr size_t WS_WSI = WS_WF + 8 * MiB;
constexpr size_t WS_WSO = WS_WSI + 48 * MiB;
constexpr size_t WS_XR = WS_WSO + 24 * MiB;
constexpr size_t WS_H = WS_XR + 132 * MiB;
constexpr size_t WS_AR = WS_H + 66 * MiB;
constexpr size_t AR_QKV = 0, AR_AO = 99 * MiB;
constexpr size_t AR_G = 0;
constexpr size_t AR_Z = 0;
constexpr size_t AR_XA = 0, AR_XB = 128 * MiB, AR_XTC = 256 * MiB, AR_Y = 260 * MiB;
constexpr size_t WS_END = WS_AR + 396 * MiB;
constexpr int CW_TMO = 0;
constexpr int CW_BAR = 4096;
constexpr int CW_SSQ = 16384;
static_assert((CW_SSQ + MT) * 4 <= (int)CTL_ZERO_BYTES, "ctl");

#define GAS __attribute__((address_space(1)))
#define LAS __attribute__((address_space(3)))
typedef unsigned short bf16;
typedef unsigned short bf16_t;
typedef short bf16x8 __attribute__((ext_vector_type(8)));
typedef short s16x4 __attribute__((ext_vector_type(4)));
typedef float f32x4 __attribute__((ext_vector_type(4)));
typedef float f32x2 __attribute__((ext_vector_type(2)));
typedef float f32x16 __attribute__((ext_vector_type(16)));
typedef unsigned u32x4 __attribute__((ext_vector_type(4)));
typedef unsigned u32x2 __attribute__((ext_vector_type(2)));

__device__ __forceinline__ unsigned cvt_pk_bf16(float lo, float hi) { unsigned r; asm volatile("v_cvt_pk_bf16_f32 %0, %1, %2" : "=v"(r) : "v"(lo), "v"(hi)); return r; }
__device__ __forceinline__ float bf2f(unsigned short b) { return __uint_as_float(((unsigned)b) << 16); }

namespace pg8 {
#define PG8_LAS __attribute__((address_space(3)))
constexpr int BM = 256, BK = 64, HALF = 128, HTB = HALF * BK * 2, STAGE_BYTES = 8 * HTB, NXCD = 8, WGM = 8;
__host__ __device__ __forceinline__ int lds_byte(int r, int c) { const int st = (r >> 4) * 2 + (c >> 5), rr = r & 15, cc = c & 31, ob = rr * 64 + cc * 2; return st * 1024 + (ob ^ (((ob >> 9) & 1) << 5)); }
__host__ __device__ __forceinline__ void stage_rc(int b, int& R, int& C) { const int st = b / 1024, sb = b % 1024, swz = sb ^ (((sb >> 9) & 1) << 5); R = (st >> 1) * 16 + swz / 64; C = (st & 1) * 32 + (swz % 64) / 2; }
__host__ __device__ __forceinline__ int perm32(int rho) { const int n = rho >> 4, i = rho & 15; return 8 * (i >> 2) + 4 * n + (i & 3); }

struct Unit { const char* a; const char* b; long o; int pm, pn; };
struct Gemm { int lda, ldb, K, bs_log2, ldb_hi; long hsB; };
__device__ __forceinline__ Gemm mk_gemm(int lda, int ldb, int K) { Gemm g; g.lda = lda; g.ldb = ldb; g.K = K; g.bs_log2 = 7; g.ldb_hi = 0; g.hsB = (long)HALF * ldb; return g; }

__device__ __forceinline__ void tile_of(int L, int nM, int nN, int& pm, int& pn) {
    const int nwg = nM * nN; int wgid = L;
    { const int q = nwg / NXCD, r = nwg % NXCD, xcd = wgid % NXCD, off = wgid / NXCD; wgid = (xcd < r ? xcd * (q + 1) : r * (q + 1) + (xcd - r) * q) + off; }
    const int nig = WGM * nN, gid = wgid / nig, fm = gid * WGM, gsz = (nM - fm) < WGM ? (nM - fm) : WGM;
    pm = fm + ((wgid % nig) % gsz); pn = (wgid % nig) / gsz;
}

__device__ __forceinline__ f32x2 gelu_pk(f32x2 v) {
    const f32x2 av = __builtin_elementwise_abs(v), d = av * 0.2316418882f + 1.0f;
    f32x2 t; t.x = __builtin_amdgcn_rcpf(d.x); t.y = __builtin_amdgcn_rcpf(d.y);
    f32x2 q = t * 0.5307027145f + (-0.7265760135f); q = q * t + 0.7107068705f; q = q * t + (-0.142248368f); q = q * t + 0.127414796f; q = q * t;
    const f32x2 s = (v * v) * (-0.72134752044f);
    f32x2 e; e.x = __builtin_amdgcn_exp2f(s.x); e.y = __builtin_amdgcn_exp2f(s.y);
    const f32x2 m = v * (q * e), r = v - m;
    f32x2 o; o.x = v.x < 0.f ? m.x : r.x; o.y = v.y < 0.f ? m.y : r.y; return o;
}

template <class Epi, class Sched, bool ALIGN_EPI = true, bool SP2 = true>
__device__ __forceinline__ void gemm_phase(PG8_LAS unsigned char* lds, const Gemm g, const Sched& S, const Epi& E) {
    int tid = threadIdx.x; asm volatile("" : "+v"(tid));
    const int wid = __builtin_amdgcn_readfirstlane(tid >> 6), lane = tid & 63, wr = wid >> 2, wc = wid & 3, fr = lane & 15, fq = lane >> 4;
    const int K = g.K, nt = K / BK;
    unsigned voffA[2], voffB[2];
#pragma unroll
    for (int i = 0; i < 2; ++i) { int R, C; stage_rc(tid * 16 + i * 8192, R, C); const int Rb = Epi::PERM ? ((R & ~31) + perm32(R & 31)) : R;
        voffA[i] = (unsigned)(R * g.lda + C) * 2u; voffB[i] = (unsigned)((Rb & ((1 << g.bs_log2) - 1)) * g.ldb + (Rb >> g.bs_log2) * g.ldb_hi + C) * 2u; }
    const size_t kstep = (size_t)(BK * 2);
    const size_t hstepA = (size_t)HALF * g.lda * 2, hstepB = (size_t)g.hsB * 2;
    const unsigned ldsw = (unsigned)wid * 1024u;
    const int aoff = lds_byte(wr * 64 + fr, fq * 8), boff = lds_byte(wc * 32 + fr, fq * 8);
#define PG8_SA(b, h) (((b) * 2 + (h)) * HTB)
#define PG8_SB(b, h) ((4 + (b) * 2 + (h)) * HTB)
#define PG8_STAGE(bufoff, gbase, voff) do { _Pragma("unroll") for (int _i = 0; _i < 2; ++_i) \
        __builtin_amdgcn_global_load_lds((const unsigned*)((const char*)(gbase) + (voff)[_i]), (PG8_LAS unsigned*)(lds + (bufoff) + ldsw + _i * 8192), 16, 0, 0); } while (0)
#define PG8_LDA(dst, b, h) do { _Pragma("unroll") for (int m = 0; m < 4; ++m) _Pragma("unroll") for (int k = 0; k < 2; ++k) dst[m][k] = *(const PG8_LAS bf16x8*)(lds + PG8_SA(b, h) + aoff + m * 2048 + k * 1024); } while (0)
#define PG8_LDB(dst, b, h) do { _Pragma("unroll") for (int n = 0; n < 2; ++n) _Pragma("unroll") for (int k = 0; k < 2; ++k) dst[n][k] = *(const PG8_LAS bf16x8*)(lds + PG8_SB(b, h) + boff + n * 2048 + k * 1024); } while (0)
#define PG8_MMA(ai, bj, At, Bt) do { __builtin_amdgcn_s_setprio(1); _Pragma("unroll") for (int m = 0; m < 4; ++m) _Pragma("unroll") for (int n = 0; n < 2; ++n) _Pragma("unroll") for (int k = 0; k < 2; ++k) \
        acc[ai][bj][m][n] = __builtin_amdgcn_mfma_f32_16x16x32_bf16(Bt[n][k], At[m][k], acc[ai][bj][m][n], 0, 0, 0); __builtin_amdgcn_s_setprio(0); } while (0)
#define PG8_WAIT_V(n) asm volatile("s_waitcnt vmcnt(" #n ")" ::: "memory")
#define PG8_WAIT_L(n) asm volatile("s_waitcnt lgkmcnt(" #n ")" ::: "memory")
#define PG8_BAR __builtin_amdgcn_s_barrier()
#define PG8_SCHED __builtin_amdgcn_sched_barrier(0)
    Unit cur, nxt; int ui = 0;
    if (!S.next(0, cur)) return;
    f32x4 acc[2][2][4][2];
#pragma unroll
    for (int a = 0; a < 2; ++a)
#pragma unroll
        for (int b = 0; b < 2; ++b)
#pragma unroll
            for (int m = 0; m < 4; ++m)
#pragma unroll
                for (int n = 0; n < 2; ++n) acc[a][b][m][n] = (f32x4){0.f, 0.f, 0.f, 0.f};
    bf16x8 At[4][2], B0[2][2], B1[2][2];
    const char* cA = cur.a; const char* cB = cur.b;
    if constexpr (SP2) {
        PG8_STAGE(PG8_SB(0, 0), cB, voffB); PG8_STAGE(PG8_SB(0, 1), cB + hstepB, voffB); PG8_STAGE(PG8_SA(0, 0), cA, voffA); PG8_STAGE(PG8_SA(0, 1), cA + hstepA, voffA);
        if (wr == 1) PG8_BAR;
        PG8_WAIT_V(2); PG8_BAR;
        PG8_STAGE(PG8_SB(1, 0), cB + kstep, voffB); PG8_STAGE(PG8_SA(1, 0), cA + kstep, voffA); PG8_STAGE(PG8_SB(1, 1), cB + hstepB + kstep, voffB);
        PG8_WAIT_V(6); PG8_BAR;
    } else {
        PG8_STAGE(PG8_SB(0, 0), cB, voffB); PG8_STAGE(PG8_SA(0, 0), cA, voffA); PG8_STAGE(PG8_SB(0, 1), cB + hstepB, voffB); PG8_STAGE(PG8_SA(0, 1), cA + hstepA, voffA);
        if (wr == 1) PG8_BAR;
        PG8_WAIT_V(4); PG8_BAR;
        PG8_STAGE(PG8_SB(1, 0), cB + kstep, voffB); PG8_STAGE(PG8_SA(1, 0), cA + kstep, voffA); PG8_STAGE(PG8_SB(1, 1), cB + hstepB + kstep, voffB);
        PG8_WAIT_V(6); PG8_BAR;
    }
    for (;;) {
        const bool has_next = S.next(ui + 1, nxt);
        const char* nA = has_next ? nxt.a : cA; const char* nB = has_next ? nxt.b : cB;
        for (int t = 0; t < nt; t += 2) {
            const bool last = (t == nt - 2);
            const char* a1 = cA + (size_t)(t + 1) * kstep;
            const char* a2 = last ? nA : cA + (size_t)(t + 2) * kstep; const char* b2 = last ? nB : cB + (size_t)(t + 2) * kstep;
            const char* a3 = a2 + kstep; const char* b3 = b2 + kstep;
            if constexpr (SP2) {
            PG8_LDB(B0, 0, 0); PG8_LDB(B1, 0, 1); PG8_SCHED; PG8_LDA(At, 0, 0); PG8_STAGE(PG8_SA(1, 1), a1 + hstepA, voffA);
            PG8_WAIT_V(8); PG8_WAIT_L(0); PG8_BAR; PG8_MMA(0, 0, At, B0); PG8_MMA(0, 1, At, B1); PG8_BAR; PG8_SCHED;
            PG8_LDA(At, 0, 1); PG8_STAGE(PG8_SB(0, 0), b2, voffB); PG8_STAGE(PG8_SB(0, 1), b2 + hstepB, voffB); PG8_STAGE(PG8_SA(0, 0), a2, voffA);
            PG8_WAIT_V(8); PG8_WAIT_L(0); PG8_BAR; PG8_MMA(1, 0, At, B0); PG8_MMA(1, 1, At, B1); PG8_BAR; PG8_SCHED;
            PG8_LDB(B0, 1, 0); PG8_LDB(B1, 1, 1); PG8_SCHED; PG8_LDA(At, 1, 0); PG8_STAGE(PG8_SA(0, 1), a2 + hstepA, voffA);
            PG8_WAIT_V(8); PG8_WAIT_L(0); PG8_BAR; PG8_MMA(0, 0, At, B0); PG8_MMA(0, 1, At, B1); PG8_BAR; PG8_SCHED;
            PG8_LDA(At, 1, 1); PG8_STAGE(PG8_SB(1, 0), b3, voffB); PG8_STAGE(PG8_SB(1, 1), b3 + hstepB, voffB); PG8_STAGE(PG8_SA(1, 0), a3, voffA);
            PG8_WAIT_V(8); PG8_WAIT_L(0); PG8_BAR; PG8_MMA(1, 0, At, B0); PG8_MMA(1, 1, At, B1); PG8_BAR; PG8_SCHED;
            } else {
            PG8_LDB(B0, 0, 0); PG8_SCHED; PG8_LDA(At, 0, 0); PG8_STAGE(PG8_SA(1, 1), a1 + hstepA, voffA);
            PG8_WAIT_L(8); PG8_BAR; PG8_WAIT_L(0); PG8_MMA(0, 0, At, B0); PG8_BAR; PG8_SCHED;
            PG8_LDB(B1, 0, 1); PG8_STAGE(PG8_SB(0, 0), b2, voffB);
            PG8_BAR; PG8_WAIT_L(0); PG8_MMA(0, 1, At, B1); PG8_BAR;
            PG8_LDA(At, 0, 1); PG8_STAGE(PG8_SA(0, 0), a2, voffA);
            PG8_BAR; PG8_WAIT_L(0); PG8_MMA(1, 0, At, B0); PG8_BAR; PG8_SCHED;
            PG8_STAGE(PG8_SB(0, 1), b2 + hstepB, voffB);
            PG8_WAIT_V(6); PG8_BAR; PG8_MMA(1, 1, At, B1); PG8_BAR;
            PG8_LDB(B0, 1, 0); PG8_SCHED; PG8_LDA(At, 1, 0); PG8_STAGE(PG8_SA(0, 1), a2 + hstepA, voffA);
            PG8_WAIT_L(8); PG8_BAR; PG8_WAIT_L(0); PG8_MMA(0, 0, At, B0); PG8_BAR; PG8_SCHED;
            PG8_LDB(B1, 1, 1); PG8_STAGE(PG8_SB(1, 0), b3, voffB);
            PG8_BAR; PG8_WAIT_L(0); PG8_MMA(0, 1, At, B1); PG8_BAR;
            PG8_LDA(At, 1, 1); PG8_STAGE(PG8_SA(1, 0), a3, voffA);
            PG8_BAR; PG8_WAIT_L(0); PG8_MMA(1, 0, At, B0); PG8_BAR; PG8_SCHED;
            PG8_STAGE(PG8_SB(1, 1), b3 + hstepB, voffB);
            PG8_WAIT_V(6); PG8_BAR; PG8_MMA(1, 1, At, B1); PG8_BAR;
            }
        }
        if constexpr (ALIGN_EPI) { if (wr == 0) PG8_BAR; }
        E(acc, cur, wr, wc, fr, fq);
        if (!has_next) break;
#pragma unroll
        for (int a = 0; a < 2; ++a)
#pragma unroll
            for (int b = 0; b < 2; ++b)
#pragma unroll
                for (int m = 0; m < 4; ++m)
#pragma unroll
                    for (int n = 0; n < 2; ++n) acc[a][b][m][n] = (f32x4){0.f, 0.f, 0.f, 0.f};
        cur = nxt; cA = nA; cB = nB; ++ui;
        if constexpr (ALIGN_EPI) { if (wr == 1) PG8_BAR; }
    }
    PG8_WAIT_V(0);
    if constexpr (!ALIGN_EPI) { if (wr == 0) PG8_BAR; }
    PG8_BAR;
#undef PG8_SA
#undef PG8_SB
#undef PG8_STAGE
#undef PG8_LDA
#undef PG8_LDB
#undef PG8_MMA
#undef PG8_WAIT_V
#undef PG8_WAIT_L
#undef PG8_BAR
#undef PG8_SCHED
}
}
namespace pg8 {
__device__ __forceinline__ int bsel_of(int pm) { return pm < 32 ? 0 : (pm < 64 ? 1 : 2); }

template <int ACT, bool SSQ> struct EpiBf16 {
    static constexpr bool PERM = true;
    bf16_t* O; int ldc; float* ssq; int ssq_pn0;
    __device__ __forceinline__ void operator()(const f32x4 (&acc)[2][2][4][2], const Unit& u, int wr, int wc, int fr, int fq) const {
        bf16_t* base = O + u.o + (size_t)(wr * 64 + fr) * ldc + wc * 32 + 8 * fq;
        const bool do_ssq = SSQ && (u.pn >= ssq_pn0);
#pragma unroll
        for (int ai = 0; ai < 2; ++ai)
#pragma unroll
            for (int m = 0; m < 4; ++m) { bf16_t* rowp = base + (size_t)(ai * HALF + m * 16) * ldc; float s = 0.f;
#pragma unroll
                for (int bj = 0; bj < 2; ++bj) { f32x4 v0 = acc[ai][bj][m][0], v1 = acc[ai][bj][m][1];
                    if (ACT == 1) { f32x2 a = gelu_pk((f32x2){v0[0], v0[1]}), b = gelu_pk((f32x2){v0[2], v0[3]}), c = gelu_pk((f32x2){v1[0], v1[1]}), d = gelu_pk((f32x2){v1[2], v1[3]});
                        v0 = (f32x4){a.x, a.y, b.x, b.y}; v1 = (f32x4){c.x, c.y, d.x, d.y}; }
                    if (SSQ) s += (v0[0] * v0[0] + v0[1] * v0[1]) + (v0[2] * v0[2] + v0[3] * v0[3]) + (v1[0] * v1[0] + v1[1] * v1[1]) + (v1[2] * v1[2] + v1[3] * v1[3]);
                    u32x4 w; w.x = cvt_pk_bf16(v0[0], v0[1]); w.y = cvt_pk_bf16(v0[2], v0[3]); w.z = cvt_pk_bf16(v1[0], v1[1]); w.w = cvt_pk_bf16(v1[2], v1[3]);
                    *(u32x4*)(rowp + bj * HALF) = w; }
                if (SSQ) { if (do_ssq) { s += __shfl_xor(s, 16); s += __shfl_xor(s, 32);
                    if (fq == 0) atomicAdd(ssq + u.pm * BM + ai * HALF + wr * 64 + m * 16 + fr, s); } }
            }
    }
};

struct EpiRes {
    static constexpr bool PERM = false;
    const float* rin; float* rout; const float* gmx; const float* gb;
    __device__ __forceinline__ void operator()(const f32x4 (&acc)[2][2][4][2], const Unit& u, int wr, int wc, int fr, int fq) const {
        const int bs = bsel_of(u.pm); const int col0 = u.pn * BM + wc * 32 + 4 * fq;
        f32x4 gv[2][2];
#pragma unroll
        for (int bj = 0; bj < 2; ++bj)
#pragma unroll
            for (int n = 0; n < 2; ++n) gv[bj][n] = *(const f32x4*)(gmx + bs * NADA + col0 + bj * HALF + n * 16) + *(const f32x4*)(gb + col0 + bj * HALF + n * 16);
#pragma unroll
        for (int ai = 0; ai < 2; ++ai)
#pragma unroll
            for (int m = 0; m < 4; ++m) { const size_t off = (size_t)(u.pm * BM + ai * HALF + wr * 64 + m * 16 + fr) * D + col0;
#pragma unroll
                for (int bj = 0; bj < 2; ++bj)
#pragma unroll
                    for (int n = 0; n < 2; ++n) { const f32x4 x = *(const f32x4*)(rin + off + bj * HALF + n * 16); *(f32x4*)(rout + off + bj * HALF + n * 16) = x + gv[bj][n] * acc[ai][bj][m][n]; }
                if (m & 1) asm volatile("" ::: "memory"); }
    }
};

struct EpiSwiGLU {
    static constexpr bool PERM = true;
    bf16_t* G; int ldg;
    __device__ __forceinline__ void operator()(const f32x4 (&acc)[2][2][4][2], const Unit& u, int wr, int wc, int fr, int fq) const {
        bf16_t* base = G + u.o + (size_t)(wr * 64 + fr) * ldg + wc * 16 + 4 * fq;
#pragma unroll
        for (int ai = 0; ai < 2; ++ai)
#pragma unroll
            for (int m = 0; m < 4; ++m) { bf16_t* rowp = base + (size_t)(ai * HALF + m * 16) * ldg;
#pragma unroll
                for (int bj = 0; bj < 2; ++bj) { const f32x4 g = acc[ai][bj][m][0], up = acc[ai][bj][m][1]; f32x4 o;
#pragma unroll
                    for (int e = 0; e < 4; ++e) { const float sg = __builtin_amdgcn_rcpf(1.f + __builtin_amdgcn_exp2f(-1.4426950408889634f * g[e])); o[e] = g[e] * sg * up[e]; }
                    u32x2 w; w.x = cvt_pk_bf16(o[0], o[1]); w.y = cvt_pk_bf16(o[2], o[3]);
                    *(u32x2*)(rowp + bj * 64) = w; } }
    }
};

struct EpiF1 {
    static constexpr bool PERM = true;
    bf16_t* O;
    __device__ __forceinline__ void operator()(const f32x4 (&acc)[2][2][4][2], const Unit& u, int wr, int wc, int fr, int fq) const {
        bf16_t* base = O + u.o + (size_t)(wr * 64 + fr) * 256 + (size_t)(wc >> 1) * 262144 + 32 * (wc & 1) + 8 * fq;
#pragma unroll
        for (int ai = 0; ai < 2; ++ai)
#pragma unroll
            for (int m = 0; m < 4; ++m)
#pragma unroll
                for (int bj = 0; bj < 2; ++bj) { const f32x4 v0 = acc[ai][bj][m][0], v1 = acc[ai][bj][m][1];
                    u32x4 w; w.x = cvt_pk_bf16(v0[0], v0[1]); w.y = cvt_pk_bf16(v0[2], v0[3]); w.z = cvt_pk_bf16(v1[0], v1[1]); w.w = cvt_pk_bf16(v1[2], v1[3]);
                    *(u32x4*)(base + (size_t)(ai * HALF + m * 16) * 256 + (size_t)bj * 2 * 262144) = w; }
    }
};
struct EpiFA {
    static constexpr bool PERM = true;
    bf16_t* O;
    __device__ __forceinline__ void operator()(const f32x4 (&acc)[2][2][4][2], const Unit& u, int wr, int wc, int fr, int fq) const {
        const int t20 = 32 * wc + 8 * fq;
        bf16_t* base = O + u.o + (size_t)wr * 256 + t20;
#pragma unroll
        for (int m = 0; m < 4; ++m) { int k1 = 16 * m + fr; asm volatile("" : "+v"(k1));     u32x4 wre[2], wim[2];
#pragma unroll
            for (int e2 = 0; e2 < 4; ++e2) { float cs[2], sn[2];
#pragma unroll
                for (int q = 0; q < 2; ++q) { const float fr_ = (float)((k1 * (t20 + 2 * e2 + q)) & 8191) * (1.0f / 8192.0f); cs[q] = __builtin_amdgcn_cosf(fr_); sn[q] = __builtin_amdgcn_sinf(fr_); }
#pragma unroll
                for (int bj = 0; bj < 2; ++bj) { float zr[2], zi[2];
#pragma unroll
                    for (int q = 0; q < 2; ++q) { const int e = 2 * e2 + q; const float a = acc[0][bj][m][e >> 2][e & 3], b = acc[1][bj][m][e >> 2][e & 3];
                        zr[q] = a * cs[q] + b * sn[q]; zi[q] = b * cs[q] - a * sn[q]; }
                    wre[bj][e2] = cvt_pk_bf16(zr[0], zr[1]); wim[bj][e2] = cvt_pk_bf16(zi[0], zi[1]); }
                __builtin_amdgcn_sched_barrier(0); }
#pragma unroll
            for (int bj = 0; bj < 2; ++bj) { bf16_t* p = base + (size_t)k1 * 524288 + (size_t)bj * 512; *(u32x4*)p = wre[bj]; *(u32x4*)(p + 128) = wim[bj]; } }
    }
};
struct EpiFB {
    static constexpr bool PERM = true;
    bf16_t* O;
    __device__ __forceinline__ void operator()(const f32x4 (&acc)[2][2][4][2], const Unit& u, int wr, int wc, int fr, int fq) const {
        bf16_t* base = O + u.o + (size_t)(64 * wr + fr) * (64 * D) + wc * 32 + 8 * fq;
#pragma unroll
        for (int ai = 0; ai < 2; ++ai)
#pragma unroll
            for (int m = 0; m < 4; ++m)
#pragma unroll
                for (int bj = 0; bj < 2; ++bj) { const f32x4 v0 = acc[ai][bj][m][0], v1 = acc[ai][bj][m][1];
                    u32x4 w; w.x = cvt_pk_bf16(v0[0], v0[1]); w.y = cvt_pk_bf16(v0[2], v0[3]); w.z = cvt_pk_bf16(v1[0], v1[1]); w.w = cvt_pk_bf16(v1[2], v1[3]);
                    *(u32x4*)(base + (size_t)(16 * m) * (64 * D) + ai * 1024 + bj * HALF) = w; }
    }
};

struct SchedRC {
    const char* A; const char* B; size_t atile, btile; long ldo; int ow, nM, nN, G, c;
    __device__ __forceinline__ bool next(int i, Unit& u) const {
        const long L = (long)i * G + c; if (L >= (long)nM * nN) return false;
        int pm, pn; tile_of((int)L, nM, nN, pm, pn);
        u.a = A + (size_t)pm * atile; u.b = B + (size_t)pn * btile; u.o = (long)pm * BM * ldo + (long)pn * ow; u.pm = pm; u.pn = pn; return true;
    }
};
__device__ __forceinline__ SchedRC make_rc(const bf16_t* A, int lda, const bf16_t* B, int ldb, int nM, int nN, long ldo, int ow, int G, int c) {
    SchedRC s; s.A = (const char*)A; s.B = (const char*)B; s.atile = (size_t)BM * lda * 2; s.btile = (size_t)BM * ldb * 2; s.ldo = ldo; s.ow = ow; s.nM = nM; s.nN = nN; s.G = G; s.c = c; return s;
}
}
typedef GAS unsigned gu32;
#define RLX_AGENT __ATOMIC_RELAXED, __HIP_MEMORY_SCOPE_AGENT
#define XB_TMO      128
#define XB_XCNT(j)  (256  + 64 * (j))
#define XB_XSUB(j)  (1280 + 64 * (j))
#define XB_XGEN(j)  (2304 + 64 * (j))
#define XB_TOP      3328
#define XB_TOPGEN   3392
#define XCD_BAR_WORDS 3456
#define XB_SPIN_CAP (1u << 18)
__device__ __forceinline__ unsigned xb_ld(unsigned* p)              { return __hip_atomic_load(p, __ATOMIC_RELAXED, __HIP_MEMORY_SCOPE_AGENT); }
__device__ __forceinline__ unsigned xb_add(unsigned* p, unsigned v) { return __hip_atomic_fetch_add(p, v, __ATOMIC_RELAXED, __HIP_MEMORY_SCOPE_AGENT); }
__device__ __forceinline__ unsigned xb_xcc_id() { return (unsigned)__builtin_amdgcn_s_getreg((3 << 11) | 20) & 0xFu; }
#define XB_SPIN(cond, bar) do { unsigned _sp = 0; while (cond) { __builtin_amdgcn_s_sleep(1); \
    if ((++_sp & 255u) == 0u) { if (xb_ld(&(bar)[XB_TMO])) break; if (_sp > XB_SPIN_CAP) { atomicAdd(&(bar)[XB_TMO], 1u); break; } } } } while (0)
struct XcdBarrier { unsigned* bar; unsigned x; volatile LAS unsigned* st; };
__device__ __forceinline__ XcdBarrier xcd_barrier_post(unsigned* bar, volatile LAS unsigned* st) {
    XcdBarrier b; b.bar = bar; b.x = xb_xcc_id(); b.st = st;
    if (threadIdx.x == 0) (void)xb_add(&bar[XB_XCNT(b.x)], 1u);
    return b;
}
__device__ __forceinline__ void xcd_barrier_complete(unsigned* bar, unsigned x, unsigned& nloc, unsigned& nx) {
    const unsigned G = gridDim.x * gridDim.y * gridDim.z;
    unsigned sum, cnt, mine, sp = 0u;
    for (;;) {
        sum = 0u; cnt = 0u; mine = 0u;
#pragma unroll
        for (unsigned j = 0; j < 16; ++j) { const unsigned c = xb_ld(&bar[XB_XCNT(j)]); sum += c; cnt += (c > 0u) ? 1u : 0u; mine = (j == x) ? c : mine; }
        if (sum == G) break;
        __builtin_amdgcn_s_sleep(1);
        if ((++sp & 255u) == 0u) { if (xb_ld(&bar[XB_TMO])) break; if (sp > XB_SPIN_CAP) { atomicAdd(&bar[XB_TMO], 1u); break; } }
    }
    nloc = mine > 0u ? mine : 1u; nx = cnt > 0u ? cnt : 1u;
}
__device__ __forceinline__ void xcd_barrier(const XcdBarrier& b) {
    asm volatile("s_waitcnt vmcnt(0)" ::: "memory");
    __syncthreads();
    if (threadIdx.x == 0) {
        unsigned* bar = b.bar;
        __builtin_amdgcn_s_waitcnt(0);
        unsigned nloc = b.st[0], nx = b.st[1];
        if (nloc == 0u) { xcd_barrier_complete(bar, b.x, nloc, nx); b.st[0] = nloc; b.st[1] = nx; }
        const unsigned old = xb_add(&bar[XB_XSUB(b.x)], 1u);
        const unsigned gen = old / nloc;
        if (old + 1u == (gen + 1u) * nloc) {
            __builtin_amdgcn_fence(__ATOMIC_RELEASE, "agent");
            asm volatile("s_waitcnt vmcnt(0)" ::: "memory");
            const unsigned og = xb_add(&bar[XB_TOP], 1u);
            const unsigned tg = og / nx;
            if (og + 1u == (tg + 1u) * nx) xb_add(&bar[XB_TOPGEN], 1u);
            else XB_SPIN(xb_ld(&bar[XB_TOPGEN]) == tg, bar);
            __builtin_amdgcn_fence(__ATOMIC_ACQUIRE, "agent");
            xb_add(&bar[XB_XGEN(b.x)], 1u);
            asm volatile("s_waitcnt vmcnt(0)" ::: "memory");
        } else {
            XB_SPIN(xb_ld(&bar[XB_XGEN(b.x)]) == gen, bar);
            __builtin_amdgcn_fence(__ATOMIC_ACQUIRE, "agent");
            asm volatile("s_waitcnt vmcnt(0)" ::: "memory");
        }
    }
    __syncthreads();
}
#define LDS_WAIT() asm volatile("s_waitcnt lgkmcnt(0)" ::: "memory")
#define VM_WAIT() asm volatile("s_waitcnt vmcnt(0)" ::: "memory")
__device__ __forceinline__ float wave_sum(float v) {
#pragma unroll
    for (int o = 1; o < 64; o <<= 1) v += __shfl_xor(v, o);
    return v;
}
__device__ __forceinline__ float silu_f(float x) { return x / (1.f + __expf(-x)); }

__device__ __forceinline__ void modnorm_phase(const float* xlat, const float* xctx, float* xr_out, bf16* H, const float* g, const float* mxl, const float* bl,
                                              int which, int nrows, int gw, int NGW, int lane) {
    asm volatile("" : "+v"(lane));
    int cur_bs = -1; f32x4 gs[8], sh[8];
    const int csh = (which * 3) * D, csc = (which * 3 + 1) * D;
    for (int row = gw; row < nrows; row += NGW) {
        const int bs = row < SEQ ? 0 : (row < ML ? 1 : 2);
        if (bs != cur_bs) {
#pragma unroll
            for (int j = 0; j < 8; ++j) { const int col = 4 * lane + 256 * j;
                const f32x4 gg = *(const f32x4*)(g + col);
                const f32x4 sc = *(const f32x4*)(mxl + bs * NADA + csc + col) + *(const f32x4*)(bl + csc + col);
                sh[j] = *(const f32x4*)(mxl + bs * NADA + csh + col) + *(const f32x4*)(bl + csh + col);
                gs[j] = gg * (sc + 1.0f); }
            cur_bs = bs;
        }
        const float* src = row < ML ? xlat + (size_t)row * D : xctx + (size_t)(row - ML) * D;
        f32x4 v[8]; float s = 0.f;
#pragma unroll
        for (int j = 0; j < 8; ++j) { v[j] = *(const f32x4*)(src + 4 * lane + 256 * j); s += (v[j].x * v[j].x + v[j].y * v[j].y) + (v[j].z * v[j].z + v[j].w * v[j].w); }
        const float r = 1.0f / sqrtf(wave_sum(s) * (1.0f / D) + EPS);
        bf16* hrow = H + (size_t)row * D;
#pragma unroll
        for (int j = 0; j < 8; ++j) { const f32x4 o = v[j] * r * gs[j] + sh[j]; u32x2 w; w.x = cvt_pk_bf16(o.x, o.y); w.y = cvt_pk_bf16(o.z, o.w);
            *(u32x2*)(hrow + 4 * lane + 256 * j) = w; }
        if (xr_out) {
#pragma unroll
            for (int j = 0; j < 8; ++j) *(f32x4*)(xr_out + (size_t)row * D + 4 * lane + 256 * j) = v[j];
        }
    }
}

__device__ __forceinline__ void qknorm_rope_phase(bf16* QKV, const float* qg, const float* kg, const f32x2* rope, int nrows, int gw, int NGW, int lane) {
    asm volatile("" : "+v"(lane));
    const int hl = lane >> 4, dl = (lane & 15) * 8;
    for (int row = gw; row < nrows; row += NGW) {
        bf16* rp = QKV + (size_t)row * NQKV;
        const bool lat = row < ML; const int t = row & (SEQ - 1);
#pragma unroll
        for (int it = 0; it < 5; ++it) {
            const int head = it * 4 + hl; bf16* p = rp + head * HD + dl;
            const u32x4 raw = *(const u32x4*)p; float v[8];
#pragma unroll
            for (int e = 0; e < 4; ++e) { v[2 * e] = __uint_as_float(raw[e] << 16); v[2 * e + 1] = __uint_as_float(raw[e] & 0xffff0000u); }
            float s = 0.f;
#pragma unroll
            for (int e = 0; e < 8; ++e) s += v[e] * v[e];
            s += __shfl_xor(s, 1); s += __shfl_xor(s, 2); s += __shfl_xor(s, 4); s += __shfl_xor(s, 8);
            const float r = 1.0f / sqrtf(s * (1.0f / HD) + EPS);
            const float* gp = (it < 4 ? qg : kg) + dl;
            const f32x4 g0 = *(const f32x4*)gp, g1 = *(const f32x4*)(gp + 4);
#pragma unroll
            for (int e = 0; e < 4; ++e) { v[e] *= r * g0[e]; v[4 + e] *= r * g1[e]; }
            float o[8];
            if (lat) {
                const f32x2* cs = rope + (size_t)t * 64 + (dl & 63);
#pragma unroll
                for (int e = 0; e < 8; ++e) { const float pr = __shfl_xor(v[e], 8); const f32x2 c = cs[e]; o[e] = v[e] * c.x + ((lane & 8) ? pr : -pr) * c.y; }
            } else {
#pragma unroll
                for (int e = 0; e < 8; ++e) o[e] = v[e];
            }
            u32x4 w; w.x = cvt_pk_bf16(o[0], o[1]); w.y = cvt_pk_bf16(o[2], o[3]); w.z = cvt_pk_bf16(o[4], o[5]); w.w = cvt_pk_bf16(o[6], o[7]);
            *(u32x4*)p = w;
        }
    }
}

__device__ __forceinline__ int dst_row_map(int n, int mode) { return mode == 0 ? n : ((n >> 2) * 8 + (n & 3) + (mode == 2 ? 4 : 0)); }
__device__ __forceinline__ void transpose_item(const float* W, int K, int N, bf16* WT, int mode, LAS float* scr, int item, int lane) {
    const int nblk = N / 32, kb = item / nblk, nb = item % nblk, k0 = 64 * kb, n0 = 32 * nb;
    const int lr = lane >> 3, lc = (lane & 7) * 4;
    f32x4 t[8];
#pragma unroll
    for (int i = 0; i < 8; ++i) t[i] = *(const f32x4*)(W + (size_t)(k0 + 8 * i + lr) * N + n0 + lc);
#pragma unroll
    for (int i = 0; i < 8; ++i) { LAS float* s = scr + (8 * i + lr) * 33 + lc; s[0] = t[i].x; s[1] = t[i].y; s[2] = t[i].z; s[3] = t[i].w; }
    LDS_WAIT(); asm volatile("" ::: "memory");
    const int c = lane & 7;
#pragma unroll
    for (int j = 0; j < 4; ++j) { const int n = (lane >> 3) + 8 * j; const LAS float* s = scr + (8 * c) * 33 + n;
        u32x4 o; o.x = cvt_pk_bf16(s[0 * 33], s[1 * 33]); o.y = cvt_pk_bf16(s[2 * 33], s[3 * 33]); o.z = cvt_pk_bf16(s[4 * 33], s[5 * 33]); o.w = cvt_pk_bf16(s[6 * 33], s[7 * 33]);
        *(u32x4*)(WT + (size_t)dst_row_map(n0 + n, mode) * K + k0 + 8 * c) = o; }
    LDS_WAIT(); asm volatile("" ::: "memory");
}
struct TrJob { const float* W; bf16* WT; int K, N, mode, nitems; };
struct KArgs { const float* in[21]; float* out; unsigned char* ws; int ph_lo, ph_hi; };
enum { I_X = 0, I_C, I_CTX, I_CCTX, I_WADA, I_BADA, I_NORMG, I_WG, I_WU, I_WD, I_WQKV, I_WO, I_QG, I_KG, I_SINK, I_WF, I_WSI, I_SVG, I_WSS, I_BSS, I_WSOUT };
constexpr int CW_QUEUE = 64;
constexpr int TR_FFN = 5632, TR_TOTAL = 98304, IT_F = 384, IT_DC = 256, IT_FC = 256, IT_ROPE = 1024, IT_TOTAL = TR_TOTAL + IT_F + IT_DC + IT_FC + IT_ROPE;
constexpr float F_SCALE_LAT = 0.00069053396600248786f;
constexpr float F_SCALE_CTX = 0.00390625f;

__device__ __forceinline__ void prologue_item(const KArgs& a, int r, LAS float* scr, int lane) {
    unsigned char* ws = a.ws;
    if (r < TR_TOTAL) {
        if (r < 12 * TR_FFN) { const int kind = r / (4 * TR_FFN), l = (r / TR_FFN) & 3, it = r % TR_FFN;
            if (kind == 0)      transpose_item(a.in[I_WG] + (size_t)l * D * DFF, D, DFF, (bf16*)(ws + WS_WGU + (size_t)l * 44 * MiB), 1, scr, it, lane);
            else if (kind == 1) transpose_item(a.in[I_WU] + (size_t)l * D * DFF, D, DFF, (bf16*)(ws + WS_WGU + (size_t)l * 44 * MiB), 2, scr, it, lane);
            else                transpose_item(a.in[I_WD] + (size_t)l * DFF * D, DFF, D, (bf16*)(ws + WS_WDN + (size_t)l * 22 * MiB), 0, scr, it, lane);
            return; }
        r -= 12 * TR_FFN;
        if (r < 6144) { const int j = r / 3072; transpose_item(a.in[I_WQKV] + (size_t)j * D * NQKV, D, NQKV, (bf16*)(ws + WS_WQKV + (size_t)j * 12 * MiB), 0, scr, r % 3072, lane); return; }
        r -= 6144;
        if (r < 4096) { const int j = r / 2048; transpose_item(a.in[I_WO] + (size_t)j * HQ * D, HQ, D, (bf16*)(ws + WS_WO + (size_t)j * 8 * MiB), 0, scr, r % 2048, lane); return; }
        r -= 4096;
        if (r < 2048) { transpose_item(a.in[I_WF], D, D, (bf16*)(ws + WS_WF), 0, scr, r, lane); return; }
        r -= 2048;
        if (r < 12288) { transpose_item(a.in[I_WSI], D, 2 * SGH, (bf16*)(ws + WS_WSI), 0, scr, r, lane); return; }
        r -= 12288;
        transpose_item(a.in[I_WSOUT], SGH, D, (bf16*)(ws + WS_WSO), 0, scr, r, lane); return;
    }
    r -= TR_TOTAL;
    if (r < IT_F) {
        float v[8];
        if (r < 128) {
            const int e0 = r * 512 + lane * 8, i = e0 >> 8, kk0 = e0 & 255, rp = i >> 7, cp = (i >> 6) & 1, k1 = i & 63;
#pragma unroll
            for (int e = 0; e < 8; ++e) { const int kk = kk0 + e, cpi = kk >> 7, re = (kk >> 6) & 1, t1 = kk & 63; const float fr = (float)((k1 * t1) & 63) * (1.0f / 64.0f);
                float c = (rp == re) ? __builtin_amdgcn_cosf(fr) : -__builtin_amdgcn_sinf(fr); if (rp == 1 && re == 1) c = -c; v[e] = (cp == cpi) ? c : 0.f; }
            u32x4 w; w.x = cvt_pk_bf16(v[0], v[1]); w.y = cvt_pk_bf16(v[2], v[3]); w.z = cvt_pk_bf16(v[4], v[5]); w.w = cvt_pk_bf16(v[6], v[7]);
            *(u32x4*)((bf16*)(ws + WS_DA) + e0) = w;
        } else {
            const int e0 = (r - 128) * 512 + lane * 8, i = e0 >> 9, kk0 = e0 & 511, cp = i >> 7, k2 = i & 127;
#pragma unroll
            for (int e = 0; e < 8; ++e) { const int kk = kk0 + e, cpi = kk >> 8, re = (kk >> 7) & 1, t2 = kk & 127; const float fr = (float)((k2 * t2) & 127) * (1.0f / 128.0f);
                const float c = re ? __builtin_amdgcn_sinf(fr) : __builtin_amdgcn_cosf(fr); v[e] = (cp == cpi) ? F_SCALE_LAT * c : 0.f; }
            u32x4 w; w.x = cvt_pk_bf16(v[0], v[1]); w.y = cvt_pk_bf16(v[2], v[3]); w.z = cvt_pk_bf16(v[4], v[5]); w.w = cvt_pk_bf16(v[6], v[7]);
            *(u32x4*)((bf16*)(ws + WS_DB) + e0) = w;
        }
        return; }
    r -= IT_F;
    if (r < IT_DC) {
        const int e0 = r * 512 + lane * 8, row = e0 >> 8, c0 = e0 & 255, m = row & 255, reim = row >> 8; float v[8];
#pragma unroll
        for (int e = 0; e < 8; ++e) { const float fr = (float)((m * (c0 + e)) & 255) * (1.0f / 256.0f); v[e] = reim ? __builtin_amdgcn_sinf(fr) : __builtin_amdgcn_cosf(fr); }
        u32x4 w; w.x = cvt_pk_bf16(v[0], v[1]); w.y = cvt_pk_bf16(v[2], v[3]); w.z = cvt_pk_bf16(v[4], v[5]); w.w = cvt_pk_bf16(v[6], v[7]);
        *(u32x4*)((bf16*)(ws + WS_DC2) + e0) = w; return; }
    r -= IT_DC;
    if (r < IT_FC) {
        const int e0 = r * 512 + lane * 8, k = e0 >> 9, c0 = e0 & 511, reim = c0 >> 8, l0 = c0 & 255; float v[8];
#pragma unroll
        for (int e = 0; e < 8; ++e) { const int idx = ((k * (l0 + e)) + reim * 64) & 255; v[e] = F_SCALE_CTX * __builtin_amdgcn_cosf((float)idx * (1.0f / 256.0f)); }
        u32x4 w; w.x = cvt_pk_bf16(v[0], v[1]); w.y = cvt_pk_bf16(v[2], v[3]); w.z = cvt_pk_bf16(v[4], v[5]); w.w = cvt_pk_bf16(v[6], v[7]);
        *(u32x4*)((bf16*)(ws + WS_FC) + e0) = w; return; }
    r -= IT_FC;
    {
        f32x2* dst = (f32x2*)(ws + WS_ROPE) + (size_t)r * 512 + lane * 8;
#pragma unroll
        for (int e = 0; e < 8; ++e) { const int idx = r * 512 + lane * 8 + e, t = idx >> 6, f = idx & 63;
            const float inv = __builtin_amdgcn_exp2f(-(float)(f & 31) * (13.287712379549449f / 32.0f));
            const float ang = (float)(f < 32 ? (t >> 6) : (t & 63)) * inv, rev = ang * 0.15915494309189535f;
            dst[e] = (f32x2){__builtin_amdgcn_cosf(rev), __builtin_amdgcn_sinf(rev)}; }
    }
}

__device__ __forceinline__ void prologue_phase(const KArgs& a, LAS unsigned char* lds, gu32* ctl, int tid, int lane, int wave) {
    asm volatile("" : "+v"(tid), "+v"(lane));
    if (blockIdx.x < 192) {
        const int l = blockIdx.x / 48, jb = blockIdx.x % 48;
        LAS float* sl = (LAS float*)lds;
        LAS float* part = (LAS float*)(lds + 24576);
        for (int i = tid; i < 3 * D; i += 512) { const int r = i / D, k = i % D; const float cv = r < 2 ? a.in[I_C][r * D + k] : a.in[I_CCTX][k]; sl[i] = silu_f(cv); }
        __syncthreads();
        const float* wp = a.in[I_WADA] + ((size_t)l * D + wave * 256) * NADA + jb * 256 + 4 * lane;
        f32x4 a0 = {0.f, 0.f, 0.f, 0.f}, a1 = a0, a2 = a0;
        for (int k = 0; k < 256; k += 8) { f32x4 w[8];
#pragma unroll
            for (int e = 0; e < 8; ++e) w[e] = *(const f32x4*)(wp + (size_t)(k + e) * NADA);
#pragma unroll
            for (int e = 0; e < 8; ++e) { const int kk = wave * 256 + k + e; a0 += w[e] * sl[kk]; a1 += w[e] * sl[D + kk]; a2 += w[e] * sl[2 * D + kk]; } }
        *(LAS f32x4*)(part + (wave * 3 + 0) * 256 + 4 * lane) = a0; *(LAS f32x4*)(part + (wave * 3 + 1) * 256 + 4 * lane) = a1; *(LAS f32x4*)(part + (wave * 3 + 2) * 256 + 4 * lane) = a2;
        __syncthreads();
        for (int i = tid; i < 768; i += 512) { const int r = i >> 8, j = i & 255; float s = 0.f;
#pragma unroll
            for (int w = 0; w < 8; ++w) s += part[(w * 3 + r) * 256 + j];
            ((float*)(a.ws + WS_MX))[((size_t)l * 3 + r) * NADA + jb * 256 + j] = s; }
        __syncthreads();
    }
    LAS float* scr = (LAS float*)(lds + wave * 16384);
    for (;;) {
        unsigned base = 0; if (lane == 0) base = __hip_atomic_fetch_add((unsigned*)(ctl + CW_QUEUE), 8u, RLX_AGENT);
        base = (unsigned)__builtin_amdgcn_readfirstlane((int)base);
        if (base >= (unsigned)IT_TOTAL) break;
        for (int i = 0; i < 8; ++i) { const int it = (int)base + i; if (it < IT_TOTAL) prologue_item(a, it, scr, lane); }
    }
}
namespace attn {
constexpr float SCALE = 0.08838834764831845f;
constexpr float THR = 8.f;
constexpr int SHM_K = 64 * 128 * 2, SHM_V = 64 * 128 * 2;
constexpr int OFF_V = 0, OFF_K = 2 * SHM_V, OFF_WS = 2 * SHM_V + 2 * SHM_K, LDS_BYTES = OFF_WS + 8 * 64 * 4;
#define KSWZ(row, colB) ((row) * 256 + ((colB) ^ (((row) & 7) << 4)))
#define SBAR() __builtin_amdgcn_sched_barrier(0)
__device__ __forceinline__ int v_st(int k, int c) { const int kk = (k & ~0xC) | ((k & 4) << 1) | ((k & 8) >> 1); return ((kk >> 3) * 4 + (c >> 5)) * 512 + ((kk & 7) * 32 + (c & 31)) * 2; }
__device__ __forceinline__ int v_rd_base(int lane) { return ((lane & 3) << 3) | (((lane >> 2) & 3) << 6) | (((lane >> 4) & 1) << 5) | (((lane >> 5) & 1) << 8); }
__device__ __forceinline__ int crow(int r, int hi) { return (r & 3) + 8 * (r >> 2) + 4 * hi; }
__device__ __forceinline__ void mask_tile(f32x16& p0, f32x16& p1, int dq, unsigned W) {
    const float NEG = -__builtin_inff();
#pragma unroll
    for (int r = 0; r < 16; ++r) { const int c = (r & 3) + 8 * (r >> 2);
        if ((unsigned)(dq - c) >= W) p0[r] = NEG;
        if ((unsigned)(dq - c - 32) >= W) p1[r] = NEG; }
}
__device__ __forceinline__ void partialSM(f32x16& p0, f32x16& p1, float& m_reg, float& mn, float& alpha) {
    float pmax = p0[0];
#pragma unroll
    for (int r = 1; r < 16; ++r) pmax = fmaxf(pmax, p0[r]);
#pragma unroll
    for (int r = 0; r < 16; ++r) pmax = fmaxf(pmax, p1[r]);
    { auto rr = __builtin_amdgcn_permlane32_swap(__float_as_uint(pmax), __float_as_uint(pmax), false, false);
      pmax = fmaxf(__uint_as_float(rr[0]), __uint_as_float(rr[1])); }
    constexpr float C2 = 1.4426950408889634f * SCALE;
    if (__builtin_expect(__all((pmax - m_reg) * SCALE <= THR), 1)) { mn = m_reg; alpha = 1.f; }
    else { mn = fmaxf(m_reg, pmax); alpha = __builtin_amdgcn_exp2f((m_reg - mn) * C2); m_reg = mn; }
    const float mnL = -mn * C2;
#pragma unroll
    for (int r = 0; r < 16; ++r) p0[r] = fmaf(p0[r], C2, mnL);
#pragma unroll
    for (int r = 0; r < 16; ++r) p1[r] = fmaf(p1[r], C2, mnL);
#pragma unroll
    for (int r = 0; r < 16; ++r) p0[r] = __builtin_amdgcn_exp2f(p0[r]);
}
__device__ __forceinline__ void finishSM(f32x16& p0, f32x16& p1, float alpha, float& l_reg, bf16x8& pa0, bf16x8& pa1, bf16x8& pa2, bf16x8& pa3) {
#pragma unroll
    for (int r = 0; r < 16; ++r) p1[r] = __builtin_amdgcn_exp2f(p1[r]);
    float ps = 0;
#pragma unroll
    for (int r = 0; r < 16; ++r) ps += p0[r];
#pragma unroll
    for (int r = 0; r < 16; ++r) ps += p1[r];
    { auto rr = __builtin_amdgcn_permlane32_swap(__float_as_uint(ps), __float_as_uint(ps), false, false);
      ps = __uint_as_float(rr[0]) + __uint_as_float(rr[1]); }
    l_reg = l_reg * alpha + ps;
#define PK4(P, B_, OUT) do { unsigned a0 = cvt_pk_bf16(P[B_+0], P[B_+1]), a1 = cvt_pk_bf16(P[B_+2], P[B_+3]);                          \
        unsigned b0 = cvt_pk_bf16(P[B_+4], P[B_+5]), b1 = cvt_pk_bf16(P[B_+6], P[B_+7]);                                             \
        auto r0 = __builtin_amdgcn_permlane32_swap(a0, b0, false, false); auto r1 = __builtin_amdgcn_permlane32_swap(a1, b1, false, false); \
        u32x4 w = {r0[0], r1[0], r0[1], r1[1]}; OUT = *reinterpret_cast<bf16x8*>(&w); } while (0)
    PK4(p0, 0, pa0); PK4(p0, 8, pa1); PK4(p1, 0, pa2); PK4(p1, 8, pa3);
#undef PK4
}
template <int KB>
__device__ __forceinline__ void qkt(f32x16& p0, f32x16& p1, const char* K_lds, int r32, int hi, const bf16x8* qr) {
    p0 = f32x16{}; p1 = f32x16{};
    const char* kb[4];
#pragma unroll
    for (int dd = 0; dd < 4; ++dd) kb[dd] = K_lds + KB * SHM_K + KSWZ(r32, (dd * 16 + hi * 8) * 2);
#pragma unroll
    for (int d0 = 0; d0 < 8; ++d0) { const char* a = kb[d0 & 3] + (d0 >> 2) * 128;
        bf16x8 b0 = *reinterpret_cast<const bf16x8*>(a);
        bf16x8 b1 = *reinterpret_cast<const bf16x8*>(a + 32 * 256);
        p0 = __builtin_amdgcn_mfma_f32_32x32x16_bf16(b0, qr[d0], p0, 0, 0, 0);
        p1 = __builtin_amdgcn_mfma_f32_32x32x16_bf16(b1, qr[d0], p1, 0, 0, 0); }
}
#define TRRD(dst, off) asm volatile("ds_read_b64_tr_b16 %0, %1 offset:%2" : "=&v"(dst) : "v"(vb0), "i"(off) : "memory")
#define PV_D0(oacc, vbuf, d0, pa0, pa1, pa2, pa3) do { s16x4 l0, l1, l2, l3, h0, h1, h2, h3; constexpr int b_ = (vbuf) + (d0) * 512; \
        TRRD(l0, b_); TRRD(h0, b_ + 2048); TRRD(l1, b_ + 4096); TRRD(h1, b_ + 6144); TRRD(l2, b_ + 8192); TRRD(h2, b_ + 10240); TRRD(l3, b_ + 12288); TRRD(h3, b_ + 14336); \
        asm volatile("s_waitcnt lgkmcnt(0)" ::: "memory"); SBAR(); \
        oacc = __builtin_amdgcn_mfma_f32_32x32x16_bf16(pa0, (bf16x8){l0[0], l0[1], l0[2], l0[3], h0[0], h0[1], h0[2], h0[3]}, oacc, 0, 0, 0);   \
        oacc = __builtin_amdgcn_mfma_f32_32x32x16_bf16(pa1, (bf16x8){l1[0], l1[1], l1[2], l1[3], h1[0], h1[1], h1[2], h1[3]}, oacc, 0, 0, 0);   \
        oacc = __builtin_amdgcn_mfma_f32_32x32x16_bf16(pa2, (bf16x8){l2[0], l2[1], l2[2], l2[3], h2[0], h2[1], h2[2], h2[3]}, oacc, 0, 0, 0);   \
        oacc = __builtin_amdgcn_mfma_f32_32x32x16_bf16(pa3, (bf16x8){l3[0], l3[1], l3[2], l3[3], h3[0], h3[1], h3[2], h3[3]}, oacc, 0, 0, 0); } while (0)
template <int VB>
__device__ __forceinline__ void pv_tile(f32x16* o, int vb0, bf16x8 pa0, bf16x8 pa1, bf16x8 pa2, bf16x8 pa3) {
    PV_D0(o[0], VB * SHM_V, 0, pa0, pa1, pa2, pa3); PV_D0(o[1], VB * SHM_V, 1, pa0, pa1, pa2, pa3);
    PV_D0(o[2], VB * SHM_V, 2, pa0, pa1, pa2, pa3); PV_D0(o[3], VB * SHM_V, 3, pa0, pa1, pa2, pa3);
}

struct AUnit { int qrow0, klat0, kctx0, kh, tb; };

__device__ __forceinline__ void attn_unit(const bf16* QKV, bf16* AO, const float* sink, const AUnit u, char* lds) {
    int tid = threadIdx.x; asm volatile("" : "+v"(tid));
    const int wid = __builtin_amdgcn_readfirstlane(tid >> 6), lane = tid & 63, r32 = lane & 31, hi = lane >> 5;
    const int hq = u.kh * 4 + (wid >> 1), half = wid & 1;
    char* V_lds = lds + OFF_V; char* K_lds = lds + OFF_K;
    float* wsc = (float*)(lds + OFF_WS) + wid * 64; float* li_l = wsc; float* al_l = wsc + 32;
    const int sr = tid >> 4, sc = (tid & 15) * 8, vst0 = v_st(sr, sc), vst1 = v_st(32 + sr, sc), kws = KSWZ(sr, sc * 2);
    const int vb0 = (int)(uintptr_t)V_lds + v_rd_base(lane);
    int jlo = 0, nwin = 0;
    if (u.tb >= 0) { jlo = u.tb - 2 < 0 ? 0 : u.tb - 2; const int jhi = u.tb + 2 > SEQ / 64 - 1 ? SEQ / 64 - 1 : u.tb + 2; nwin = jhi - jlo + 1; }
    const int NT = 4 + nwin;
    const bf16* kvbase = QKV + HQ + u.kh * HD + sc;
    bf16x8 st_k0, st_k1, st_v0, st_v1;
#define A_KROW(t) ((t) < 4 ? u.kctx0 + 64 * (t) : u.klat0 + 64 * (jlo + (t) - 4))
#define A_LOAD(t) do { const bf16* p_ = kvbase + (size_t)(A_KROW(t) + sr) * NQKV; st_k0 = *(const bf16x8*)p_; st_k1 = *(const bf16x8*)(p_ + (size_t)32 * NQKV); \
                       st_v0 = *(const bf16x8*)(p_ + HKV); st_v1 = *(const bf16x8*)(p_ + (size_t)32 * NQKV + HKV); } while (0)
#define A_WRITE(bf) do { *(bf16x8*)(K_lds + (bf) * SHM_K + kws) = st_k0; *(bf16x8*)(K_lds + (bf) * SHM_K + kws + 32 * 256) = st_k1; \
                         *(bf16x8*)(V_lds + (bf) * SHM_V + vst0) = st_v0; *(bf16x8*)(V_lds + (bf) * SHM_V + vst1) = st_v1; } while (0)
    A_LOAD(0);
    bf16x8 qr[8];
    { const bf16* qp = QKV + (size_t)(u.qrow0 + 32 * half + r32) * NQKV + hq * HD + hi * 8;
#pragma unroll
      for (int d0 = 0; d0 < 8; ++d0) qr[d0] = *(const bf16x8*)(qp + d0 * 16); }
    float m_reg = sink[hq] * (1.0f / SCALE), l_reg = 1.0f; f32x16 o[4] = {};
    const int qpos128 = 64 * u.tb + 32 * half + r32 + 128 - 4 * hi;
    VM_WAIT(); A_WRITE(0);
    __syncthreads();
#define A_RESC(a) do { if (__any((a) < 1.f)) { if (hi == 0) al_l[r32] = (a); asm volatile("s_waitcnt lgkmcnt(0)" ::: "memory");              \
                     _Pragma("unroll") for (int d_ = 0; d_ < 4; ++d_) _Pragma("unroll") for (int r = 0; r < 16; ++r) o[d_][r] *= al_l[crow(r, hi)]; } } while (0)
#define A_COMPUTE(BUF, t) do { f32x16 p0, p1; float mn, alpha; bf16x8 pa0, pa1, pa2, pa3; \
        qkt<BUF>(p0, p1, K_lds, r32, hi, qr); \
        if ((t) >= 4) { const int blk = jlo + (t) - 4; if (blk == u.tb - 2 || blk == u.tb + 2) mask_tile(p0, p1, qpos128 - 64 * blk, 257u); } \
        partialSM(p0, p1, m_reg, mn, alpha); A_RESC(alpha); finishSM(p0, p1, alpha, l_reg, pa0, pa1, pa2, pa3); SBAR(); \
        pv_tile<BUF>(o, vb0, pa0, pa1, pa2, pa3); } while (0)
    for (int t = 0; t < NT; t += 2) {
        if (t + 1 < NT) A_LOAD(t + 1);
        A_COMPUTE(0, t);
        if (t + 1 < NT) { VM_WAIT(); A_WRITE(1); }
        __syncthreads();
        if (t + 1 >= NT) break;
        if (t + 2 < NT) A_LOAD(t + 2);
        A_COMPUTE(1, t + 1);
        if (t + 2 < NT) { VM_WAIT(); A_WRITE(0); }
        __syncthreads();
    }
    if (hi == 0) li_l[r32] = l_reg; asm volatile("s_waitcnt lgkmcnt(0)" ::: "memory");
    bf16* Ow = AO + (size_t)(u.qrow0 + 32 * half) * D + hq * HD;
#pragma unroll
    for (int r = 0; r < 16; ++r) { const int orow = crow(r, hi); const float rl = __builtin_amdgcn_rcpf(li_l[orow]);
#pragma unroll
        for (int d0 = 0; d0 < 4; ++d0) { const float v = o[d0][r] * rl; const float vn = __shfl_xor(v, 1);
            if ((r32 & 1) == 0) *(unsigned*)(Ow + (size_t)orow * D + d0 * 32 + r32) = cvt_pk_bf16(v, vn); } }
    asm volatile("s_waitcnt lgkmcnt(0)" ::: "memory");
    __syncthreads();
#undef A_KROW
#undef A_LOAD
#undef A_WRITE
#undef A_RESC
#undef A_COMPUTE
}

__device__ __forceinline__ void attn_phase(const bf16* QKV, bf16* AO, const float* sink, bool with_ctx, int vcu, int G, char* lds) {
    for (int uid = vcu * 4; uid < 1024; uid += G * 4) {
        for (int i = 0; i < 4; ++i) { const int id = uid + i, bk = id >> 7, b = bk >> 2; AUnit u; u.kh = bk & 3; u.tb = id & 127;
            u.qrow0 = b * SEQ + 64 * u.tb; u.klat0 = b * SEQ; u.kctx0 = ML + b * CTXL; attn_unit(QKV, AO, sink, u, lds); }
    }
    if (with_ctx) for (int id = vcu; id < 32; id += G) { AUnit u; const int b = id >> 4; u.kh = (id >> 2) & 3; u.tb = -1; u.qrow0 = ML + b * CTXL + 64 * (id & 3); u.klat0 = 0; u.kctx0 = ML + b * CTXL;
        attn_unit(QKV, AO, sink, u, lds); }
}

__device__ __forceinline__ void sgu_unit(bf16* Z, const float* ssq, const float* wsp, const float* bsp, const float* gvv, int chunk, int g, char* lds) {
    int tid = threadIdx.x; asm volatile("" : "+v"(tid));
    const int wid = __builtin_amdgcn_readfirstlane(tid >> 6), lane = tid & 63, r32 = lane & 31, hi = lane >> 5;
    const int pb = wid & 3, dh = wid >> 2, R0 = chunk * 128;
    char* V_lds = lds;
    const int sr = tid >> 4, sc = (tid & 15) * 8, vst0 = v_st(sr, sc), vst1 = v_st(32 + sr, sc);
    const int vb0 = (int)(uintptr_t)V_lds + v_rd_base(lane);
    bf16x8 pa[8];
    { const float* wrow = wsp + ((size_t)(g * 128 + pb * 32 + r32)) * 128 + 8 * hi; const float* sq = ssq + R0 + 8 * hi;
#pragma unroll
      for (int ks = 0; ks < 8; ++ks) { const f32x4 w0 = *(const f32x4*)(wrow + ks * 16), w1 = *(const f32x4*)(wrow + ks * 16 + 4); const f32x4 s0 = *(const f32x4*)(sq + ks * 16), s1 = *(const f32x4*)(sq + ks * 16 + 4);
          float v[8];
#pragma unroll
          for (int e = 0; e < 4; ++e) { v[e] = w0[e] / sqrtf(s0[e] * (1.0f / SGH) + EPS); v[4 + e] = w1[e] / sqrtf(s1[e] * (1.0f / SGH) + EPS); }
          u32x4 w; w.x = cvt_pk_bf16(v[0], v[1]); w.y = cvt_pk_bf16(v[2], v[3]); w.z = cvt_pk_bf16(v[4], v[5]); w.w = cvt_pk_bf16(v[6], v[7]); pa[ks] = *reinterpret_cast<bf16x8*>(&w); } }
    float bias[16];
#pragma unroll
    for (int r = 0; r < 16; ++r) bias[r] = bsp[g * 128 + pb * 32 + crow(r, hi)];
    const bf16* vsrc = Z + (size_t)(R0 + sr) * (2 * SGH) + SGH + g * SGG + sc;
    bf16x8 s00, s01, s10, s11;
#define S_LOAD(db) do { const bf16* p_ = vsrc + (db) * 128; s00 = *(const bf16x8*)p_; s01 = *(const bf16x8*)(p_ + (size_t)32 * 2 * SGH); \
                        s10 = *(const bf16x8*)(p_ + (size_t)64 * 2 * SGH); s11 = *(const bf16x8*)(p_ + (size_t)96 * 2 * SGH); } while (0)
#define S_WRITE() do { *(bf16x8*)(V_lds + vst0) = s00; *(bf16x8*)(V_lds + vst1) = s01; *(bf16x8*)(V_lds + SHM_V + vst0) = s10; *(bf16x8*)(V_lds + SHM_V + vst1) = s11; } while (0)
    S_LOAD(0);
    for (int db = 0; db < 6; ++db) {
        VM_WAIT(); S_WRITE();
        __syncthreads();
        if (db + 1 < 6) S_LOAD(db + 1);
        f32x16 o0 = {}, o1 = {};
        if (dh == 0) { PV_D0(o0, 0, 0, pa[0], pa[1], pa[2], pa[3]); PV_D0(o0, SHM_V, 0, pa[4], pa[5], pa[6], pa[7]); PV_D0(o1, 0, 1, pa[0], pa[1], pa[2], pa[3]); PV_D0(o1, SHM_V, 1, pa[4], pa[5], pa[6], pa[7]); }
        else         { PV_D0(o0, 0, 2, pa[0], pa[1], pa[2], pa[3]); PV_D0(o0, SHM_V, 2, pa[4], pa[5], pa[6], pa[7]); PV_D0(o1, 0, 3, pa[0], pa[1], pa[2], pa[3]); PV_D0(o1, SHM_V, 3, pa[4], pa[5], pa[6], pa[7]); }
        const int colb = g * SGG + db * 128 + dh * 64 + r32; const float gv0 = gvv[colb], gv1 = gvv[colb + 32];
        bf16* up = Z + (size_t)(R0 + pb * 32) * (2 * SGH) + colb;
#pragma unroll
        for (int r = 0; r < 16; ++r) { const int p = crow(r, hi); const float t0 = gv0 * o0[r] + bias[r], t1 = gv1 * o1[r] + bias[r];
            const float t0n = __shfl_xor(t0, 1), t1n = __shfl_xor(t1, 1);
            if ((r32 & 1) == 0) { unsigned* q0 = (unsigned*)(up + (size_t)p * (2 * SGH)); unsigned* q1 = (unsigned*)(up + (size_t)p * (2 * SGH) + 32);
                const unsigned ua = *q0, ub = *q1;
                *q0 = cvt_pk_bf16(__uint_as_float(ua << 16) * t0, __uint_as_float(ua & 0xffff0000u) * t0n);
                *q1 = cvt_pk_bf16(__uint_as_float(ub << 16) * t1, __uint_as_float(ub & 0xffff0000u) * t1n); } }
        __syncthreads();
    }
#undef S_LOAD
#undef S_WRITE
}
#undef TRRD
}
constexpr int NWAVES = 8;
constexpr int RING_BYTES = 131072, LDSCTL_OFF = RING_BYTES, LDS_BYTES = 147456;
constexpr int NPH = 32;

struct Ctx { KArgs a; LAS unsigned char* lds; gu32* ctl; XcdBarrier bar; int tid, lane, wave, vcu, G, gw, NGW, lo, hi; };
#define PH_IN(k) (C.lo <= (k) && (k) < C.hi)
#define PH_SEAM(k) do { if (!MK_PER_PHASE && (k) + 1 < C.hi) xcd_barrier(C.bar); } while (0)
#define WSP(T, off) ((T*)(C.a.ws + (off)))

struct SchedF {
    const char* A; const char* B; int mode, G, c;
    __device__ __forceinline__ bool next(int i, pg8::Unit& u) const {
        const int L = i * G + c; u.pm = 0; u.pn = 0;
        if (mode == 0) { if (L >= 1024) return false; const int b = L >> 9, rem = L & 511, gr = rem & 15, tq = rem >> 4, g = gr >> 1, reim = gr & 1;
            u.a = A + (size_t)reim * 256 * 256 * 2; u.b = B + ((size_t)(b * SEQ + 4 * tq) * D + g * 256) * 2;
            u.o = ((((long)(b * 128 + 4 * tq) * 1024 + (g & 3) * 256) * 2 + (g >> 2)) * 2 + reim) * 64; return true; }
        if (mode == 1) { if (L >= 32) return false; const int b = L >> 4, gr = L & 15, g = gr >> 1, reim = gr & 1;
            u.a = A + (size_t)reim * 256 * 256 * 2; u.b = B + ((size_t)(ML + b * CTXL) * D + g * 256) * 2; u.o = (long)(b * D + g * 256) * 512 + reim * 256; return true; }
        if (mode == 2) { if (L >= 1024) return false; const int b = L >> 9, cp = L & 511;
            u.a = A; u.b = B + ((size_t)b * 33554432 + (size_t)cp * 512) * 2; u.o = (long)b * 33554432 + (long)cp * 1024; return true; }
        if (mode == 3) { if (L >= 512) return false; const int b = L >> 8, k1 = (L >> 2) & 63, cb = L & 3;
            u.a = A; u.b = B + ((size_t)(b * 64 + k1) * 1024 + cb * 256) * 512 * 2; u.o = (long)(b * SEQ + k1) * D + cb * 256; return true; }
        if (L >= 16) return false; { const int b = L >> 3, pn = L & 7;
            u.a = A; u.b = B + (size_t)(b * D + pn * 256) * 512 * 2; u.o = (long)(ML + b * CTXL) * D + pn * 256; return true; }
    }
};

template <int PH0> __device__ __forceinline__ void ffn_block(Ctx& C, int l, int nM) {
    const float* mxl = WSP(const float, WS_MX) + (size_t)l * 3 * NADA; const float* bl = C.a.in[I_BADA] + (size_t)l * NADA;
    float* XR = WSP(float, WS_XR); bf16* H = WSP(bf16, WS_H); bf16* Gb = WSP(bf16, WS_AR + AR_G);
    if (PH_IN(PH0)) { modnorm_phase(XR, XR + (size_t)ML * D, nullptr, H, C.a.in[I_NORMG] + (size_t)(l * 2 + 1) * D, mxl, bl, 1, nM * 256, C.gw, C.NGW, C.lane); PH_SEAM(PH0); }
    if (PH_IN(PH0 + 1)) { const pg8::SchedRC S = pg8::make_rc(H, D, WSP(const bf16, WS_WGU + (size_t)l * 44 * MiB), D, nM, 44, DFF, 128, C.G, (int)blockIdx.x);
        const pg8::EpiSwiGLU E{Gb, DFF};
        pg8::gemm_phase<pg8::EpiSwiGLU, pg8::SchedRC>(C.lds, pg8::mk_gemm(D, D, D), S, E); PH_SEAM(PH0 + 1); }
    if (PH_IN(PH0 + 2)) { const pg8::SchedRC S = pg8::make_rc(Gb, DFF, WSP(const bf16, WS_WDN + (size_t)l * 22 * MiB), DFF, nM, 8, D, 256, C.G, (int)blockIdx.x);
        const pg8::EpiRes E{XR, l == DEPTH - 1 ? C.a.out : XR, mxl + 5 * D, bl + 5 * D};
        pg8::gemm_phase<pg8::EpiRes, pg8::SchedRC>(C.lds, pg8::mk_gemm(DFF, DFF, DFF), S, E); PH_SEAM(PH0 + 2); }
}

template <int PH0> __device__ __forceinline__ void attn_block(Ctx& C, int l, int j, bool first, bool ctx_out) {
    const float* mxl = WSP(const float, WS_MX) + (size_t)l * 3 * NADA; const float* bl = C.a.in[I_BADA] + (size_t)l * NADA;
    float* XR = WSP(float, WS_XR); bf16* H = WSP(bf16, WS_H); bf16* QKV = WSP(bf16, WS_AR + AR_QKV); bf16* AO = WSP(bf16, WS_AR + AR_AO);
    if (PH_IN(PH0)) { modnorm_phase(first ? C.a.in[I_X] : XR, first ? C.a.in[I_CTX] : XR + (size_t)ML * D, first ? XR : nullptr, H, C.a.in[I_NORMG] + (size_t)(l * 2) * D, mxl, bl, 0, MT, C.gw, C.NGW, C.lane); PH_SEAM(PH0); }
    if (PH_IN(PH0 + 1)) { const pg8::SchedRC S = pg8::make_rc(H, D, WSP(const bf16, WS_WQKV + (size_t)j * 12 * MiB), D, 66, 12, NQKV, 256, C.G, (int)blockIdx.x);
        const pg8::EpiBf16<0, false> E{QKV, NQKV, nullptr, 0};
        pg8::gemm_phase<pg8::EpiBf16<0, false>, pg8::SchedRC>(C.lds, pg8::mk_gemm(D, D, D), S, E); PH_SEAM(PH0 + 1); }
    if (PH_IN(PH0 + 2)) { qknorm_rope_phase(QKV, C.a.in[I_QG] + j * HD, C.a.in[I_KG] + j * HD, WSP(const f32x2, WS_ROPE), MT, C.gw, C.NGW, C.lane); PH_SEAM(PH0 + 2); }
    if (PH_IN(PH0 + 3)) { attn::attn_phase(QKV, AO, C.a.in[I_SINK] + j * NH, ctx_out, C.vcu, C.G, (char*)C.lds); PH_SEAM(PH0 + 3); }
    if (PH_IN(PH0 + 4)) { const pg8::SchedRC S = pg8::make_rc(AO, D, WSP(const bf16, WS_WO + (size_t)j * 8 * MiB), D, ctx_out ? 66 : 64, 8, D, 256, C.G, (int)blockIdx.x);
        const pg8::EpiRes E{XR, XR, mxl + 2 * D, bl + 2 * D};
        pg8::gemm_phase<pg8::EpiRes, pg8::SchedRC>(C.lds, pg8::mk_gemm(D, D, D), S, E); PH_SEAM(PH0 + 4); }
}

__global__ void __launch_bounds__(NWAVES * 64, 2) mega(KArgs args) {
    extern __shared__ __attribute__((aligned(16))) unsigned char lds_raw[];
    Ctx C; C.a = args; C.lds = (LAS unsigned char*)lds_raw; C.ctl = (gu32*)(args.ws + WS_CTL);
    C.tid = threadIdx.x; C.lane = C.tid & 63; C.wave = __builtin_amdgcn_readfirstlane(C.tid >> 6);
    C.G = gridDim.x; { const int bx = blockIdx.x; C.vcu = (C.G % 8 == 0) ? (bx % 8) * (C.G / 8) + bx / 8 : bx; }
    C.gw = C.vcu * NWAVES + C.wave; C.NGW = C.G * NWAVES; C.lo = args.ph_lo; C.hi = args.ph_hi;
    volatile LAS unsigned* MISC = (volatile LAS unsigned*)(C.lds + LDSCTL_OFF);
    for (int u = C.tid; u < (LDS_BYTES - LDSCTL_OFF) / 4; u += NWAVES * 64) ((LAS unsigned*)(C.lds + LDSCTL_OFF))[u] = 0u;
    __syncthreads();
    C.bar.bar = (unsigned*)(C.ctl + CW_BAR); C.bar.x = 0; C.bar.st = nullptr;
    if (!MK_PER_PHASE) C.bar = xcd_barrier_post((unsigned*)(C.ctl + CW_BAR), MISC + 8);

    float* XR = WSP(float, WS_XR); bf16* H = WSP(bf16, WS_H);
    if (PH_IN(0)) { prologue_phase(C.a, C.lds, C.ctl, C.tid, C.lane, C.wave); PH_SEAM(0); }
    attn_block<1>(C, 0, 0, true, true);
    ffn_block<6>(C, 0, 66);
    {
        const int l = 1; const float* mxl = WSP(const float, WS_MX) + (size_t)l * 3 * NADA; const float* bl = C.a.in[I_BADA] + (size_t)l * NADA;
        bf16* XA = WSP(bf16, WS_AR + AR_XA); bf16* XB = WSP(bf16, WS_AR + AR_XB); bf16* XTC = WSP(bf16, WS_AR + AR_XTC); bf16* Y = WSP(bf16, WS_AR + AR_Y);
        if (PH_IN(9)) { modnorm_phase(XR, XR + (size_t)ML * D, nullptr, H, C.a.in[I_NORMG] + (size_t)(l * 2) * D, mxl, bl, 0, MT, C.gw, C.NGW, C.lane); PH_SEAM(9); }
        if (PH_IN(10)) {
            { const SchedF S{(const char*)WSP(bf16, WS_DC2), (const char*)H, 0, C.G, (int)blockIdx.x}; const pg8::EpiF1 E{XA};
              pg8::Gemm g = pg8::mk_gemm(256, 128 * D, 256); g.bs_log2 = 6; g.ldb_hi = D; g.hsB = 2 * D;
              pg8::gemm_phase<pg8::EpiF1, SchedF>(C.lds, g, S, E); }
            { const SchedF S{(const char*)WSP(bf16, WS_DC2), (const char*)H, 1, C.G, C.G - 1 - (int)blockIdx.x}; const pg8::EpiBf16<0, false> E{XTC, 512, nullptr, 0};
              pg8::gemm_phase<pg8::EpiBf16<0, false>, SchedF>(C.lds, pg8::mk_gemm(256, D, 256), S, E); }
            PH_SEAM(10); }
        if (PH_IN(11)) {
            { const SchedF S{(const char*)WSP(bf16, WS_DA), (const char*)XA, 2, C.G, (int)blockIdx.x}; const pg8::EpiFA E{XB};
              pg8::Gemm g = pg8::mk_gemm(256, 262144, 256); g.hsB = 256;
              pg8::gemm_phase<pg8::EpiFA, SchedF>(C.lds, g, S, E); }
            { const SchedF S{(const char*)WSP(bf16, WS_FC), (const char*)XTC, 4, C.G, C.G - 1 - (int)blockIdx.x}; const pg8::EpiBf16<0, false> E{Y, D, nullptr, 0};
              pg8::gemm_phase<pg8::EpiBf16<0, false>, SchedF>(C.lds, pg8::mk_gemm(512, 512, 512), S, E); }
            PH_SEAM(11); }
        if (PH_IN(12)) {
            const SchedF S{(const char*)WSP(bf16, WS_DB), (const char*)XB, 3, C.G, (int)blockIdx.x}; const pg8::EpiFB E{Y};
            pg8::gemm_phase<pg8::EpiFB, SchedF>(C.lds, pg8::mk_gemm(512, 512, 512), S, E);
            PH_SEAM(12); }
        if (PH_IN(13)) { const pg8::SchedRC S = pg8::make_rc(Y, D, WSP(const bf16, WS_WF), D, 66, 8, D, 256, C.G, (int)blockIdx.x);
            const pg8::EpiRes E{XR, XR, mxl + 2 * D, bl + 2 * D};
            pg8::gemm_phase<pg8::EpiRes, pg8::SchedRC>(C.lds, pg8::mk_gemm(D, D, D), S, E); PH_SEAM(13); }
    }
    ffn_block<14>(C, 1, 66);
    {
        const int l = 2; const float* mxl = WSP(const float, WS_MX) + (size_t)l * 3 * NADA; const float* bl = C.a.in[I_BADA] + (size_t)l * NADA;
        bf16* Z = WSP(bf16, WS_AR + AR_Z); float* SSQ = (float*)(C.a.ws + WS_CTL) + CW_SSQ;
        if (PH_IN(17)) { modnorm_phase(XR, XR + (size_t)ML * D, nullptr, H, C.a.in[I_NORMG] + (size_t)(l * 2) * D, mxl, bl, 0, MT, C.gw, C.NGW, C.lane); PH_SEAM(17); }
        if (PH_IN(18)) { const pg8::SchedRC S = pg8::make_rc(H, D, WSP(const bf16, WS_WSI), D, 66, 48, 2 * SGH, 256, C.G, (int)blockIdx.x);
            const pg8::EpiBf16<1, true> E{Z, 2 * SGH, SSQ, 24};
            pg8::gemm_phase<pg8::EpiBf16<1, true>, pg8::SchedRC>(C.lds, pg8::mk_gemm(D, D, D), S, E); PH_SEAM(18); }
        if (PH_IN(19)) { for (int uid = C.vcu; uid < (MT / 128) * 8; uid += C.G) attn::sgu_unit(Z, SSQ, C.a.in[I_WSS], C.a.in[I_BSS], C.a.in[I_SVG], uid >> 3, uid & 7, (char*)C.lds); PH_SEAM(19); }
        if (PH_IN(20)) { const pg8::SchedRC S = pg8::make_rc(Z, 2 * SGH, WSP(const bf16, WS_WSO), SGH, 66, 8, D, 256, C.G, (int)blockIdx.x);
            const pg8::EpiRes E{XR, XR, mxl + 2 * D, bl + 2 * D};
            pg8::gemm_phase<pg8::EpiRes, pg8::SchedRC>(C.lds, pg8::mk_gemm(2 * SGH, SGH, SGH), S, E); PH_SEAM(20); }
    }
    ffn_block<21>(C, 2, 66);
    attn_block<24>(C, 3, 1, false, false);
    ffn_block<29>(C, 3, 64);
}

extern "C" void kernel_launch(void* const* d_in, const int* in_sizes, int n_in, void* d_out, int out_size, void* d_ws, size_t ws_size, hipStream_t stream) {
    static int grid = 0;
    if (grid == 0) {
        if (n_in != 21 || in_sizes[0] != ML * D || out_size != ML * D || ws_size < WS_END) { fprintf(stderr, "kernel_launch: unexpected shapes (n_in %d, in0 %d, out %d, ws %zu < %zu)\n", n_in, n_in > 0 ? in_sizes[0] : -1, out_size, ws_size, (size_t)WS_END); grid = -1; return; }
        int dev = 0, cus = 0, per_cu = 0;
        if (hipGetDevice(&dev) != hipSuccess || hipDeviceGetAttribute(&cus, hipDeviceAttributeMultiprocessorCount, dev) != hipSuccess) { grid = -1; return; }
        if (hipFuncSetAttribute((const void*)mega, hipFuncAttributeMaxDynamicSharedMemorySize, LDS_BYTES) != hipSuccess) { fprintf(stderr, "kernel_launch: hipFuncSetAttribute failed\n"); grid = -1; return; }
        if (hipOccupancyMaxActiveBlocksPerMultiprocessor(&per_cu, (const void*)mega, NWAVES * 64, LDS_BYTES) != hipSuccess || per_cu < 1) fprintf(stderr, "kernel_launch: occupancy query says %d\n", per_cu);
        (void)hipGetLastError();
        grid = cus;
    }
    if (grid < 0) return;
    if (hipMemsetAsync((char*)d_ws + WS_CTL, 0, CTL_ZERO_BYTES, stream) != hipSuccess) return;
    KArgs a{};
    for (int i = 0; i < 21; ++i) a.in[i] = (const float*)d_in[i];
    a.out = (float*)d_out; a.ws = (unsigned char*)d_ws;
#if MK_PER_PHASE
    for (int ph = 0; ph < NPH; ++ph) { a.ph_lo = ph; a.ph_hi = ph + 1; hipLaunchKernelGGL(mega, dim3(grid), dim3(NWAVES * 64), LDS_BYTES, stream, a); }
#else
    a.ph_lo = 0; a.ph_hi = NPH; hipLaunchKernelGGL(mega, dim3(grid), dim3(NWAVES * 64), LDS_BYTES, stream, a);
#endif
}
```

```cpp
#include <hip/hip_runtime.h>
#include <cstdio>
#include <cstdint>

#ifndef MK_PER_PHASE
#define MK_PER_PHASE 0
#endif

#ifndef KCHUNK
#define KCHUNK 0
#endif
#ifndef GLDS_SADDR
#define GLDS_SADDR 1
#endif
#ifndef SK_POS
#define SK_POS 0
#endif
#ifndef STAGGER_G
#define STAGGER_G 0
#endif
#ifndef PROBE_BAR2
#define PROBE_BAR2 0
#endif
#ifndef PROBE_PH
#define PROBE_PH 0ull
#endif
#ifndef PROBE_T
#define PROBE_T 0
#endif
#ifndef PROBE_DUP
#define PROBE_DUP 0
#endif
constexpr int D = 2048, NBATCH = 2, SEQ = 8192, CTXL = 256, DEPTH = 4;
constexpr int ML = NBATCH * SEQ, MC = NBATCH * CTXL, MT = ML + MC;
constexpr int NH = 16, NKV = 4, HD = 128, HQ = 2048, HKV = 512, NQKV = HQ + 2 * HKV;
constexpr int DFF = 5632, SGH = 6144, SGG = 768, NADA = 6 * D;
constexpr float EPS = 1e-6f;

constexpr size_t MiB = 1u << 20;
constexpr size_t WS_CTL = 0, CTL_ZERO_BYTES = 2 * MiB;
constexpr size_t WS_MX = 2 * MiB;
constexpr size_t WS_ROPE = 3 * MiB;
constexpr size_t WS_DC2 = 7 * MiB;
constexpr size_t WS_DB = WS_DC2 + 256 * 1024;
constexpr size_t WS_FC = WS_DC2 + 512 * 1024;
constexpr size_t WS_DA = WS_DC2 + 768 * 1024;
constexpr size_t WS_WGU = 8 * MiB;
constexpr size_t WS_WDN = WS_WGU + 4 * 44 * MiB;
constexpr int LDG_PAD = 5760;
constexpr size_t WDN_SLOT = 24 * MiB;
constexpr size_t WS_WQKV = WS_WDN + 4 * WDN_SLOT;
constexpr size_t WS_WO = WS_WQKV + 2 * 12 * MiB;
constexpr size_t WS_WF = WS_WO + 2 * 8 * MiB;
constexpr size_t WS_WSI = WS_WF + 8 * MiB;
constexpr size_t WS_WSO = WS_WSI + 48 * MiB;
constexpr size_t WS_XR = WS_WSO + 24 * MiB;
constexpr size_t WS_H = WS_XR + 132 * MiB;
constexpr size_t WS_AR = WS_H + 66 * MiB;
constexpr size_t AR_QKV = 0, AR_AO = 99 * MiB;
constexpr size_t AR_G = 0;
constexpr size_t AR_Z = 0;
constexpr size_t AR_XA = 0, AR_XB = 128 * MiB, AR_XTC = 256 * MiB, AR_Y = 260 * MiB;
constexpr size_t WS_SLAB = WS_AR + 396 * MiB;
constexpr size_t WS_Z2 = WS_CTL + 256 * 1024, Z2_BYTES = 1280 * 1024;
constexpr size_t Z2_SWGU = 0;
constexpr size_t Z2_SWSI = 540672;
constexpr size_t Z2_SWQ3 = Z2_SWSI + 147456;
constexpr size_t Z2_SSQX = 786432;
static_assert(Z2_SWQ3 + 36864 <= Z2_SSQX && Z2_SSQX + 6 * 16896 * 4 <= Z2_BYTES, "z2");
constexpr size_t WS_END = WS_SLAB + 72 * MiB;
constexpr int CW_TMO = 0;
constexpr int CW_BAR = 4096;
constexpr int CW_SSQ = 16384;
static_assert((size_t)(CW_SSQ + MT) * 4 <= WS_Z2 && WS_Z2 + Z2_BYTES <= WS_CTL + CTL_ZERO_BYTES, "ctl");

#define GAS __attribute__((address_space(1)))
#define LAS __attribute__((address_space(3)))
typedef unsigned short bf16;
typedef unsigned short bf16_t;
typedef short bf16x8 __attribute__((ext_vector_type(8)));
typedef short s16x4 __attribute__((ext_vector_type(4)));
typedef float f32x4 __attribute__((ext_vector_type(4)));
typedef float f32x2 __attribute__((ext_vector_type(2)));
typedef float f32x16 __attribute__((ext_vector_type(16)));
typedef unsigned u32x4 __attribute__((ext_vector_type(4)));
typedef unsigned u32x2 __attribute__((ext_vector_type(2)));

typedef _Float16 xr_t;
typedef _Float16 slab_t;
typedef _Float16 h16x4 __attribute__((ext_vector_type(4)));
__device__ __forceinline__ f32x4 ld4(const float* p) { return *(const f32x4*)p; }
__device__ __forceinline__ f32x4 ld4(const xr_t* p) { return __builtin_convertvector(*(const h16x4*)p, f32x4); }
__device__ __forceinline__ void st4(float* p, f32x4 v) { *(f32x4*)p = v; }
__device__ __forceinline__ void st4(xr_t* p, f32x4 v) { *(h16x4*)p = __builtin_convertvector(v, h16x4); }
typedef _Float16 h16x8 __attribute__((ext_vector_type(8)));
typedef float f32x8 __attribute__((ext_vector_type(8)));
__device__ __forceinline__ void ld8(const float* p, f32x4& a, f32x4& b) { a = *(const f32x4*)p; b = *(const f32x4*)(p + 4); }
__device__ __forceinline__ void ld8(const xr_t* p, f32x4& a, f32x4& b) { const f32x8 v = __builtin_convertvector(*(const h16x8*)p, f32x8); a = (f32x4){v[0], v[1], v[2], v[3]}; b = (f32x4){v[4], v[5], v[6], v[7]}; }
__device__ __forceinline__ void st8(float* p, f32x4 a, f32x4 b) { *(f32x4*)p = a; *(f32x4*)(p + 4) = b; }
__device__ __forceinline__ void st8(xr_t* p, f32x4 a, f32x4 b) { const f32x8 v = {a[0], a[1], a[2], a[3], b[0], b[1], b[2], b[3]}; *(h16x8*)p = __builtin_convertvector(v, h16x8); }
__device__ __forceinline__ unsigned cvt_pk_bf16(float lo, float hi) { unsigned r; asm volatile("v_cvt_pk_bf16_f32 %0, %1, %2" : "=v"(r) : "v"(lo), "v"(hi)); return r; }
__device__ __forceinline__ float bf2f(unsigned short b) { return __uint_as_float(((unsigned)b) << 16); }

namespace pg8 {
#define PG8_LAS __attribute__((address_space(3)))
constexpr int BM = 256, BK = 64, HALF = 128, HTB = HALF * BK * 2, STAGE_BYTES = 8 * HTB, NXCD = 8, WGM = 8;
__host__ __device__ __forceinline__ int lds_byte(int r, int c) { const int st = (r >> 4) * 2 + (c >> 5), rr = r & 15, cc = c & 31, ob = rr * 64 + cc * 2; return st * 1024 + (ob ^ (((ob >> 9) & 1) << 5)); }
__host__ __device__ __forceinline__ void stage_rc(int b, int& R, int& C) { const int st = b / 1024, sb = b % 1024, swz = sb ^ (((sb >> 9) & 1) << 5); R = (st >> 1) * 16 + swz / 64; C = (st & 1) * 32 + (swz % 64) / 2; }
__host__ __device__ __forceinline__ int perm32(int rho) { const int n = rho >> 4, i = rho & 15; return 8 * (i >> 2) + 4 * n + (i & 3); }

struct Unit { const char* a; const char* b; long o; int pm, pn, nt, kind; };
struct Gemm { int lda, ldb, K, bs_log2, ldb_hi; long hsB; int kcl2; size_t acs, bcs; };
__device__ __forceinline__ Gemm mk_gemm(int lda, int ldb, int K) { Gemm g; g.lda = lda; g.ldb = ldb; g.K = K; g.bs_log2 = 7; g.ldb_hi = 0; g.hsB = (long)HALF * ldb; g.kcl2 = 24; g.acs = 0; g.bcs = 0; return g; }

__device__ __forceinline__ void tile_of(int L, int nM, int nN, int& pm, int& pn, int wgm = WGM) {
    const int nwg = nM * nN; int wgid = L;
    { const int q = nwg / NXCD, r = nwg % NXCD, xcd = wgid % NXCD, off = wgid / NXCD; wgid = (xcd < r ? xcd * (q + 1) : r * (q + 1) + (xcd - r) * q) + off; }
    const int nig = wgm * nN, gid = wgid / nig, fm = gid * wgm, gsz = (nM - fm) < wgm ? (nM - fm) : wgm;
    pm = fm + ((wgid % nig) % gsz); pn = (wgid % nig) / gsz;
}

__device__ __forceinline__ f32x2 gelu_pk(f32x2 v) {
    const f32x2 av = __builtin_elementwise_abs(v), d = av * 0.2316418882f + 1.0f;
    f32x2 t; t.x = __builtin_amdgcn_rcpf(d.x); t.y = __builtin_amdgcn_rcpf(d.y);
    f32x2 q = t * 0.5307027145f + (-0.7265760135f); q = q * t + 0.7107068705f; q = q * t + (-0.142248368f); q = q * t + 0.127414796f; q = q * t;
    const f32x2 s = (v * v) * (-0.72134752044f);
    f32x2 e; e.x = __builtin_amdgcn_exp2f(s.x); e.y = __builtin_amdgcn_exp2f(s.y);
    const f32x2 m = v * (q * e), r = v - m;
    f32x2 o; o.x = v.x < 0.f ? m.x : r.x; o.y = v.y < 0.f ? m.y : r.y; return o;
}

template <class Epi, class Sched, bool KCH = false, bool ALIGN_EPI = true, bool SP2 = true, int TPROBE = 0>
__device__ __forceinline__ void gemm_phase(PG8_LAS unsigned char* lds, const Gemm g, const Sched& S, const Epi& E) {
    int tid = threadIdx.x; asm volatile("" : "+v"(tid));
    const int wid = __builtin_amdgcn_readfirstlane(tid >> 6), lane = tid & 63, wr = wid >> 2, wc = wid & 3, fr = lane & 15, fq = lane >> 4;
    const int K = g.K; int nt = K / BK;
    unsigned voffA[2], voffB[2];
#pragma unroll
    for (int i = 0; i < 2; ++i) { int R, C; stage_rc(tid * 16 + i * 8192, R, C); const int Rb = Epi::PERM ? ((R & ~31) + perm32(R & 31)) : R;
        voffA[i] = (unsigned)(R * g.lda + C) * 2u; voffB[i] = (unsigned)((Rb & ((1 << g.bs_log2) - 1)) * g.ldb + (Rb >> g.bs_log2) * g.ldb_hi + C) * 2u; }
    const size_t kstep = (size_t)(BK * 2);
    const size_t hstepA = (size_t)HALF * g.lda * 2, hstepB = (size_t)g.hsB * 2;
    const unsigned ldsw = (unsigned)wid * 1024u;
    const int aoff = lds_byte(wr * 64 + fr, fq * 8), boff = lds_byte(wc * 32 + fr, fq * 8);
#define PG8_SA(b, h) (((b) * 2 + (h)) * HTB)
#define PG8_SB(b, h) ((4 + (b) * 2 + (h)) * HTB)
#if GLDS_SADDR
    const unsigned lds0 = (unsigned)(uintptr_t)lds + ldsw;
#define PG8_STAGE(bufoff, gbase, voff) do { _Pragma("unroll") for (int _i = 0; _i < 2; ++_i) { unsigned keep_; \
        asm volatile("s_mov_b32 %0, m0\n\ts_mov_b32 m0, %3\n\ts_nop 0\n\tglobal_load_lds_dwordx4 %1, %2\n\ts_mov_b32 m0, %0" : "=&s"(keep_) : "v"((voff)[_i]), "s"((const char*)(gbase)), "s"((unsigned)__builtin_amdgcn_readfirstlane((int)(lds0 + (unsigned)(bufoff) + (unsigned)(_i * 8192)))) : "memory"); } } while (0)
#else
#define PG8_STAGE(bufoff, gbase, voff) do { _Pragma("unroll") for (int _i = 0; _i < 2; ++_i) \
        __builtin_amdgcn_global_load_lds((const unsigned*)((const char*)(gbase) + (voff)[_i]), (PG8_LAS unsigned*)(lds + (bufoff) + ldsw + _i * 8192), 16, 0, 0); } while (0)
#endif
#define PG8_LDA(dst, b, h) do { _Pragma("unroll") for (int m = 0; m < 4; ++m) _Pragma("unroll") for (int k = 0; k < 2; ++k) dst[m][k] = *(const PG8_LAS bf16x8*)(lds + PG8_SA(b, h) + aoff + m * 2048 + k * 1024); } while (0)
#define PG8_LDB(dst, b, h) do { _Pragma("unroll") for (int n = 0; n < 2; ++n) _Pragma("unroll") for (int k = 0; k < 2; ++k) dst[n][k] = *(const PG8_LAS bf16x8*)(lds + PG8_SB(b, h) + boff + n * 2048 + k * 1024); } while (0)
#define PG8_MMA(ai, bj, At, Bt) do { __builtin_amdgcn_s_setprio(1); _Pragma("unroll") for (int m = 0; m < 4; ++m) _Pragma("unroll") for (int n = 0; n < 2; ++n) _Pragma("unroll") for (int k = 0; k < 2; ++k) \
        acc[ai][bj][m][n] = __builtin_amdgcn_mfma_f32_16x16x32_bf16(Bt[n][k], At[m][k], acc[ai][bj][m][n], 0, 0, 0); __builtin_amdgcn_s_setprio(0); } while (0)
#define PG8_WAIT_V(n) asm volatile("s_waitcnt vmcnt(" #n ")" ::: "memory")
#define PG8_WAIT_L(n) asm volatile("s_waitcnt lgkmcnt(" #n ")" ::: "memory")
#define PG8_BAR __builtin_amdgcn_s_barrier()
#define PG8_SCHED __builtin_amdgcn_sched_barrier(0)
    Unit cur, nxt; int ui = 0;
    if (!S.next(0, cur)) return;
    if (cur.nt) nt = cur.nt;
    unsigned long long tp_acc = 0, tp_t0 = 0; if (TPROBE) tp_t0 = __builtin_amdgcn_s_memrealtime();
    f32x4 acc[2][2][4][2];
#pragma unroll
    for (int a = 0; a < 2; ++a)
#pragma unroll
        for (int b = 0; b < 2; ++b)
#pragma unroll
            for (int m = 0; m < 4; ++m)
#pragma unroll
                for (int n = 0; n < 2; ++n) acc[a][b][m][n] = (f32x4){0.f, 0.f, 0.f, 0.f};
    bf16x8 At[4][2], B0[2][2], B1[2][2];
    const char* cA = cur.a; const char* cB = cur.b;
    if constexpr (SP2) {
        PG8_STAGE(PG8_SB(0, 0), cB, voffB); PG8_STAGE(PG8_SB(0, 1), cB + hstepB, voffB); PG8_STAGE(PG8_SA(0, 0), cA, voffA); PG8_STAGE(PG8_SA(0, 1), cA + hstepA, voffA);
        if (wr == 1) PG8_BAR;
        PG8_WAIT_V(2); PG8_BAR;
        PG8_STAGE(PG8_SB(1, 0), cB + kstep, voffB); PG8_STAGE(PG8_SA(1, 0), cA + kstep, voffA); PG8_STAGE(PG8_SB(1, 1), cB + hstepB + kstep, voffB);
        PG8_WAIT_V(6); PG8_BAR;
    } else {
        PG8_STAGE(PG8_SB(0, 0), cB, voffB); PG8_STAGE(PG8_SA(0, 0), cA, voffA); PG8_STAGE(PG8_SB(0, 1), cB + hstepB, voffB); PG8_STAGE(PG8_SA(0, 1), cA + hstepA, voffA);
        if (wr == 1) PG8_BAR;
        PG8_WAIT_V(4); PG8_BAR;
        PG8_STAGE(PG8_SB(1, 0), cB + kstep, voffB); PG8_STAGE(PG8_SA(1, 0), cA + kstep, voffA); PG8_STAGE(PG8_SB(1, 1), cB + hstepB + kstep, voffB);
        PG8_WAIT_V(6); PG8_BAR;
    }
    for (;;) {
        const bool has_next = S.next(ui + 1, nxt);
        const char* nA = has_next ? nxt.a : cA; const char* nB = has_next ? nxt.b : cB;
        for (int t = 0; t < nt; t += 2) {
            const bool last = (t == nt - 2);
            const char* a1; const char* a2; const char* b2;
            if constexpr (KCH) { const int t2_ = t + 2, tc_ = t2_ >> g.kcl2, tr_ = t2_ & ((1 << g.kcl2) - 1);
                a1 = cA + (size_t)(t >> g.kcl2) * g.acs + (size_t)((t & ((1 << g.kcl2) - 1)) + 1) * kstep;
                a2 = last ? nA : cA + (size_t)tc_ * g.acs + (size_t)tr_ * kstep; b2 = last ? nB : cB + (size_t)tc_ * g.bcs + (size_t)tr_ * kstep;
            } else { a1 = cA + (size_t)(t + 1) * kstep; a2 = last ? nA : cA + (size_t)(t + 2) * kstep; b2 = last ? nB : cB + (size_t)(t + 2) * kstep; }
            const char* a3 = a2 + kstep; const char* b3 = b2 + kstep;
            if constexpr (SP2) {
            PG8_LDB(B0, 0, 0); PG8_LDB(B1, 0, 1); PG8_SCHED; PG8_LDA(At, 0, 0); PG8_STAGE(PG8_SA(1, 1), a1 + hstepA, voffA);
            PG8_WAIT_V(8); PG8_WAIT_L(0); PG8_BAR; PG8_MMA(0, 0, At, B0); PG8_MMA(0, 1, At, B1); PG8_BAR; PG8_SCHED;
            PG8_LDA(At, 0, 1); PG8_STAGE(PG8_SB(0, 0), b2, voffB); PG8_STAGE(PG8_SB(0, 1), b2 + hstepB, voffB); PG8_STAGE(PG8_SA(0, 0), a2, voffA);
            PG8_WAIT_V(8); PG8_WAIT_L(0); PG8_BAR; PG8_MMA(1, 0, At, B0); PG8_MMA(1, 1, At, B1); PG8_BAR; PG8_SCHED;
            PG8_LDB(B0, 1, 0); PG8_LDB(B1, 1, 1); PG8_SCHED; PG8_LDA(At, 1, 0); PG8_STAGE(PG8_SA(0, 1), a2 + hstepA, voffA);
            PG8_WAIT_V(8); PG8_WAIT_L(0); PG8_BAR; PG8_MMA(0, 0, At, B0); PG8_MMA(0, 1, At, B1); PG8_BAR; PG8_SCHED;
            PG8_LDA(At, 1, 1); PG8_STAGE(PG8_SB(1, 0), b3, voffB); PG8_STAGE(PG8_SB(1, 1), b3 + hstepB, voffB); PG8_STAGE(PG8_SA(1, 0), a3, voffA);
            PG8_WAIT_V(8); PG8_WAIT_L(0); PG8_BAR; PG8_MMA(1, 0, At, B0); PG8_MMA(1, 1, At, B1); PG8_BAR; PG8_SCHED;
            } else {
            PG8_LDB(B0, 0, 0); PG8_SCHED; PG8_LDA(At, 0, 0); PG8_STAGE(PG8_SA(1, 1), a1 + hstepA, voffA);
            PG8_WAIT_L(8); PG8_BAR; PG8_WAIT_L(0); PG8_MMA(0, 0, At, B0); PG8_BAR; PG8_SCHED;
            PG8_LDB(B1, 0, 1); PG8_STAGE(PG8_SB(0, 0), b2, voffB);
            PG8_BAR; PG8_WAIT_L(0); PG8_MMA(0, 1, At, B1); PG8_BAR;
            PG8_LDA(At, 0, 1); PG8_STAGE(PG8_SA(0, 0), a2, voffA);
            PG8_BAR; PG8_WAIT_L(0); PG8_MMA(1, 0, At, B0); PG8_BAR; PG8_SCHED;
            PG8_STAGE(PG8_SB(0, 1), b2 + hstepB, voffB);
            PG8_WAIT_V(6); PG8_BAR; PG8_MMA(1, 1, At, B1); PG8_BAR;
            PG8_LDB(B0, 1, 0); PG8_SCHED; PG8_LDA(At, 1, 0); PG8_STAGE(PG8_SA(0, 1), a2 + hstepA, voffA);
            PG8_WAIT_L(8); PG8_BAR; PG8_WAIT_L(0); PG8_MMA(0, 0, At, B0); PG8_BAR; PG8_SCHED;
            PG8_LDB(B1, 1, 1); PG8_STAGE(PG8_SB(1, 0), b3, voffB);
            PG8_BAR; PG8_WAIT_L(0); PG8_MMA(0, 1, At, B1); PG8_BAR;
            PG8_LDA(At, 1, 1); PG8_STAGE(PG8_SA(1, 0), a3, voffA);
            PG8_BAR; PG8_WAIT_L(0); PG8_MMA(1, 0, At, B0); PG8_BAR; PG8_SCHED;
            PG8_STAGE(PG8_SB(1, 1), b3 + hstepB, voffB);
            PG8_WAIT_V(6); PG8_BAR; PG8_MMA(1, 1, At, B1); PG8_BAR;
            }
        }
        if (TPROBE == 2) { const unsigned long long t_ = __builtin_amdgcn_s_memrealtime(); tp_acc += t_ - tp_t0; }
        if (TPROBE == 1) tp_t0 = __builtin_amdgcn_s_memrealtime();
        if constexpr (ALIGN_EPI) { if (wr == 0) PG8_BAR; }
        E(acc, cur, wr, wc, fr, fq);
        if (!has_next) { if (TPROBE == 1) { const unsigned long long t_ = __builtin_amdgcn_s_memrealtime(); tp_acc += t_ - tp_t0; } break; }
#pragma unroll
        for (int a = 0; a < 2; ++a)
#pragma unroll
            for (int b = 0; b < 2; ++b)
#pragma unroll
                for (int m = 0; m < 4; ++m)
#pragma unroll
                    for (int n = 0; n < 2; ++n) acc[a][b][m][n] = (f32x4){0.f, 0.f, 0.f, 0.f};
        cur = nxt; cA = nA; cB = nB; ++ui; nt = cur.nt ? cur.nt : K / BK;
        if constexpr (ALIGN_EPI) { if (wr == 1) PG8_BAR; }
        if (TPROBE == 1) { const unsigned long long t_ = __builtin_amdgcn_s_memrealtime(); tp_acc += t_ - tp_t0; }
        if (TPROBE == 2) tp_t0 = __builtin_amdgcn_s_memrealtime();
    }
    PG8_WAIT_V(0);
    if constexpr (!ALIGN_EPI) { if (wr == 0) PG8_BAR; }
    PG8_BAR;
    if (TPROBE) { if (wid == 0) { const unsigned long long t1_ = __builtin_amdgcn_s_memrealtime(); while (__builtin_amdgcn_s_memrealtime() - t1_ < tp_acc) __builtin_amdgcn_s_sleep(8); } PG8_BAR; }
#undef PG8_SA
#undef PG8_SB
#undef PG8_STAGE
#undef PG8_LDA
#undef PG8_LDB
#undef PG8_MMA
#undef PG8_WAIT_V
#undef PG8_WAIT_L
#undef PG8_BAR
#undef PG8_SCHED
}
}
namespace pg8 {
__device__ __forceinline__ int bsel_of(int pm) { return pm < 32 ? 0 : (pm < 64 ? 1 : 2); }

template <int ACT, bool SSQ, bool FUSED = false> struct EpiBf16 {
    static constexpr bool PERM = true;
    bf16_t* O; int ldc; float* ssq; int ssq_pn0; const float* nssq; const float* nsw; int nswN;
    __device__ __forceinline__ void operator()(const f32x4 (&acc)[2][2][4][2], const Unit& u, int wr, int wc, int fr, int fq) const {
        bf16_t* base = O + u.o + (size_t)(wr * 64 + fr) * ldc + wc * 32 + 8 * fq;
        const bool do_ssq = SSQ && (u.pn >= ssq_pn0);
        f32x4 swv[2][2];
        if (FUSED) { const float* sp = nsw + (size_t)bsel_of(u.pm) * nswN + u.pn * BM + wc * 32 + 8 * fq;
#pragma unroll
            for (int bj = 0; bj < 2; ++bj) { swv[bj][0] = *(const f32x4*)(sp + bj * HALF); swv[bj][1] = *(const f32x4*)(sp + bj * HALF + 4); } }
#pragma unroll
        for (int ai = 0; ai < 2; ++ai)
#pragma unroll
            for (int m = 0; m < 4; ++m) { bf16_t* rowp = base + (size_t)(ai * HALF + m * 16) * ldc; float s = 0.f;
                float rr = 1.f; if (FUSED) rr = __builtin_amdgcn_rsqf(nssq[u.pm * BM + ai * HALF + wr * 64 + m * 16 + fr] * (1.0f / D) + EPS);
#pragma unroll
                for (int bj = 0; bj < 2; ++bj) { f32x4 v0 = acc[ai][bj][m][0], v1 = acc[ai][bj][m][1];
                    if (FUSED) { v0 = v0 * rr + swv[bj][0]; v1 = v1 * rr + swv[bj][1]; }
                    if (ACT == 1) { f32x2 a = gelu_pk((f32x2){v0[0], v0[1]}), b = gelu_pk((f32x2){v0[2], v0[3]}), c = gelu_pk((f32x2){v1[0], v1[1]}), d = gelu_pk((f32x2){v1[2], v1[3]});
                        v0 = (f32x4){a.x, a.y, b.x, b.y}; v1 = (f32x4){c.x, c.y, d.x, d.y}; }
                    if (SSQ) s += (v0[0] * v0[0] + v0[1] * v0[1]) + (v0[2] * v0[2] + v0[3] * v0[3]) + (v1[0] * v1[0] + v1[1] * v1[1]) + (v1[2] * v1[2] + v1[3] * v1[3]);
                    u32x4 w; w.x = cvt_pk_bf16(v0[0], v0[1]); w.y = cvt_pk_bf16(v0[2], v0[3]); w.z = cvt_pk_bf16(v1[0], v1[1]); w.w = cvt_pk_bf16(v1[2], v1[3]);
                    *(u32x4*)(rowp + bj * HALF) = w; }
                if (SSQ) { if (do_ssq) { s += __shfl_xor(s, 16); s += __shfl_xor(s, 32);
                    if (fq == 0) atomicAdd(ssq + u.pm * BM + ai * HALF + wr * 64 + m * 16 + fr, s); } }
            }
    }
};

template <bool NEXT, class TIN, class TOUT> struct EpiRes {
    static constexpr bool PERM = true;
    const TIN* rin; TOUT* rout; const float* gmx; const float* gb;
    bf16_t* hq; const float* ng; const float* nmx; const float* nb; float* nssq;
    __device__ __forceinline__ void operator()(const f32x4 (&acc)[2][2][4][2], const Unit& u, int wr, int wc, int fr, int fq) const {
        const int bs = bsel_of(u.pm); const int col0 = u.pn * BM + wc * 32 + 8 * fq;
        f32x4 gv[2][2], gn[2][2];
#pragma unroll
        for (int bj = 0; bj < 2; ++bj)
#pragma unroll
            for (int n = 0; n < 2; ++n) { const int cc = col0 + bj * HALF + n * 4; gv[bj][n] = *(const f32x4*)(gmx + bs * NADA + cc) + *(const f32x4*)(gb + cc);
                if (NEXT) gn[bj][n] = *(const f32x4*)(ng + cc) * (*(const f32x4*)(nmx + bs * NADA + cc) + *(const f32x4*)(nb + cc) + 1.0f); }
        f32x4 xr[2][2][2];
#define ER_LOAD(g) do { const size_t off_ = (size_t)(u.pm * BM + ((g) >> 2) * HALF + wr * 64 + ((g) & 3) * 16 + fr) * D + col0; \
            _Pragma("unroll") for (int bj = 0; bj < 2; ++bj) ld8(rin + off_ + bj * HALF, xr[(g) & 1][bj][0], xr[(g) & 1][bj][1]); } while (0)
        ER_LOAD(0);
#pragma unroll
        for (int g = 0; g < 8; ++g) { const int ai = g >> 2, m = g & 3;
            if (g + 1 < 8) ER_LOAD(g + 1);
            const int row = u.pm * BM + ai * HALF + wr * 64 + m * 16 + fr; const size_t off = (size_t)row * D + col0; float s = 0.f;
#pragma unroll
            for (int bj = 0; bj < 2; ++bj) { const f32x4 o0 = xr[g & 1][bj][0] + gv[bj][0] * acc[ai][bj][m][0], o1 = xr[g & 1][bj][1] + gv[bj][1] * acc[ai][bj][m][1];
                st8(rout + off + bj * HALF, o0, o1);
                if (NEXT) { s += (o0[0] * o0[0] + o0[1] * o0[1]) + (o0[2] * o0[2] + o0[3] * o0[3]) + (o1[0] * o1[0] + o1[1] * o1[1]) + (o1[2] * o1[2] + o1[3] * o1[3]);
                    const f32x4 h0 = o0 * gn[bj][0], h1 = o1 * gn[bj][1]; u32x4 w; w.x = cvt_pk_bf16(h0[0], h0[1]); w.y = cvt_pk_bf16(h0[2], h0[3]); w.z = cvt_pk_bf16(h1[0], h1[1]); w.w = cvt_pk_bf16(h1[2], h1[3]);
                    *(u32x4*)(hq + off + bj * HALF) = w; } }
            if (NEXT) { s += __shfl_xor(s, 16); s += __shfl_xor(s, 32); if (fq == 0) atomicAdd(nssq + row, s); }
            asm volatile("" ::: "memory"); }
#undef ER_LOAD
    }
};

template <bool FUSED> struct EpiSwiGLU {
    static constexpr bool PERM = true;
    bf16_t* G; int ldg; const float* nssq; const float* nsw;
    __device__ __forceinline__ void operator()(const f32x4 (&acc)[2][2][4][2], const Unit& u, int wr, int wc, int fr, int fq) const {
        bf16_t* base = G + u.o + (size_t)(wr * 64 + fr) * ldg + wc * 32 + 8 * fq;
        f32x4 swv[2][2];
        if (FUSED) { const float* sp = nsw + (size_t)bsel_of(u.pm) * (2 * DFF) + u.pn * BM + wc * 32 + 8 * fq;
#pragma unroll
            for (int bj = 0; bj < 2; ++bj) { swv[bj][0] = *(const f32x4*)(sp + bj * HALF); swv[bj][1] = *(const f32x4*)(sp + bj * HALF + 4); } }
#pragma unroll
        for (int ai = 0; ai < 2; ++ai)
#pragma unroll
            for (int m = 0; m < 4; ++m) { bf16_t* rowp = base + (size_t)(ai * HALF + m * 16) * ldg;
                float rr = 1.f; if (FUSED) rr = __builtin_amdgcn_rsqf(nssq[u.pm * BM + ai * HALF + wr * 64 + m * 16 + fr] * (1.0f / D) + EPS);
                u32x4 w;
#pragma unroll
                for (int bj = 0; bj < 2; ++bj) { f32x4 g = acc[ai][bj][m][0], up = acc[ai][bj][m][1]; f32x4 o;
                    if (FUSED) { g = g * rr + swv[bj][0]; up = up * rr + swv[bj][1]; }
#pragma unroll
                    for (int e = 0; e < 4; ++e) { const float sg = __builtin_amdgcn_rcpf(1.f + __builtin_amdgcn_exp2f(-1.4426950408889634f * g[e])); o[e] = g[e] * sg * up[e]; }
                    w[2 * bj] = cvt_pk_bf16(o[0], o[1]); w[2 * bj + 1] = cvt_pk_bf16(o[2], o[3]); }
                *(u32x4*)rowp = w; }
    }
};

struct EpiF1 {
    static constexpr bool PERM = true;
    bf16_t* O;
    __device__ __forceinline__ void operator()(const f32x4 (&acc)[2][2][4][2], const Unit& u, int wr, int wc, int fr, int fq) const {
        bf16_t* base = O + u.o + (size_t)(wr * 64 + fr) * 256 + (size_t)(wc >> 1) * 262144 + 32 * (wc & 1) + 8 * fq;
#pragma unroll
        for (int ai = 0; ai < 2; ++ai)
#pragma unroll
            for (int m = 0; m < 4; ++m)
#pragma unroll
                for (int bj = 0; bj < 2; ++bj) { const f32x4 v0 = acc[ai][bj][m][0], v1 = acc[ai][bj][m][1];
                    u32x4 w; w.x = cvt_pk_bf16(v0[0], v0[1]); w.y = cvt_pk_bf16(v0[2], v0[3]); w.z = cvt_pk_bf16(v1[0], v1[1]); w.w = cvt_pk_bf16(v1[2], v1[3]);
                    *(u32x4*)(base + (size_t)(ai * HALF + m * 16) * 256 + (size_t)bj * 2 * 262144) = w; }
    }
};
struct EpiFA {
    static constexpr bool PERM = true;
    bf16_t* O;
    __device__ __forceinline__ void operator()(const f32x4 (&acc)[2][2][4][2], const Unit& u, int wr, int wc, int fr, int fq) const {
        const int t20 = 32 * wc + 8 * fq;
        bf16_t* base = O + u.o + (size_t)wr * 256 + t20;
#pragma unroll
        for (int m = 0; m < 4; ++m) { int k1 = 16 * m + fr; asm volatile("" : "+v"(k1));     u32x4 wre[2], wim[2];
#pragma unroll
            for (int e2 = 0; e2 < 4; ++e2) { float cs[2], sn[2];
#pragma unroll
                for (int q = 0; q < 2; ++q) { const float fr_ = (float)((k1 * (t20 + 2 * e2 + q)) & 8191) * (1.0f / 8192.0f); cs[q] = __builtin_amdgcn_cosf(fr_); sn[q] = __builtin_amdgcn_sinf(fr_); }
#pragma unroll
                for (int bj = 0; bj < 2; ++bj) { float zr[2], zi[2];
#pragma unroll
                    for (int q = 0; q < 2; ++q) { const int e = 2 * e2 + q; const float a = acc[0][bj][m][e >> 2][e & 3], b = acc[1][bj][m][e >> 2][e & 3];
                        zr[q] = a * cs[q] + b * sn[q]; zi[q] = b * cs[q] - a * sn[q]; }
                    wre[bj][e2] = cvt_pk_bf16(zr[0], zr[1]); wim[bj][e2] = cvt_pk_bf16(zi[0], zi[1]); }
                __builtin_amdgcn_sched_barrier(0); }
#pragma unroll
            for (int bj = 0; bj < 2; ++bj) { bf16_t* p = base + (size_t)k1 * 524288 + (size_t)bj * 512; *(u32x4*)p = wre[bj]; *(u32x4*)(p + 128) = wim[bj]; } }
    }
};
struct EpiFB {
    static constexpr bool PERM = true;
    bf16_t* O;
    __device__ __forceinline__ void operator()(const f32x4 (&acc)[2][2][4][2], const Unit& u, int wr, int wc, int fr, int fq) const {
        bf16_t* base = O + u.o + (size_t)(64 * wr + fr) * (64 * D) + wc * 32 + 8 * fq;
#pragma unroll
        for (int ai = 0; ai < 2; ++ai)
#pragma unroll
            for (int m = 0; m < 4; ++m)
#pragma unroll
                for (int bj = 0; bj < 2; ++bj) { const f32x4 v0 = acc[ai][bj][m][0], v1 = acc[ai][bj][m][1];
                    u32x4 w; w.x = cvt_pk_bf16(v0[0], v0[1]); w.y = cvt_pk_bf16(v0[2], v0[3]); w.z = cvt_pk_bf16(v1[0], v1[1]); w.w = cvt_pk_bf16(v1[2], v1[3]);
                    *(u32x4*)(base + (size_t)(16 * m) * (64 * D) + ai * 1024 + bj * HALF) = w; }
    }
};

struct EpiSlab {
    static constexpr bool PERM = true;
    slab_t* O; int ldc;
    __device__ __forceinline__ void operator()(const f32x4 (&acc)[2][2][4][2], const Unit& u, int wr, int wc, int fr, int fq) const {
        slab_t* base = O + u.o + (size_t)(wr * 64 + fr) * ldc + wc * 32 + 8 * fq;
#pragma unroll
        for (int ai = 0; ai < 2; ++ai)
#pragma unroll
            for (int m = 0; m < 4; ++m) { slab_t* rowp = base + (size_t)(ai * HALF + m * 16) * ldc;
#pragma unroll
                for (int bj = 0; bj < 2; ++bj) st8(rowp + bj * HALF, acc[ai][bj][m][0], acc[ai][bj][m][1]); }
    }
};
struct SchedSK {
    const char* A; const char* B; int lda, ldb, ns, nN, pn0, N, G, c; size_t aks, bks;
    __device__ __forceinline__ bool next(int i, Unit& u) const {
        const int L = i * G + c; if (L >= ns * 2 * nN) return false;
        const int s = L % ns, t = L / ns, pmc = t & 1, pn = pn0 + (t >> 1);
        u.a = A + (size_t)(ML + pmc * 256) * lda * 2 + (size_t)s * aks; u.b = B + (size_t)pn * 256 * ldb * 2 + (size_t)s * bks;
        u.o = ((long)s * MC + pmc * 256) * N + pn * 256; u.pm = 64 + pmc; u.pn = pn; u.nt = 0; u.kind = 0; return true;
    }
};

template <class EA, class EB> struct Epi2 {
    static constexpr bool PERM = EA::PERM; static_assert(EA::PERM == EB::PERM, "Epi2: layouts differ");
    EA ea; EB eb;
    __device__ __forceinline__ void operator()(const f32x4 (&acc)[2][2][4][2], const Unit& u, int wr, int wc, int fr, int fq) const { if (u.kind) eb(acc, u, wr, wc, fr, fq); else ea(acc, u, wr, wc, fr, fq); }
};
template <class SA  , class SB  > struct SchedMix {
    SA lat; SB sk; int nt_sk; bool has;
    __device__ __forceinline__ bool next(int i, Unit& u) const {
        if (has) { if (i == SK_POS) { sk.next(0, u); u.nt = nt_sk; u.kind = 1; return true; } return lat.next(i < SK_POS ? i : i - 1, u); }
        return lat.next(i, u);
    }
};

struct SchedRC {
    const char* A; const char* B; size_t atile, btile; long ldo, ocs; int ow, nM, nN, G, c, wgm, ocl2, pm0, pmsplit, pmjump;
    __device__ __forceinline__ bool next(int i, Unit& u) const {
        const long L = (long)i * G + c; if (L >= (long)nM * nN) return false;
        int pm, pn; tile_of((int)L, nM, nN, pm, pn, wgm); pm += pm0 + (pm >= pmsplit ? pmjump : 0);
        u.a = A + (size_t)pm * atile; u.b = B + (size_t)pn * btile; u.o = (long)(pn >> ocl2) * ocs + (long)pm * BM * ldo + (long)(pn & ((1 << ocl2) - 1)) * ow; u.pm = pm; u.pn = pn; u.nt = 0; u.kind = 0; return true;
    }
};
__device__ __forceinline__ SchedRC make_rc(const bf16_t* A, int lda, const bf16_t* B, int ldb, int nM, int nN, long ldo, int ow, int G, int c, int wgm = WGM) {
    SchedRC s; s.wgm = wgm; s.ocl2 = 24; s.ocs = 0; s.pm0 = 0; s.pmsplit = 1 << 20; s.pmjump = 0; s.A = (const char*)A; s.B = (const char*)B; s.atile = (size_t)BM * lda * 2; s.btile = (size_t)BM * ldb * 2; s.ldo = ldo; s.ow = ow; s.nM = nM; s.nN = nN; s.G = G; s.c = c; return s;
}
}
typedef GAS unsigned gu32;
#define RLX_AGENT __ATOMIC_RELAXED, __HIP_MEMORY_SCOPE_AGENT
#define XB_TMO      128
#define XB_XCNT(j)  (256  + 64 * (j))
#define XB_XSUB(j)  (1280 + 64 * (j))
#define XB_XGEN(j)  (2304 + 64 * (j))
#define XB_TOP      3328
#define XB_TOPGEN   3392
#define XCD_BAR_WORDS 3456
#define XB_SPIN_CAP (1u << 18)
__device__ __forceinline__ unsigned xb_ld(unsigned* p)              { return __hip_atomic_load(p, __ATOMIC_RELAXED, __HIP_MEMORY_SCOPE_AGENT); }
__device__ __forceinline__ unsigned xb_add(unsigned* p, unsigned v) { return __hip_atomic_fetch_add(p, v, __ATOMIC_RELAXED, __HIP_MEMORY_SCOPE_AGENT); }
__device__ __forceinline__ unsigned xb_xcc_id() { return (unsigned)__builtin_amdgcn_s_getreg((3 << 11) | 20) & 0xFu; }
#define XB_SPIN(cond, bar) do { unsigned _sp = 0; while (cond) { __builtin_amdgcn_s_sleep(1); \
    if ((++_sp & 255u) == 0u) { if (xb_ld(&(bar)[XB_TMO])) break; if (_sp > XB_SPIN_CAP) { atomicAdd(&(bar)[XB_TMO], 1u); break; } } } } while (0)
struct XcdBarrier { unsigned* bar; unsigned x; volatile LAS unsigned* st; };
__device__ __forceinline__ XcdBarrier xcd_barrier_post(unsigned* bar, volatile LAS unsigned* st) {
    XcdBarrier b; b.bar = bar; b.x = xb_xcc_id(); b.st = st;
    if (threadIdx.x == 0) (void)xb_add(&bar[XB_XCNT(b.x)], 1u);
    return b;
}
__device__ __forceinline__ void xcd_barrier_complete(unsigned* bar, unsigned x, unsigned& nloc, unsigned& nx) {
    const unsigned G = gridDim.x * gridDim.y * gridDim.z;
    unsigned sum, cnt, mine, sp = 0u;
    for (;;) {
        sum = 0u; cnt = 0u; mine = 0u;
#pragma unroll
        for (unsigned j = 0; j < 16; ++j) { const unsigned c = xb_ld(&bar[XB_XCNT(j)]); sum += c; cnt += (c > 0u) ? 1u : 0u; mine = (j == x) ? c : mine; }
        if (sum == G) break;
        __builtin_amdgcn_s_sleep(1);
        if ((++sp & 255u) == 0u) { if (xb_ld(&bar[XB_TMO])) break; if (sp > XB_SPIN_CAP) { atomicAdd(&bar[XB_TMO], 1u); break; } }
    }
    nloc = mine > 0u ? mine : 1u; nx = cnt > 0u ? cnt : 1u;
}
__device__ __forceinline__ void xcd_barrier(const XcdBarrier& b) {
    asm volatile("s_waitcnt vmcnt(0)" ::: "memory");
    __syncthreads();
    if (threadIdx.x == 0) {
        unsigned* bar = b.bar;
        __builtin_amdgcn_s_waitcnt(0);
        unsigned nloc = b.st[0], nx = b.st[1];
        if (nloc == 0u) { xcd_barrier_complete(bar, b.x, nloc, nx); b.st[0] = nloc; b.st[1] = nx; }
        const unsigned old = xb_add(&bar[XB_XSUB(b.x)], 1u);
        const unsigned gen = old / nloc;
        if (old + 1u == (gen + 1u) * nloc) {
            __builtin_amdgcn_fence(__ATOMIC_RELEASE, "agent");
            asm volatile("s_waitcnt vmcnt(0)" ::: "memory");
            const unsigned og = xb_add(&bar[XB_TOP], 1u);
            const unsigned tg = og / nx;
            if (og + 1u == (tg + 1u) * nx) xb_add(&bar[XB_TOPGEN], 1u);
            else XB_SPIN(xb_ld(&bar[XB_TOPGEN]) == tg, bar);
            __builtin_amdgcn_fence(__ATOMIC_ACQUIRE, "agent");
            xb_add(&bar[XB_XGEN(b.x)], 1u);
            asm volatile("s_waitcnt vmcnt(0)" ::: "memory");
        } else {
            XB_SPIN(xb_ld(&bar[XB_XGEN(b.x)]) == gen, bar);
            __builtin_amdgcn_fence(__ATOMIC_ACQUIRE, "agent");
            asm volatile("s_waitcnt vmcnt(0)" ::: "memory");
        }
    }
    __syncthreads();
}
#define LDS_WAIT() asm volatile("s_waitcnt lgkmcnt(0)" ::: "memory")
#define VM_WAIT() asm volatile("s_waitcnt vmcnt(0)" ::: "memory")
__device__ __forceinline__ float wave_sum(float v) {
#pragma unroll
    for (int o = 1; o < 64; o <<= 1) v += __shfl_xor(v, o);
    return v;
}
__device__ __forceinline__ float silu_f(float x) { return x / (1.f + __expf(-x)); }

template <class TX> __device__ __forceinline__ void modnorm_phase(const TX* xlat, const TX* xctx, xr_t* xr_out, bf16* H, const float* g, const float* mxl, const float* bl,
                                              int which, int nrows, int gw, int NGW, int lane, const slab_t* fin_slab = nullptr, int fin_ns = 0, const float* fin_gmx = nullptr, const float* fin_gb = nullptr, xr_t* fin_xr = nullptr) {
    asm volatile("" : "+v"(lane));
    int cur_bs = -1; f32x4 gs[8], sh[8];
    const int csh = (which * 3) * D, csc = (which * 3 + 1) * D;
    int row = gw;
    if (row < ML) {
        f32x4 v[8], vn[8];
#pragma unroll
        for (int j = 0; j < 8; ++j) v[j] = ld4(xlat + (size_t)row * D + 4 * lane + 256 * j);
        for (; row < ML; row += NGW) {
            const int nrow = row + NGW;
            if (nrow < ML) {
#pragma unroll
                for (int j = 0; j < 8; ++j) vn[j] = ld4(xlat + (size_t)nrow * D + 4 * lane + 256 * j);
            }
            const int bs = row < SEQ ? 0 : 1;
            if (bs != cur_bs) {
#pragma unroll
                for (int j = 0; j < 8; ++j) { const int col = 4 * lane + 256 * j;
                    const f32x4 gg = *(const f32x4*)(g + col);
                    const f32x4 sc = *(const f32x4*)(mxl + bs * NADA + csc + col) + *(const f32x4*)(bl + csc + col);
                    sh[j] = *(const f32x4*)(mxl + bs * NADA + csh + col) + *(const f32x4*)(bl + csh + col);
                    gs[j] = gg * (sc + 1.0f); }
                cur_bs = bs;
            }
            float s = 0.f;
#pragma unroll
            for (int j = 0; j < 8; ++j) s += (v[j].x * v[j].x + v[j].y * v[j].y) + (v[j].z * v[j].z + v[j].w * v[j].w);
            const float r = 1.0f / sqrtf(wave_sum(s) * (1.0f / D) + EPS);
            bf16* hrow = H + (size_t)row * D;
#pragma unroll
            for (int j = 0; j < 8; ++j) { const f32x4 o = v[j] * r * gs[j] + sh[j]; u32x2 w; w.x = cvt_pk_bf16(o.x, o.y); w.y = cvt_pk_bf16(o.z, o.w);
                *(u32x2*)(hrow + 4 * lane + 256 * j) = w; }
#pragma unroll
            for (int j = 0; j < 8; ++j) v[j] = vn[j];
        }
    }
    for (; row < nrows; row += NGW) {
        const int bs = row < SEQ ? 0 : (row < ML ? 1 : 2);
        if (bs != cur_bs) {
#pragma unroll
            for (int j = 0; j < 8; ++j) { const int col = 4 * lane + 256 * j;
                const f32x4 gg = *(const f32x4*)(g + col);
                const f32x4 sc = *(const f32x4*)(mxl + bs * NADA + csc + col) + *(const f32x4*)(bl + csc + col);
                sh[j] = *(const f32x4*)(mxl + bs * NADA + csh + col) + *(const f32x4*)(bl + csh + col);
                gs[j] = gg * (sc + 1.0f); }
            cur_bs = bs;
        }
        const TX* src = row < ML ? xlat + (size_t)row * D : xctx + (size_t)(row - ML) * D;
        f32x4 v[8]; float s = 0.f;
#pragma unroll
        for (int j = 0; j < 8; ++j) v[j] = ld4(src + 4 * lane + 256 * j);
        if (fin_slab && row >= ML) {
            f32x4 a[8];
#pragma unroll
            for (int j = 0; j < 8; ++j) a[j] = (f32x4){0.f, 0.f, 0.f, 0.f};
            const slab_t* sp = fin_slab + (size_t)(row - ML) * D + 4 * lane;
            for (int sidx = 0; sidx < fin_ns; ++sidx) {
                f32x4 t0[8];
#pragma unroll
                for (int j = 0; j < 8; ++j) t0[j] = ld4(sp + (size_t)sidx * MC * D + 256 * j);
#pragma unroll
                for (int j = 0; j < 8; ++j) a[j] += t0[j];
            }
#pragma unroll
            for (int j = 0; j < 8; ++j) { const int col = 4 * lane + 256 * j;
                const f32x4 gt = *(const f32x4*)(fin_gmx + 2 * NADA + col) + *(const f32x4*)(fin_gb + col);
                v[j] += gt * a[j]; st4(fin_xr + (size_t)row * D + col, v[j]); }
        }
#pragma unroll
        for (int j = 0; j < 8; ++j) s += (v[j].x * v[j].x + v[j].y * v[j].y) + (v[j].z * v[j].z + v[j].w * v[j].w);
        const float r = 1.0f / sqrtf(wave_sum(s) * (1.0f / D) + EPS);
        bf16* hrow = H + (size_t)row * D;
#pragma unroll
        for (int j = 0; j < 8; ++j) { const f32x4 o = v[j] * r * gs[j] + sh[j]; u32x2 w; w.x = cvt_pk_bf16(o.x, o.y); w.y = cvt_pk_bf16(o.z, o.w);
            *(u32x2*)(hrow + 4 * lane + 256 * j) = w; }
        if (xr_out && row >= ML) {
#pragma unroll
            for (int j = 0; j < 8; ++j) st4(xr_out + (size_t)row * D + 4 * lane + 256 * j, v[j]);
        }
    }
}

__device__ __forceinline__ void ctxfin_phase(const slab_t* slab, int ns, const float* gmx, const float* gb, xr_t* XR, bf16* H, const float* ng, const float* nmx, const float* nb, float* nssq, int gw, int NGW, int lane) {
    asm volatile("" : "+v"(lane));
    for (int it = gw; it < MC * 4; it += NGW) { const int r = it >> 2, q = it & 3, row = ML + r, c0 = q * 512 + 4 * lane;
        f32x4 a[2], v[2];
#pragma unroll
        for (int j = 0; j < 2; ++j) { a[j] = (f32x4){0.f, 0.f, 0.f, 0.f}; v[j] = ld4(XR + (size_t)row * D + c0 + 256 * j); }
        const slab_t* sp = slab + (size_t)r * D + c0;
        for (int s0 = 0; s0 < ns; s0 += 4) { f32x4 t0[4][2];
#pragma unroll
            for (int k = 0; k < 4; ++k) { const int sidx = s0 + k < ns ? s0 + k : s0;
#pragma unroll
                for (int j = 0; j < 2; ++j) t0[k][j] = ld4(sp + (size_t)sidx * MC * D + 256 * j); }
#pragma unroll
            for (int k = 0; k < 4; ++k) if (s0 + k < ns) { a[0] += t0[k][0]; a[1] += t0[k][1]; } }
        float s = 0.f;
#pragma unroll
        for (int j = 0; j < 2; ++j) { const int col = c0 + 256 * j;
            const f32x4 gt = *(const f32x4*)(gmx + 2 * NADA + col) + *(const f32x4*)(gb + col);
            v[j] += gt * a[j]; st4(XR + (size_t)row * D + col, v[j]);
            s += (v[j].x * v[j].x + v[j].y * v[j].y) + (v[j].z * v[j].z + v[j].w * v[j].w);
            const f32x4 h = v[j] * (*(const f32x4*)(ng + col) * (*(const f32x4*)(nmx + 2 * NADA + col) + *(const f32x4*)(nb + col) + 1.0f));
            u32x2 w; w.x = cvt_pk_bf16(h.x, h.y); w.y = cvt_pk_bf16(h.z, h.w); *(u32x2*)(H + (size_t)row * D + col) = w; }
        s = wave_sum(s); if (lane == 0) atomicAdd(nssq + row, s);
    }
}

__device__ __forceinline__ void qknorm_rope_phase(bf16* QKV, const float* qg, const float* kg, const f32x2* rope, int nrows, int gw, int NGW, int lane, const slab_t* slab = nullptr, int ns = 0, int ctx_it0 = 0, const float* fssq = nullptr, const float* fsw = nullptr, int row0 = 0) {
    asm volatile("" : "+v"(lane));
    const int hl = lane >> 4, dl = (lane & 15) * 8;
    if (row0 < ML) {
        const f32x4 gq0 = *(const f32x4*)(qg + dl), gq1 = *(const f32x4*)(qg + dl + 4), gk0 = *(const f32x4*)(kg + dl), gk1 = *(const f32x4*)(kg + dl + 4);
        u32x4 cur[5], nxt[5]; f32x4 ccs[4], ncs[4];
        int row = row0 + gw;
#define QK_LOAD(dst, dcs, r_) do { const bf16* rp_ = QKV + (size_t)(r_) * NQKV + hl * HD + dl; _Pragma("unroll") for (int it = 0; it < 5; ++it) dst[it] = *(const u32x4*)(rp_ + it * 4 * HD); \
            const f32x4* cp_ = (const f32x4*)(rope + (size_t)((r_) & (SEQ - 1)) * 64 + (dl & 63)); _Pragma("unroll") for (int e = 0; e < 4; ++e) dcs[e] = cp_[e]; } while (0)
        if (row < ML) QK_LOAD(cur, ccs, row);
        while (row < ML) {
            const int nrow = row + NGW; const bool more = nrow < ML;
            if (more) QK_LOAD(nxt, ncs, nrow);
            bf16* rp = QKV + (size_t)row * NQKV + hl * HD + dl;
#pragma unroll
            for (int it = 0; it < 5; ++it) { float v[8];
#pragma unroll
                for (int e = 0; e < 4; ++e) { v[2 * e] = __uint_as_float(cur[it][e] << 16); v[2 * e + 1] = __uint_as_float(cur[it][e] & 0xffff0000u); }
                float s = 0.f;
#pragma unroll
                for (int e = 0; e < 8; ++e) s += v[e] * v[e];
                s += __shfl_xor(s, 1); s += __shfl_xor(s, 2); s += __shfl_xor(s, 4); s += __shfl_xor(s, 8);
                const float r = __builtin_amdgcn_rsqf(s * (1.0f / HD) + EPS);
                const f32x4 g0 = it < 4 ? gq0 : gk0, g1 = it < 4 ? gq1 : gk1;
#pragma unroll
                for (int e = 0; e < 4; ++e) { v[e] *= r * g0[e]; v[4 + e] *= r * g1[e]; }
                float o[8];
#pragma unroll
                for (int e = 0; e < 8; ++e) { const float pr = __shfl_xor(v[e], 8); const float cc = ccs[e >> 1][(e & 1) * 2], ss = ccs[e >> 1][(e & 1) * 2 + 1]; o[e] = v[e] * cc + ((lane & 8) ? pr : -pr) * ss; }
                u32x4 w; w.x = cvt_pk_bf16(o[0], o[1]); w.y = cvt_pk_bf16(o[2], o[3]); w.z = cvt_pk_bf16(o[4], o[5]); w.w = cvt_pk_bf16(o[6], o[7]);
                *(u32x4*)(rp + it * 4 * HD) = w; }
            if (more) {
#pragma unroll
                for (int it = 0; it < 5; ++it) cur[it] = nxt[it];
#pragma unroll
                for (int e = 0; e < 4; ++e) ccs[e] = ncs[e]; }
            row = nrow;
        }
#undef QK_LOAD
    }
    for (int row = (row0 < ML ? ML : row0) + gw; row < nrows; row += NGW) {
        bf16* rp = QKV + (size_t)row * NQKV;
        const bool lat = row < ML; const int t = row & (SEQ - 1);
        const bool fin = (slab != nullptr) && !lat;
        if (fin) {
            const slab_t* sp = slab + (size_t)(row - ML) * NQKV + HQ + HKV + lane * 8; f32x4 t0[8], t1[8];
#pragma unroll
            for (int sidx = 0; sidx < 8; ++sidx) ld8(sp + (size_t)sidx * MC * NQKV, t0[sidx], t1[sidx]);
            f32x4 a0 = t0[0], a1 = t1[0];
#pragma unroll
            for (int sidx = 1; sidx < 8; ++sidx) { a0 += t0[sidx]; a1 += t1[sidx]; }
            if (fssq) { const float rr = __builtin_amdgcn_rsqf(fssq[row] * (1.0f / D) + EPS); const float* swp = fsw + HQ + HKV + lane * 8; a0 = a0 * rr + *(const f32x4*)swp; a1 = a1 * rr + *(const f32x4*)(swp + 4); }
            u32x4 w; w.x = cvt_pk_bf16(a0[0], a0[1]); w.y = cvt_pk_bf16(a0[2], a0[3]); w.z = cvt_pk_bf16(a1[0], a1[1]); w.w = cvt_pk_bf16(a1[2], a1[3]);
            *(u32x4*)(rp + HQ + HKV + lane * 8) = w;
        }
#pragma unroll
        for (int it = 0; it < 5; ++it) {
            if (fin && it < ctx_it0) continue;
            const int head = it * 4 + hl; bf16* p = rp + head * HD + dl;
            float v[8];
            if (fin) { const slab_t* sp = slab + (size_t)(row - ML) * NQKV + head * HD + dl; f32x4 t0[8], t1[8];
#pragma unroll
                for (int sidx = 0; sidx < 8; ++sidx) ld8(sp + (size_t)sidx * MC * NQKV, t0[sidx], t1[sidx]);
                f32x4 a0 = t0[0], a1 = t1[0];
#pragma unroll
                for (int sidx = 1; sidx < 8; ++sidx) { a0 += t0[sidx]; a1 += t1[sidx]; }
                if (fssq) { const float rr = __builtin_amdgcn_rsqf(fssq[row] * (1.0f / D) + EPS); const float* swp = fsw + head * HD + dl; a0 = a0 * rr + *(const f32x4*)swp; a1 = a1 * rr + *(const f32x4*)(swp + 4); }
#pragma unroll
                for (int e = 0; e < 4; ++e) { v[e] = a0[e]; v[4 + e] = a1[e]; }
            } else { const u32x4 raw = *(const u32x4*)p;
#pragma unroll
                for (int e = 0; e < 4; ++e) { v[2 * e] = __uint_as_float(raw[e] << 16); v[2 * e + 1] = __uint_as_float(raw[e] & 0xffff0000u); } }
            float s = 0.f;
#pragma unroll
            for (int e = 0; e < 8; ++e) s += v[e] * v[e];
            s += __shfl_xor(s, 1); s += __shfl_xor(s, 2); s += __shfl_xor(s, 4); s += __shfl_xor(s, 8);
            const float r = 1.0f / sqrtf(s * (1.0f / HD) + EPS);
            const float* gp = (it < 4 ? qg : kg) + dl;
            const f32x4 g0 = *(const f32x4*)gp, g1 = *(const f32x4*)(gp + 4);
#pragma unroll
            for (int e = 0; e < 4; ++e) { v[e] *= r * g0[e]; v[4 + e] *= r * g1[e]; }
            float o[8];
            if (lat) {
                const f32x2* cs = rope + (size_t)t * 64 + (dl & 63);
#pragma unroll
                for (int e = 0; e < 8; ++e) { const float pr = __shfl_xor(v[e], 8); const f32x2 c = cs[e]; o[e] = v[e] * c.x + ((lane & 8) ? pr : -pr) * c.y; }
            } else {
#pragma unroll
                for (int e = 0; e < 8; ++e) o[e] = v[e];
            }
            u32x4 w; w.x = cvt_pk_bf16(o[0], o[1]); w.y = cvt_pk_bf16(o[2], o[3]); w.z = cvt_pk_bf16(o[4], o[5]); w.w = cvt_pk_bf16(o[6], o[7]);
            *(u32x4*)p = w;
        }
    }
}

__device__ __forceinline__ int dst_row_map(int n, int mode) { if (mode == 0) return n; const int j = n & 127; return (n >> 7) * 256 + 128 * ((j >> 2) & 1) + 32 * (j >> 5) + 8 * ((j >> 3) & 3) + (j & 3) + (mode == 2 ? 4 : 0); }
__device__ __forceinline__ void transpose_item(const float* W, int K, int N, bf16* WT, int mode, LAS float* scr, int item, int lane, int kchunk = 0, f32x4* swacc = nullptr, const float* shmx = nullptr, const float* shb = nullptr, int ldk = 0) {
    const bool sw = swacc != nullptr;
    const int nblk = N / 32, nkb = K / 64, kb = sw ? item % nkb : item / nblk, nb = sw ? item / nkb : item % nblk, k0 = 64 * kb, n0 = 32 * nb;
    const int lr = lane >> 3, lc = (lane & 7) * 4;
    f32x4 t[8];
#pragma unroll
    for (int i = 0; i < 8; ++i) t[i] = *(const f32x4*)(W + (size_t)(k0 + 8 * i + lr) * N + n0 + lc);
#pragma unroll
    for (int i = 0; i < 8; ++i) { LAS float* s = scr + (8 * i + lr) * 33 + lc; s[0] = t[i].x; s[1] = t[i].y; s[2] = t[i].z; s[3] = t[i].w; }
    if (sw) { const float bq = shb[k0 + lane]; LAS float* shs = scr + 64 * 33;
        const int tp = (lane & 7) * 8 + (lane >> 3);
        shs[tp] = shmx[k0 + lane] + bq; shs[64 + tp] = shmx[NADA + k0 + lane] + bq; shs[128 + tp] = shmx[2 * NADA + k0 + lane] + bq; }
    LDS_WAIT(); asm volatile("" ::: "memory");
    if (sw) {
        const LAS float* shs = scr + 64 * 33 + lr * 8;
#pragma unroll
        for (int bs = 0; bs < 3; ++bs) { const f32x4 s0 = *(const LAS f32x4*)(shs + 64 * bs), s1 = *(const LAS f32x4*)(shs + 64 * bs + 4);
            swacc[bs] += t[0] * s0[0] + t[1] * s0[1] + t[2] * s0[2] + t[3] * s0[3] + t[4] * s1[0] + t[5] * s1[1] + t[6] * s1[2] + t[7] * s1[3]; }
    }
    const int c = lane & 7;
#pragma unroll
    for (int j = 0; j < 4; ++j) { const int n = (lane >> 3) + 8 * j; const LAS float* s = scr + (8 * c) * 33 + n;
        u32x4 o; o.x = cvt_pk_bf16(s[0 * 33], s[1 * 33]); o.y = cvt_pk_bf16(s[2 * 33], s[3 * 33]); o.z = cvt_pk_bf16(s[4 * 33], s[5 * 33]); o.w = cvt_pk_bf16(s[6 * 33], s[7 * 33]);
        const int dr = dst_row_map(n0 + n, mode);
        bf16* dp = kchunk ? WT + ((size_t)(k0 / kchunk) * N + dr) * kchunk + (k0 % kchunk) + 8 * c : WT + (size_t)dr * (ldk ? ldk : K) + k0 + 8 * c;
        *(u32x4*)dp = o; }
    LDS_WAIT(); asm volatile("" ::: "memory");
}
template <bool SW>
__device__ __forceinline__ void transpose_group(const float* W, int K, int N, bf16* WT, int mode, LAS float* scr, int item0, int lane, f32x4* swacc, const float* shmx, const float* shb, int ldk) {
    asm volatile("" : "+v"(lane));
    const int nblk = N / 32, nkb = K / 64, kb0 = SW ? item0 % nkb : item0 / nblk, nb0 = SW ? item0 / nkb : item0 % nblk;
    const int lr = lane >> 3, lc = (lane & 7) * 4, c = lane & 7;
    const float* src = W + (size_t)(64 * kb0 + lr) * N + 32 * nb0 + lc;
    const size_t istep = SW ? (size_t)64 * N : (size_t)32;
#define TRG_LOAD(T, i) do { const float* p_ = src + (size_t)(i) * istep; _Pragma("unroll") for (int e = 0; e < 8; ++e) T[e] = __builtin_nontemporal_load((const f32x4*)(p_ + (size_t)(8 * e) * N)); } while (0)
#define TRG_FIN(T, i) do { const int k0 = 64 * (kb0 + (SW ? (i) : 0)), n0 = 32 * (nb0 + (SW ? 0 : (i))); \
        _Pragma("unroll") for (int e = 0; e < 8; ++e) { LAS float* s_ = scr + (8 * e + lr) * 33 + lc; s_[0] = T[e].x; s_[1] = T[e].y; s_[2] = T[e].z; s_[3] = T[e].w; } \
        LDS_WAIT(); asm volatile("" ::: "memory"); \
        if (SW) { const LAS float* shs_ = scr + 64 * 33 + (i) * 192 + lr * 8; \
            _Pragma("unroll") for (int bs = 0; bs < 3; ++bs) { const f32x4 s0 = *(const LAS f32x4*)(shs_ + 64 * bs), s1 = *(const LAS f32x4*)(shs_ + 64 * bs + 4); \
                swacc[bs] += T[0] * s0[0] + T[1] * s0[1] + T[2] * s0[2] + T[3] * s0[3] + T[4] * s1[0] + T[5] * s1[1] + T[6] * s1[2] + T[7] * s1[3]; } } \
        _Pragma("unroll") for (int j = 0; j < 4; ++j) { const int n = (lane >> 3) + 8 * j; const LAS float* s_ = scr + (8 * c) * 33 + n; \
            u32x4 o; o.x = cvt_pk_bf16(s_[0 * 33], s_[1 * 33]); o.y = cvt_pk_bf16(s_[2 * 33], s_[3 * 33]); o.z = cvt_pk_bf16(s_[4 * 33], s_[5 * 33]); o.w = cvt_pk_bf16(s_[6 * 33], s_[7 * 33]); \
            __builtin_nontemporal_store(o, (u32x4*)(WT + (size_t)dst_row_map(n0 + n, mode) * ldk + k0 + 8 * c)); } \
        LDS_WAIT(); asm volatile("" ::: "memory"); } while (0)
    f32x4 ta[8], tb[8];
    if (SW) {
        float bq[8], h0[8], h1[8], h2[8];
#pragma unroll
        for (int i = 0; i < 8; ++i) { const int k = 64 * (kb0 + i) + lane; bq[i] = shb[k]; h0[i] = shmx[k]; h1[i] = shmx[NADA + k]; h2[i] = shmx[2 * NADA + k]; }
        TRG_LOAD(ta, 0); asm volatile("" ::: "memory");
        const int tp = (lane & 7) * 8 + (lane >> 3); LAS float* shs = scr + 64 * 33;
#pragma unroll
        for (int i = 0; i < 8; ++i) { shs[i * 192 + tp] = h0[i] + bq[i]; shs[i * 192 + 64 + tp] = h1[i] + bq[i]; shs[i * 192 + 128 + tp] = h2[i] + bq[i]; }
    } else { TRG_LOAD(ta, 0); }
#pragma unroll 1
    for (int i = 0; i < 8; i += 2) {
        TRG_LOAD(tb, i + 1);
        TRG_FIN(ta, i);
        if (i + 2 < 8) TRG_LOAD(ta, i + 2);
        TRG_FIN(tb, i + 1);
    }
#undef TRG_LOAD
#undef TRG_FIN
}
__device__ __forceinline__ void sw_flush(f32x4* swacc, float* sw, int swN, int n0, int mode, int lane) {
    const int lr = lane >> 3, lc = (lane & 7) * 4;
#pragma unroll
    for (int bs = 0; bs < 3; ++bs) { float pick = 0.f;
#pragma unroll
        for (int e = 0; e < 4; ++e) { float v = swacc[bs][e]; v += __shfl_xor(v, 8); v += __shfl_xor(v, 16); v += __shfl_xor(v, 32); if (lr == e) pick = v; }
        if (lr < 4) atomicAdd(sw + (size_t)bs * swN + dst_row_map(n0 + lc + lr, mode), pick);
        swacc[bs] = (f32x4){0.f, 0.f, 0.f, 0.f}; }
}
struct KArgs { const float* in[21]; float* out; unsigned char* ws; int ph_lo, ph_hi; };
enum { I_X = 0, I_C, I_CTX, I_CCTX, I_WADA, I_BADA, I_NORMG, I_WG, I_WU, I_WD, I_WQKV, I_WO, I_QG, I_KG, I_SINK, I_WF, I_WSI, I_SVG, I_WSS, I_BSS, I_WSOUT };
constexpr int CW_QUEUE = 64;
constexpr int TR_FFN = 5632;
constexpr float F_SCALE_LAT = 0.00069053396600248786f;
constexpr float F_SCALE_CTX = 0.00390625f;
constexpr int ITA_TR = 4 * TR_FFN + 3072 + 4096 + 2048 + 6144, IT_F = 384, IT_DC = 256, IT_FC = 256, IT_ROPE = 1024, ITA_TOTAL = ITA_TR + IT_F + IT_DC + IT_FC + IT_ROPE;
constexpr int ITB_TOTAL = 8 * TR_FFN + 12288 + 3072;

__device__ __forceinline__ void prologue_group_b(const KArgs& a, int r0, LAS float* scr, int lane) {
    unsigned char* ws = a.ws; const float* MX = (const float*)(ws + WS_MX); const float* BA = a.in[I_BADA];
    const float* W; bf16* WT; int N, mode; float* sw; int swN; const float* shmx; const float* shb; int r = r0;
    if (r < 8 * TR_FFN) { const int kind = r / (4 * TR_FFN), l = (r / TR_FFN) & 3; r = r % TR_FFN;
        W = a.in[kind ? I_WU : I_WG] + (size_t)l * D * DFF; WT = (bf16*)(ws + WS_WGU + (size_t)l * 44 * MiB); N = DFF; mode = kind ? 2 : 1;
        sw = (float*)(ws + WS_Z2 + Z2_SWGU) + (size_t)l * 3 * 2 * DFF; swN = 2 * DFF; shmx = MX + (size_t)l * 3 * NADA + 3 * D; shb = BA + (size_t)l * NADA + 3 * D; }
    else { r -= 8 * TR_FFN;
        if (r < 12288) { W = a.in[I_WSI]; WT = (bf16*)(ws + WS_WSI); N = 2 * SGH; mode = 0; sw = (float*)(ws + WS_Z2 + Z2_SWSI); swN = 2 * SGH; shmx = MX + (size_t)2 * 3 * NADA; shb = BA + (size_t)2 * NADA; }
        else { r -= 12288; W = a.in[I_WQKV] + (size_t)D * NQKV; WT = (bf16*)(ws + WS_WQKV + (size_t)12 * MiB); N = NQKV; mode = 0; sw = (float*)(ws + WS_Z2 + Z2_SWQ3); swN = NQKV; shmx = MX + (size_t)3 * 3 * NADA; shb = BA + (size_t)3 * NADA; } }
    f32x4 swacc[3] = {{0.f, 0.f, 0.f, 0.f}, {0.f, 0.f, 0.f, 0.f}, {0.f, 0.f, 0.f, 0.f}};
    const int gidx = r >> 3, nblk = N / 32, nb = gidx % nblk, kb8 = gidx / nblk;
    transpose_group<true>(W, D, N, WT, mode, scr, nb * 32 + kb8 * 8, lane, swacc, shmx, shb, D);
    sw_flush(swacc, sw, swN, 32 * nb, mode, lane);
}
__device__ __forceinline__ void prologue_group_a(const KArgs& a, int r, LAS float* scr, int lane) {
    unsigned char* ws = a.ws; const float* W; bf16* WT; int K, N, ldk;
    if (r < 4 * TR_FFN) { const int l = r / TR_FFN; r = r % TR_FFN; W = a.in[I_WD] + (size_t)l * DFF * D; K = DFF; N = D; WT = (bf16*)(ws + WS_WDN + (size_t)l * WDN_SLOT); ldk = LDG_PAD; }
    else { r -= 4 * TR_FFN;
        if (r < 3072) { W = a.in[I_WQKV]; K = D; N = NQKV; WT = (bf16*)(ws + WS_WQKV); ldk = D; }
        else { r -= 3072;
            if (r < 4096) { const int j = r / 2048; r = r % 2048; W = a.in[I_WO] + (size_t)j * HQ * D; K = HQ; N = D; WT = (bf16*)(ws + WS_WO + (size_t)j * 8 * MiB); ldk = HQ; }
            else { r -= 4096;
                if (r < 2048) { W = a.in[I_WF]; K = D; N = D; WT = (bf16*)(ws + WS_WF); ldk = D; }
                else { r -= 2048; W = a.in[I_WSOUT]; K = SGH; N = D; WT = (bf16*)(ws + WS_WSO); ldk = SGH; } } } }
    f32x4 dummy[3];
    transpose_group<false>(W, K, N, WT, 0, scr, r, lane, dummy, nullptr, nullptr, ldk);
}
__device__ __forceinline__ void prologue_item(const KArgs& a, int r, LAS float* scr, int lane) {
    unsigned char* ws = a.ws;
    r -= ITA_TR;
    if (r < IT_F) {
        float v[8];
        if (r < 128) {
            const int e0 = r * 512 + lane * 8, i = e0 >> 8, kk0 = e0 & 255, rp = i >> 7, cp = (i >> 6) & 1, k1 = i & 63;
#pragma unroll
            for (int e = 0; e < 8; ++e) { const int kk = kk0 + e, cpi = kk >> 7, re = (kk >> 6) & 1, t1 = kk & 63; const float fr = (float)((k1 * t1) & 63) * (1.0f / 64.0f);
                float c = (rp == re) ? __builtin_amdgcn_cosf(fr) : -__builtin_amdgcn_sinf(fr); if (rp == 1 && re == 1) c = -c; v[e] = (cp == cpi) ? c : 0.f; }
            u32x4 w; w.x = cvt_pk_bf16(v[0], v[1]); w.y = cvt_pk_bf16(v[2], v[3]); w.z = cvt_pk_bf16(v[4], v[5]); w.w = cvt_pk_bf16(v[6], v[7]);
            *(u32x4*)((bf16*)(ws + WS_DA) + e0) = w;
        } else {
            const int e0 = (r - 128) * 512 + lane * 8, i = e0 >> 9, kk0 = e0 & 511, cp = i >> 7, k2 = i & 127;
#pragma unroll
            for (int e = 0; e < 8; ++e) { const int kk = kk0 + e, cpi = kk >> 8, re = (kk >> 7) & 1, t2 = kk & 127; const float fr = (float)((k2 * t2) & 127) * (1.0f / 128.0f);
                const float c = re ? __builtin_amdgcn_sinf(fr) : __builtin_amdgcn_cosf(fr); v[e] = (cp == cpi) ? F_SCALE_LAT * c : 0.f; }
            u32x4 w; w.x = cvt_pk_bf16(v[0], v[1]); w.y = cvt_pk_bf16(v[2], v[3]); w.z = cvt_pk_bf16(v[4], v[5]); w.w = cvt_pk_bf16(v[6], v[7]);
            *(u32x4*)((bf16*)(ws + WS_DB) + e0) = w;
        }
        return; }
    r -= IT_F;
    if (r < IT_DC) {
        const int e0 = r * 512 + lane * 8, row = e0 >> 8, c0 = e0 & 255, m = row & 255, reim = row >> 8; float v[8];
#pragma unroll
        for (int e = 0; e < 8; ++e) { const float fr = (float)((m * (c0 + e)) & 255) * (1.0f / 256.0f); v[e] = reim ? __builtin_amdgcn_sinf(fr) : __builtin_amdgcn_cosf(fr); }
        u32x4 w; w.x = cvt_pk_bf16(v[0], v[1]); w.y = cvt_pk_bf16(v[2], v[3]); w.z = cvt_pk_bf16(v[4], v[5]); w.w = cvt_pk_bf16(v[6], v[7]);
        *(u32x4*)((bf16*)(ws + WS_DC2) + e0) = w; return; }
    r -= IT_DC;
    if (r < IT_FC) {
        const int e0 = r * 512 + lane * 8, k = e0 >> 9, c0 = e0 & 511, reim = c0 >> 8, l0 = c0 & 255; float v[8];
#pragma unroll
        for (int e = 0; e < 8; ++e) { const int idx = ((k * (l0 + e)) + reim * 64) & 255; v[e] = F_SCALE_CTX * __builtin_amdgcn_cosf((float)idx * (1.0f / 256.0f)); }
        u32x4 w; w.x = cvt_pk_bf16(v[0], v[1]); w.y = cvt_pk_bf16(v[2], v[3]); w.z = cvt_pk_bf16(v[4], v[5]); w.w = cvt_pk_bf16(v[6], v[7]);
        *(u32x4*)((bf16*)(ws + WS_FC) + e0) = w; return; }
    r -= IT_FC;
    {
        f32x2* dst = (f32x2*)(ws + WS_ROPE) + (size_t)r * 512 + lane * 8;
#pragma unroll
        for (int e = 0; e < 8; ++e) { const int idx = r * 512 + lane * 8 + e, t = idx >> 6, f = idx & 63;
            const float inv = __builtin_amdgcn_exp2f(-(float)(f & 31) * (13.287712379549449f / 32.0f));
            const float ang = (float)(f < 32 ? (t >> 6) : (t & 63)) * inv, rev = ang * 0.15915494309189535f;
            dst[e] = (f32x2){__builtin_amdgcn_cosf(rev), __builtin_amdgcn_sinf(rev)}; }
    }
}

template <int PART> __device__ __forceinline__ void prologue_phase(const KArgs& a, LAS unsigned char* lds, gu32* ctl, int tid, int lane, int wave) {
    asm volatile("" : "+v"(tid), "+v"(lane));
    if (PART == 0) {
        LAS float* sl = (LAS float*)lds;
        LAS float* part = (LAS float*)(lds + 24576);
        for (int i = tid; i < 3 * D; i += 512) { const int r = i / D, k = i % D; const float cv = r < 2 ? a.in[I_C][r * D + k] : a.in[I_CCTX][k]; sl[i] = silu_f(cv); }
        __syncthreads();
        const int sub = lane >> 4, lc = (lane & 15) * 4;
        for (int item = blockIdx.x; item < 4 * 192; item += gridDim.x) {
            const int l = item / 192, jb = item % 192;
            const float* wp = a.in[I_WADA] + ((size_t)l * D + wave * 256 + sub) * NADA + jb * 64 + lc;
            f32x4 a0 = {0.f, 0.f, 0.f, 0.f}, a1 = a0, a2 = a0;
            for (int k = 0; k < 256; k += 32) { f32x4 w[8];
#pragma unroll
                for (int e = 0; e < 8; ++e) w[e] = *(const f32x4*)(wp + (size_t)(k + 4 * e) * NADA);
#pragma unroll
                for (int e = 0; e < 8; ++e) { const int kk = wave * 256 + k + 4 * e + sub; a0 += w[e] * sl[kk]; a1 += w[e] * sl[D + kk]; a2 += w[e] * sl[2 * D + kk]; } }
#pragma unroll
            for (int e = 0; e < 4; ++e) { a0[e] += __shfl_xor(a0[e], 16); a0[e] += __shfl_xor(a0[e], 32); a1[e] += __shfl_xor(a1[e], 16); a1[e] += __shfl_xor(a1[e], 32); a2[e] += __shfl_xor(a2[e], 16); a2[e] += __shfl_xor(a2[e], 32); }
            if (sub == 0) { *(LAS f32x4*)(part + (wave * 3 + 0) * 64 + lc) = a0; *(LAS f32x4*)(part + (wave * 3 + 1) * 64 + lc) = a1; *(LAS f32x4*)(part + (wave * 3 + 2) * 64 + lc) = a2; }
            __syncthreads();
            if (tid < 192) { const int r = tid >> 6, j = tid & 63; float s = 0.f;
#pragma unroll
                for (int w = 0; w < 8; ++w) s += part[(w * 3 + r) * 64 + j];
                ((float*)(a.ws + WS_MX))[((size_t)l * 3 + r) * NADA + jb * 64 + j] = s; }
            __syncthreads();
        }
        return;
    }
    LAS float* scr = (LAS float*)(lds + wave * 16384);
    for (;;) {
        unsigned base = 0; if (lane == 0) base = __hip_atomic_fetch_add((unsigned*)(ctl + CW_QUEUE + 64), 8u, RLX_AGENT);
        base = (unsigned)__builtin_amdgcn_readfirstlane((int)base);
        if (base >= (unsigned)ITB_TOTAL) break;
        prologue_group_b(a, (int)base, scr, lane);
    }
    for (;;) {
        unsigned base = 0; if (lane == 0) base = __hip_atomic_fetch_add((unsigned*)(ctl + CW_QUEUE), 8u, RLX_AGENT);
        base = (unsigned)__builtin_amdgcn_readfirstlane((int)base);
        if (base >= (unsigned)ITA_TOTAL) break;
        if (base < (unsigned)ITA_TR) prologue_group_a(a, (int)base, scr, lane);
        else for (int i = 0; i < 8; ++i) { const int it = (int)base + i; if (it < ITA_TOTAL) prologue_item(a, it, scr, lane); }
    }
}
namespace attn {
constexpr float SCALE = 0.08838834764831845f;
constexpr float THR = 8.f;
constexpr int SHM_K = 64 * 128 * 2, SHM_V = 64 * 128 * 2;
constexpr int OFF_V = 0, OFF_K = 2 * SHM_V, OFF_WS = 2 * SHM_V + 2 * SHM_K, LDS_BYTES = OFF_WS + 8 * 64 * 4;
#define KSWZ(row, colB) ((row) * 256 + ((colB) ^ (((row) & 7) << 4)))
#define SBAR() __builtin_amdgcn_sched_barrier(0)
__device__ __forceinline__ int v_st(int k, int c) { const int kk = (k & ~0xC) | ((k & 4) << 1) | ((k & 8) >> 1); return ((kk >> 3) * 4 + (c >> 5)) * 512 + ((kk & 7) * 32 + (c & 31)) * 2; }
__device__ __forceinline__ int v_rd_base(int lane) { return ((lane & 3) << 3) | (((lane >> 2) & 3) << 6) | (((lane >> 4) & 1) << 5) | (((lane >> 5) & 1) << 8); }
__device__ __forceinline__ int crow(int r, int hi) { return (r & 3) + 8 * (r >> 2) + 4 * hi; }
__device__ __forceinline__ void mask_tile(f32x16& p0, f32x16& p1, int dq, unsigned W) {
    const float NEG = -__builtin_inff();
#pragma unroll
    for (int r = 0; r < 16; ++r) { const int c = (r & 3) + 8 * (r >> 2);
        if ((unsigned)(dq - c) >= W) p0[r] = NEG;
        if ((unsigned)(dq - c - 32) >= W) p1[r] = NEG; }
}
__device__ __forceinline__ void partialSM(f32x16& p0, f32x16& p1, float& m_reg, float& mn, float& alpha) {
    float pmax = p0[0];
#pragma unroll
    for (int r = 1; r < 16; ++r) pmax = fmaxf(pmax, p0[r]);
#pragma unroll
    for (int r = 0; r < 16; ++r) pmax = fmaxf(pmax, p1[r]);
    { auto rr = __builtin_amdgcn_permlane32_swap(__float_as_uint(pmax), __float_as_uint(pmax), false, false);
      pmax = fmaxf(__uint_as_float(rr[0]), __uint_as_float(rr[1])); }
    constexpr float C2 = 1.4426950408889634f * SCALE;
    if (__builtin_expect(__all((pmax - m_reg) * SCALE <= THR), 1)) { mn = m_reg; alpha = 1.f; }
    else { mn = fmaxf(m_reg, pmax); alpha = __builtin_amdgcn_exp2f((m_reg - mn) * C2); m_reg = mn; }
    const float mnL = -mn * C2;
#pragma unroll
    for (int r = 0; r < 16; ++r) p0[r] = fmaf(p0[r], C2, mnL);
#pragma unroll
    for (int r = 0; r < 16; ++r) p1[r] = fmaf(p1[r], C2, mnL);
#pragma unroll
    for (int r = 0; r < 16; ++r) p0[r] = __builtin_amdgcn_exp2f(p0[r]);
}
__device__ __forceinline__ void finishSM(f32x16& p0, f32x16& p1, float alpha, float& l_reg, bf16x8& pa0, bf16x8& pa1, bf16x8& pa2, bf16x8& pa3) {
#pragma unroll
    for (int r = 0; r < 16; ++r) p1[r] = __builtin_amdgcn_exp2f(p1[r]);
    float ps = 0;
#pragma unroll
    for (int r = 0; r < 16; ++r) ps += p0[r];
#pragma unroll
    for (int r = 0; r < 16; ++r) ps += p1[r];
    { auto rr = __builtin_amdgcn_permlane32_swap(__float_as_uint(ps), __float_as_uint(ps), false, false);
      ps = __uint_as_float(rr[0]) + __uint_as_float(rr[1]); }
    l_reg = l_reg * alpha + ps;
#define PK4(P, B_, OUT) do { unsigned a0 = cvt_pk_bf16(P[B_+0], P[B_+1]), a1 = cvt_pk_bf16(P[B_+2], P[B_+3]);                          \
        unsigned b0 = cvt_pk_bf16(P[B_+4], P[B_+5]), b1 = cvt_pk_bf16(P[B_+6], P[B_+7]);                                             \
        auto r0 = __builtin_amdgcn_permlane32_swap(a0, b0, false, false); auto r1 = __builtin_amdgcn_permlane32_swap(a1, b1, false, false); \
        u32x4 w = {r0[0], r1[0], r0[1], r1[1]}; OUT = *reinterpret_cast<bf16x8*>(&w); } while (0)
    PK4(p0, 0, pa0); PK4(p0, 8, pa1); PK4(p1, 0, pa2); PK4(p1, 8, pa3);
#undef PK4
}
template <int KB>
__device__ __forceinline__ void qkt(f32x16& p0, f32x16& p1, const char* K_lds, int r32, int hi, const bf16x8* qr) {
    p0 = f32x16{}; p1 = f32x16{};
    const char* kb[4];
#pragma unroll
    for (int dd = 0; dd < 4; ++dd) kb[dd] = K_lds + KB * SHM_K + KSWZ(r32, (dd * 16 + hi * 8) * 2);
#pragma unroll
    for (int d0 = 0; d0 < 8; ++d0) { const char* a = kb[d0 & 3] + (d0 >> 2) * 128;
        bf16x8 b0 = *reinterpret_cast<const bf16x8*>(a);
        bf16x8 b1 = *reinterpret_cast<const bf16x8*>(a + 32 * 256);
        p0 = __builtin_amdgcn_mfma_f32_32x32x16_bf16(b0, qr[d0], p0, 0, 0, 0);
        p1 = __builtin_amdgcn_mfma_f32_32x32x16_bf16(b1, qr[d0], p1, 0, 0, 0); }
}
#define TRRD(dst, off) asm volatile("ds_read_b64_tr_b16 %0, %1 offset:%2" : "=&v"(dst) : "v"(vb0), "i"(off) : "memory")
#define PV_D0(oacc, vbuf, d0, pa0, pa1, pa2, pa3) do { s16x4 l0, l1, l2, l3, h0, h1, h2, h3; constexpr int b_ = (vbuf) + (d0) * 512; \
        TRRD(l0, b_); TRRD(h0, b_ + 2048); TRRD(l1, b_ + 4096); TRRD(h1, b_ + 6144); TRRD(l2, b_ + 8192); TRRD(h2, b_ + 10240); TRRD(l3, b_ + 12288); TRRD(h3, b_ + 14336); \
        asm volatile("s_waitcnt lgkmcnt(0)" ::: "memory"); SBAR(); \
        oacc = __builtin_amdgcn_mfma_f32_32x32x16_bf16(pa0, (bf16x8){l0[0], l0[1], l0[2], l0[3], h0[0], h0[1], h0[2], h0[3]}, oacc, 0, 0, 0);   \
        oacc = __builtin_amdgcn_mfma_f32_32x32x16_bf16(pa1, (bf16x8){l1[0], l1[1], l1[2], l1[3], h1[0], h1[1], h1[2], h1[3]}, oacc, 0, 0, 0);   \
        oacc = __builtin_amdgcn_mfma_f32_32x32x16_bf16(pa2, (bf16x8){l2[0], l2[1], l2[2], l2[3], h2[0], h2[1], h2[2], h2[3]}, oacc, 0, 0, 0);   \
        oacc = __builtin_amdgcn_mfma_f32_32x32x16_bf16(pa3, (bf16x8){l3[0], l3[1], l3[2], l3[3], h3[0], h3[1], h3[2], h3[3]}, oacc, 0, 0, 0); } while (0)
template <int VB>
__device__ __forceinline__ void pv_tile(f32x16* o, int vb0, bf16x8 pa0, bf16x8 pa1, bf16x8 pa2, bf16x8 pa3) {
    PV_D0(o[0], VB * SHM_V, 0, pa0, pa1, pa2, pa3); PV_D0(o[1], VB * SHM_V, 1, pa0, pa1, pa2, pa3);
    PV_D0(o[2], VB * SHM_V, 2, pa0, pa1, pa2, pa3); PV_D0(o[3], VB * SHM_V, 3, pa0, pa1, pa2, pa3);
}

struct AUnit { int qrow0, klat0, kctx0, kh, tb; };

__device__ __forceinline__ void attn_unit(const bf16* QKV, bf16* AO, const float* sink, const AUnit u, char* lds) {
    int tid = threadIdx.x; asm volatile("" : "+v"(tid));
    const int wid = __builtin_amdgcn_readfirstlane(tid >> 6), lane = tid & 63, r32 = lane & 31, hi = lane >> 5;
    const int hq = u.kh * 4 + (wid >> 1), half = wid & 1;
    char* V_lds = lds + OFF_V; char* K_lds = lds + OFF_K;
    float* wsc = (float*)(lds + OFF_WS) + wid * 64; float* li_l = wsc; float* al_l = wsc + 32;
    const int sr = tid >> 4, sc = (tid & 15) * 8, vst0 = v_st(sr, sc), vst1 = v_st(32 + sr, sc), kws = KSWZ(sr, sc * 2);
    const int vb0 = (int)(uintptr_t)V_lds + v_rd_base(lane);
    int jlo = 0, nwin = 0;
    if (u.tb >= 0) { jlo = u.tb - 2 < 0 ? 0 : u.tb - 2; const int jhi = u.tb + 2 > SEQ / 64 - 1 ? SEQ / 64 - 1 : u.tb + 2; nwin = jhi - jlo + 1; }
    const int NT = 4 + nwin;
    const bf16* kvbase = QKV + HQ + u.kh * HD + sc;
    bf16x8 st_k0, st_k1, st_v0, st_v1;
#define A_KROW(t) ((t) < 4 ? u.kctx0 + 64 * (t) : u.klat0 + 64 * (jlo + (t) - 4))
#define A_LOADK(t) do { const bf16* p_ = kvbase + (size_t)(A_KROW(t) + sr) * NQKV; st_k0 = *(const bf16x8*)p_; st_k1 = *(const bf16x8*)(p_ + (size_t)32 * NQKV); } while (0)
#define A_LOADV(t) do { const bf16* p_ = kvbase + (size_t)(A_KROW(t) + sr) * NQKV + HKV; st_v0 = *(const bf16x8*)p_; st_v1 = *(const bf16x8*)(p_ + (size_t)32 * NQKV); } while (0)
#define A_WRITEK(bf) do { *(bf16x8*)(K_lds + (bf) * SHM_K + kws) = st_k0; *(bf16x8*)(K_lds + (bf) * SHM_K + kws + 32 * 256) = st_k1; } while (0)
#define A_WRITEV(bf) do { *(bf16x8*)(V_lds + (bf) * SHM_V + vst0) = st_v0; *(bf16x8*)(V_lds + (bf) * SHM_V + vst1) = st_v1; } while (0)
    A_LOADK(0); A_LOADV(0);
    bf16x8 qr[8];
    { const bf16* qp = QKV + (size_t)(u.qrow0 + 32 * half + r32) * NQKV + hq * HD + hi * 8;
#pragma unroll
      for (int d0 = 0; d0 < 8; ++d0) qr[d0] = *(const bf16x8*)(qp + d0 * 16); }
    float m_reg = sink[hq] * (1.0f / SCALE), l_reg = 1.0f; f32x16 o[4] = {};
    const int qpos128 = 64 * u.tb + 32 * half + r32 + 128 - 4 * hi;
    VM_WAIT(); A_WRITEK(0); A_WRITEV(0);
    A_LOADK(1); VM_WAIT(); A_WRITEK(1);
    __syncthreads();
    f32x16 pA0, pA1, pB0, pB1;
    qkt<0>(pA0, pA1, K_lds, r32, hi, qr);
    __syncthreads();
#define A_RESC(a) do { if (__any((a) < 1.f)) { if (hi == 0) al_l[r32] = (a); asm volatile("s_waitcnt lgkmcnt(0)" ::: "memory");              \
                     _Pragma("unroll") for (int d_ = 0; d_ < 4; ++d_) _Pragma("unroll") for (int r = 0; r < 16; ++r) o[d_][r] *= al_l[crow(r, hi)]; } } while (0)
#define A_STEP(PX0, PX1, PY0, PY1, t, KBN, VB) do { float mn, alpha; bf16x8 pa0, pa1, pa2, pa3; \
        if ((t) + 2 < NT) A_LOADK((t) + 2); if ((t) + 1 < NT) A_LOADV((t) + 1); \
        if ((t) + 1 < NT) qkt<KBN>(PY0, PY1, K_lds, r32, hi, qr); \
        if ((t) >= 4) { const int blk = jlo + (t) - 4; if (blk == u.tb - 2 || blk == u.tb + 2) mask_tile(PX0, PX1, qpos128 - 64 * blk, 257u); } \
        partialSM(PX0, PX1, m_reg, mn, alpha); A_RESC(alpha); finishSM(PX0, PX1, alpha, l_reg, pa0, pa1, pa2, pa3); SBAR(); \
        pv_tile<VB>(o, vb0, pa0, pa1, pa2, pa3); \
        VM_WAIT(); if ((t) + 2 < NT) A_WRITEK(VB); if ((t) + 1 < NT) A_WRITEV(KBN); \
        __syncthreads(); } while (0)
    for (int t = 0; t < NT; t += 2) {
        A_STEP(pA0, pA1, pB0, pB1, t, 1, 0);
        if (t + 1 >= NT) break;
        A_STEP(pB0, pB1, pA0, pA1, t + 1, 0, 1);
    }
    if (hi == 0) li_l[r32] = l_reg; asm volatile("s_waitcnt lgkmcnt(0)" ::: "memory");
    bf16* Ow = AO + (size_t)(u.qrow0 + 32 * half) * D + hq * HD;
    char* stg = lds + wid * 8192;
#pragma unroll
    for (int r = 0; r < 16; ++r) { const int orow = crow(r, hi); const float rl = __builtin_amdgcn_rcpf(li_l[orow]);
#pragma unroll
        for (int d0 = 0; d0 < 4; ++d0) { const float v = o[d0][r] * rl; const float vn = __shfl_xor(v, 1);
            if ((r32 & 1) == 0) *(unsigned*)(stg + orow * 256 + (d0 * 32 + r32) * 2) = cvt_pk_bf16(v, vn); } }
    asm volatile("s_waitcnt lgkmcnt(0)" ::: "memory");
#pragma unroll
    for (int i = 0; i < 8; ++i) { const int row = i * 4 + (lane >> 4), ch = lane & 15; const u32x4 v = *(const u32x4*)(stg + row * 256 + ch * 16); *(u32x4*)(Ow + (size_t)row * D + ch * 8) = v; }
    asm volatile("s_waitcnt lgkmcnt(0)" ::: "memory");
    __syncthreads();
#undef A_KROW
#undef A_LOADK
#undef A_LOADV
#undef A_WRITEK
#undef A_WRITEV
#undef A_RESC
#undef A_STEP
}

__device__ __forceinline__ void attn_phase(const bf16* QKV, bf16* AO, const float* sink, bool with_ctx, int vcu, int G, char* lds) {
    for (int uid = vcu * 4; uid < 1024; uid += G * 4) {
        for (int i = 0; i < 4; ++i) { const int id = uid + i, bk = id >> 7, b = bk >> 2; AUnit u; u.kh = bk & 3; u.tb = id & 127;
            u.qrow0 = b * SEQ + 64 * u.tb; u.klat0 = b * SEQ; u.kctx0 = ML + b * CTXL; attn_unit(QKV, AO, sink, u, lds); }
    }
    if (with_ctx) for (int id = vcu; id < 32; id += G) { AUnit u; const int b = id >> 4; u.kh = (id >> 2) & 3; u.tb = -1; u.qrow0 = ML + b * CTXL + 64 * (id & 3); u.klat0 = 0; u.kctx0 = ML + b * CTXL;
        attn_unit(QKV, AO, sink, u, lds); }
}

constexpr int SG_T = 2 * SHM_V, SG_TP = 132;
__device__ __forceinline__ void sgu_unit(bf16* Z, const float* ssq, const float* wsp, const float* bsp, const float* gvv, int chunk, int g, int db0, char* lds, long store_off = 0) {
    int tid = threadIdx.x; asm volatile("" : "+v"(tid));
    const int wid = __builtin_amdgcn_readfirstlane(tid >> 6), lane = tid & 63, r32 = lane & 31, hi = lane >> 5;
    const int pb = wid & 3, dh = wid >> 2, R0 = chunk * 128;
    char* V_lds = lds; float* T = (float*)(lds + SG_T);
    const int sr = tid >> 4, sc = (tid & 15) * 8, vst0 = v_st(sr, sc), vst1 = v_st(32 + sr, sc);
    const int vb0 = (int)(uintptr_t)V_lds + v_rd_base(lane);
    bf16x8 pa[8];
    { const float* wrow = wsp + ((size_t)(g * 128 + pb * 32 + r32)) * 128 + 8 * hi; const float* sq = ssq + R0 + 8 * hi;
#pragma unroll
      for (int ks = 0; ks < 8; ++ks) { const f32x4 w0 = *(const f32x4*)(wrow + ks * 16), w1 = *(const f32x4*)(wrow + ks * 16 + 4); const f32x4 s0 = *(const f32x4*)(sq + ks * 16), s1 = *(const f32x4*)(sq + ks * 16 + 4);
          float v[8];
#pragma unroll
          for (int e = 0; e < 4; ++e) { v[e] = w0[e] * __builtin_amdgcn_rsqf(s0[e] * (1.0f / SGH) + EPS); v[4 + e] = w1[e] * __builtin_amdgcn_rsqf(s1[e] * (1.0f / SGH) + EPS); }
          u32x4 w; w.x = cvt_pk_bf16(v[0], v[1]); w.y = cvt_pk_bf16(v[2], v[3]); w.z = cvt_pk_bf16(v[4], v[5]); w.w = cvt_pk_bf16(v[6], v[7]); pa[ks] = *reinterpret_cast<bf16x8*>(&w); } }
    float bias[16];
#pragma unroll
    for (int r = 0; r < 16; ++r) bias[r] = bsp[g * 128 + pb * 32 + crow(r, hi)];
#if KCHUNK
#define ZADDR(row, col) (((size_t)((col) >> 9) * MT + (row)) * 512 + ((col) & 511))
#define ZLD 512
#else
#define ZADDR(row, col) ((size_t)(row) * (2 * SGH) + (col))
#define ZLD (2 * SGH)
#endif
    bf16x8 s00, s01, s10, s11;
#define S_LOAD(db) do { const bf16* p_ = Z + ZADDR(R0 + sr, SGH + g * SGG + (db) * 128 + sc); s00 = *(const bf16x8*)p_; s01 = *(const bf16x8*)(p_ + (size_t)32 * ZLD); \
                        s10 = *(const bf16x8*)(p_ + (size_t)64 * ZLD); s11 = *(const bf16x8*)(p_ + (size_t)96 * ZLD); } while (0)
#define S_WRITE() do { *(bf16x8*)(V_lds + vst0) = s00; *(bf16x8*)(V_lds + vst1) = s01; *(bf16x8*)(V_lds + SHM_V + vst0) = s10; *(bf16x8*)(V_lds + SHM_V + vst1) = s11; } while (0)
    S_LOAD(db0);
    for (int db = db0; db < db0 + 2; ++db) {
        VM_WAIT(); S_WRITE();
        __syncthreads();
        u32x4 ur[4]; bf16* usrc = Z + ZADDR(R0 + sr, g * SGG + db * 128 + sc);
#pragma unroll
        for (int ps = 0; ps < 4; ++ps) ur[ps] = *(const u32x4*)(usrc + (size_t)32 * ps * ZLD);
        if (db + 1 < db0 + 2) S_LOAD(db + 1);
        f32x16 o0 = {}, o1 = {};
        if (dh == 0) { PV_D0(o0, 0, 0, pa[0], pa[1], pa[2], pa[3]); PV_D0(o0, SHM_V, 0, pa[4], pa[5], pa[6], pa[7]); PV_D0(o1, 0, 1, pa[0], pa[1], pa[2], pa[3]); PV_D0(o1, SHM_V, 1, pa[4], pa[5], pa[6], pa[7]); }
        else         { PV_D0(o0, 0, 2, pa[0], pa[1], pa[2], pa[3]); PV_D0(o0, SHM_V, 2, pa[4], pa[5], pa[6], pa[7]); PV_D0(o1, 0, 3, pa[0], pa[1], pa[2], pa[3]); PV_D0(o1, SHM_V, 3, pa[4], pa[5], pa[6], pa[7]); }
        { const int colb = g * SGG + db * 128 + dh * 64 + r32; const float gv0 = gvv[colb], gv1 = gvv[colb + 32];
          float* tp = T + (size_t)(pb * 32) * SG_TP + dh * 64 + r32;
#pragma unroll
          for (int r = 0; r < 16; ++r) { const int p = crow(r, hi); tp[p * SG_TP] = gv0 * o0[r] + bias[r]; tp[p * SG_TP + 32] = gv1 * o1[r] + bias[r]; } }
        __syncthreads();
#pragma unroll
        for (int ps = 0; ps < 4; ++ps) { const float* tr = T + (size_t)(32 * ps + sr) * SG_TP + sc; const f32x4 t0 = *(const f32x4*)tr, t1 = *(const f32x4*)(tr + 4); const u32x4 u = ur[ps];
            u32x4 w; w.x = cvt_pk_bf16(__uint_as_float(u.x << 16) * t0[0], __uint_as_float(u.x & 0xffff0000u) * t0[1]); w.y = cvt_pk_bf16(__uint_as_float(u.y << 16) * t0[2], __uint_as_float(u.y & 0xffff0000u) * t0[3]);
            w.z = cvt_pk_bf16(__uint_as_float(u.z << 16) * t1[0], __uint_as_float(u.z & 0xffff0000u) * t1[1]); w.w = cvt_pk_bf16(__uint_as_float(u.w << 16) * t1[2], __uint_as_float(u.w & 0xffff0000u) * t1[3]);
            *(u32x4*)(usrc + store_off + (size_t)32 * ps * ZLD) = w; }
    }
    __syncthreads();
#undef S_LOAD
#undef S_WRITE
#undef ZADDR
#undef ZLD
}
#undef TRRD
}
constexpr int NWAVES = 8;
constexpr int RING_BYTES = 131072, LDSCTL_OFF = RING_BYTES, LDS_BYTES = 147456;
constexpr int NPH = 32;

struct Ctx { KArgs a; LAS unsigned char* lds; gu32* ctl; XcdBarrier bar; int tid, lane, wave, vcu, G, gw, NGW, lo, hi; unsigned long long tlast; };
#define PH_IN(k) (C.lo <= (k) && (k) < C.hi)
#define PH_SEAM(k) do { if (PROBE_PH) { if (C.wave == 0) { const unsigned long long n_ = __builtin_amdgcn_s_memrealtime(), d_ = n_ - C.tlast; if ((PROBE_PH >> (k)) & 1ull) { while (__builtin_amdgcn_s_memrealtime() - n_ < d_) __builtin_amdgcn_s_sleep(8); } } } \
    if (!MK_PER_PHASE && (k) + 1 < C.hi) xcd_barrier(C.bar); if (PROBE_PH) C.tlast = __builtin_amdgcn_s_memrealtime(); } while (0)
#define WSP(T, off) ((T*)(C.a.ws + (off)))

struct SchedF {
    const char* A; const char* B; int mode, G, c;
    __device__ __forceinline__ bool next(int i, pg8::Unit& u) const {
        const int L = i * G + c; u.pm = 0; u.pn = 0; u.nt = 0; u.kind = 0;
        if (mode == 0) { if (L >= 1024) return false; const int b = L >> 9, rem = L & 511, gr = rem & 15, tq = rem >> 4, g = gr >> 1, reim = gr & 1;
            u.a = A + (size_t)reim * 256 * 256 * 2; u.b = B + ((size_t)(b * SEQ + 4 * tq) * D + g * 256) * 2;
            u.o = ((((long)(b * 128 + 4 * tq) * 1024 + (g & 3) * 256) * 2 + (g >> 2)) * 2 + reim) * 64; return true; }
        if (mode == 1) { if (L >= 32) return false; const int b = L >> 4, gr = L & 15, g = gr >> 1, reim = gr & 1;
            u.a = A + (size_t)reim * 256 * 256 * 2; u.b = B + ((size_t)(ML + b * CTXL) * D + g * 256) * 2; u.o = (long)(b * D + g * 256) * 512 + reim * 256; return true; }
        if (mode == 2) { if (L >= 1024) return false; const int b = L >> 9, cp = L & 511;
            u.a = A; u.b = B + ((size_t)b * 33554432 + (size_t)cp * 512) * 2; u.o = (long)b * 33554432 + (long)cp * 1024; return true; }
        if (mode == 3) { if (L >= 512) return false; const int b = L >> 8, k1 = (L >> 2) & 63, cb = L & 3;
            u.a = A; u.b = B + ((size_t)(b * 64 + k1) * 1024 + cb * 256) * 512 * 2; u.o = (long)(b * SEQ + k1) * D + cb * 256; return true; }
        if (L >= 16) return false; { const int b = L >> 3, pn = L & 7;
            u.a = A; u.b = B + (size_t)(b * D + pn * 256) * 512 * 2; u.o = (long)(ML + b * CTXL) * D + pn * 256; return true; }
    }
};

__device__ __forceinline__ void ctx_splitk(Ctx& C, const bf16* A, int lda, const bf16* B, int ldb, int Ks, int ns, int nN, int pn0, int N, size_t aks = 0, size_t bks = 0, int gsub = 0) {
    const int cr = C.G - 1 - (int)blockIdx.x; const int Gs = gsub ? gsub : C.G; const int cs = (cr < Gs) ? cr : (1 << 28);
    const pg8::SchedSK S{(const char*)A, (const char*)B, lda, ldb, ns, nN, pn0, N, Gs, cs, aks ? aks : (size_t)Ks * 2, bks ? bks : (size_t)Ks * 2};
    const pg8::EpiSlab E{WSP(slab_t, WS_SLAB), N};
    pg8::gemm_phase<pg8::EpiSlab, pg8::SchedSK>(C.lds, pg8::mk_gemm(lda, ldb, Ks), S, E);
}
#define MXL(l) (WSP(const float, WS_MX) + (size_t)(l) * 3 * NADA)
#define BAL(l) (C.a.in[I_BADA] + (size_t)(l) * NADA)
#define SSQX(site) (WSP(float, WS_Z2 + Z2_SSQX) + (size_t)(site) * MT)
#define NORMG(l, w) (C.a.in[I_NORMG] + (size_t)((l) * 2 + (w)) * D)

template <bool NEXT, bool KCH, class TIN = xr_t, class TOUT = xr_t> __device__ __forceinline__ void residual_gemm(Ctx& C, const bf16* A, int lda, const bf16* Bt, int ldb, int K, pg8::Gemm g, int l, int gchunk, TOUT* rout, int nl, int nw, int site,
                                                                              bool ctx, int ns, int Ks, size_t aks, size_t bks, int pm0 = 0, int npan = 64, const TIN* rin = nullptr) {
    const TIN* XR = rin ? rin : (const TIN*)WSP(const xr_t, WS_XR);
    pg8::SchedRC S = pg8::make_rc(A, lda, Bt, ldb, npan, 8, D, 256, C.G, (int)blockIdx.x); S.pm0 = pm0;
    const pg8::EpiRes<NEXT, TIN, TOUT> E{XR, rout, MXL(l) + gchunk * D, BAL(l) + gchunk * D, WSP(bf16, WS_H), NORMG(nl, nw), MXL(nl) + (nw * 3 + 1) * D, BAL(nl) + (nw * 3 + 1) * D, SSQX(site)};
    if (ctx && !KCH) {
        const int cr = C.G - 1 - (int)blockIdx.x;
        const pg8::SchedSK SK{(const char*)A, (const char*)Bt, lda, ldb, ns, 8, 0, D, C.G, cr, aks ? aks : (size_t)Ks * 2, bks ? bks : (size_t)Ks * 2};
        const pg8::SchedMix<pg8::SchedRC, pg8::SchedSK> SM{S, SK, Ks / 64, cr < ns * 2 * 8};
        const pg8::Epi2<pg8::EpiRes<NEXT, TIN, TOUT>, pg8::EpiSlab> E2{E, pg8::EpiSlab{WSP(slab_t, WS_SLAB), D}};
        pg8::gemm_phase<pg8::Epi2<pg8::EpiRes<NEXT, TIN, TOUT>, pg8::EpiSlab>, pg8::SchedMix<pg8::SchedRC, pg8::SchedSK>, false>(C.lds, g, SM, E2);
    } else {
        if (ctx) ctx_splitk(C, A, lda, Bt, ldb, Ks, ns, 8, 0, D, aks, bks, STAGGER_G);
        pg8::gemm_phase<pg8::EpiRes<NEXT, TIN, TOUT>, pg8::SchedRC, KCH>(C.lds, g, S, E);
    }
}
__device__ __forceinline__ void ctxfin(Ctx& C, int ns, int l, int gchunk, int nl, int nw, int site) {
    ctxfin_phase(WSP(const slab_t, WS_SLAB), ns, MXL(l) + gchunk * D, BAL(l) + gchunk * D, WSP(xr_t, WS_XR), WSP(bf16, WS_H), NORMG(nl, nw), MXL(nl) + (nw * 3 + 1) * D, BAL(nl) + (nw * 3 + 1) * D, SSQX(site), C.gw, C.NGW, C.lane);
}
__device__ __forceinline__ void gateup_gemm(Ctx& C, int l, int nM, int site) {
    constexpr size_t GCS = (size_t)MT * 512;
    const pg8::EpiSwiGLU<true> E{WSP(bf16, WS_AR + AR_G), KCHUNK ? 512 : LDG_PAD, SSQX(site), WSP(const float, WS_Z2 + Z2_SWGU) + (size_t)l * 3 * 2 * DFF};
    { pg8::SchedRC S = pg8::make_rc(WSP(const bf16, WS_H), D, WSP(const bf16, WS_WGU + (size_t)l * 44 * MiB), D, 64, 44, KCHUNK ? 512 : LDG_PAD, 128, C.G, (int)blockIdx.x); if (KCHUNK) { S.ocl2 = 2; S.ocs = (long)GCS; }
      pg8::gemm_phase<pg8::EpiSwiGLU<true>, pg8::SchedRC>(C.lds, pg8::mk_gemm(D, D, D), S, E); }
    if (nM == 66) { pg8::SchedRC S = pg8::make_rc(WSP(const bf16, WS_H), D, WSP(const bf16, WS_WGU + (size_t)l * 44 * MiB), D, 2, 44, KCHUNK ? 512 : LDG_PAD, 128, C.G, C.G - 1 - (int)blockIdx.x); S.pm0 = 64; if (KCHUNK) { S.ocl2 = 2; S.ocs = (long)GCS; }
      pg8::gemm_phase<pg8::EpiSwiGLU<true>, pg8::SchedRC>(C.lds, pg8::mk_gemm(D, D, D), S, E); }
}
template <bool NEXT, bool LAST = false> __device__ __forceinline__ void down_gemm(Ctx& C, int l, bool ctx, int nl, int site, int pm0 = 0, int npan = 64) {
    constexpr size_t GCS = (size_t)MT * 512; constexpr int LDG = KCHUNK ? 512 : LDG_PAD;
    pg8::Gemm gd = pg8::mk_gemm(LDG, LDG, DFF); if (KCHUNK) { gd.kcl2 = 3; gd.acs = GCS * 2; gd.bcs = (size_t)D * 512 * 2; }
    if constexpr (LAST) residual_gemm<NEXT, KCHUNK != 0, xr_t, float>(C, WSP(const bf16, WS_AR + AR_G), LDG, WSP(const bf16, WS_WDN + (size_t)l * WDN_SLOT), LDG, DFF, gd, l, 5, C.a.out, nl, 0, site,
                                     ctx, 11, 512, KCHUNK ? GCS * 2 : 0, KCHUNK ? (size_t)D * 512 * 2 : 0, pm0, npan);
    else residual_gemm<NEXT, KCHUNK != 0>(C, WSP(const bf16, WS_AR + AR_G), LDG, WSP(const bf16, WS_WDN + (size_t)l * WDN_SLOT), LDG, DFF, gd, l, 5, WSP(xr_t, WS_XR), nl, 0, site,
                                     ctx, 11, 512, KCHUNK ? GCS * 2 : 0, KCHUNK ? (size_t)D * 512 * 2 : 0, pm0, npan);
}

__global__ void __launch_bounds__(NWAVES * 64, 2) mega(KArgs args) {
    extern __shared__ __attribute__((aligned(16))) unsigned char lds_raw[];
    Ctx C; C.a = args; C.lds = (LAS unsigned char*)lds_raw; C.ctl = (gu32*)(args.ws + WS_CTL);
    C.tid = threadIdx.x; C.lane = C.tid & 63; C.wave = __builtin_amdgcn_readfirstlane(C.tid >> 6);
    C.G = gridDim.x; { const int bx = blockIdx.x; C.vcu = (C.G % 8 == 0) ? (bx % 8) * (C.G / 8) + bx / 8 : bx; }
    C.gw = C.vcu * NWAVES + C.wave; C.NGW = C.G * NWAVES; C.lo = args.ph_lo; C.hi = args.ph_hi;
    volatile LAS unsigned* MISC = (volatile LAS unsigned*)(C.lds + LDSCTL_OFF);
    for (int u = C.tid; u < (LDS_BYTES - LDSCTL_OFF) / 4; u += NWAVES * 64) ((LAS unsigned*)(C.lds + LDSCTL_OFF))[u] = 0u;
    __syncthreads();
    C.bar.bar = (unsigned*)(C.ctl + CW_BAR); C.bar.x = 0; C.bar.st = nullptr;
    if (!MK_PER_PHASE) C.bar = xcd_barrier_post((unsigned*)(C.ctl + CW_BAR), MISC + 8);
    C.tlast = PROBE_PH ? __builtin_amdgcn_s_memrealtime() : 0ull;

    xr_t* XR = WSP(xr_t, WS_XR); bf16* H = WSP(bf16, WS_H);
    bf16* QKV = WSP(bf16, WS_AR + AR_QKV); bf16* AO = WSP(bf16, WS_AR + AR_AO);
    if (PH_IN(0)) { prologue_phase<0>(C.a, C.lds, C.ctl, C.tid, C.lane, C.wave); PH_SEAM(0); }
    if (PH_IN(1)) { prologue_phase<1>(C.a, C.lds, C.ctl, C.tid, C.lane, C.wave);
        if (!MK_PER_PHASE || true) { asm volatile("s_waitcnt vmcnt(0) lgkmcnt(0)" ::: "memory"); __syncthreads(); modnorm_phase(C.a.in[I_X], C.a.in[I_CTX], XR, H, NORMG(0, 0), MXL(0), BAL(0), 0, MT, C.gw, C.NGW, C.lane); }
        PH_SEAM(1); }

    if (PH_IN(3)) { const bf16* Wq = WSP(const bf16, WS_WQKV);
        { const pg8::SchedRC S = pg8::make_rc(H, D, Wq, D, 64, 12, NQKV, 256, C.G, (int)blockIdx.x);
          const pg8::EpiBf16<0, false, false> E{QKV, NQKV, nullptr, 0, nullptr, nullptr, 0};
          const int cr = C.G - 1 - (int)blockIdx.x;
          const pg8::SchedSK SK{(const char*)H, (const char*)Wq, D, D, 8, 12, 0, NQKV, C.G, cr, (size_t)256 * 2, (size_t)256 * 2};
          const pg8::SchedMix<pg8::SchedRC, pg8::SchedSK> SM{S, SK, 4, cr < 8 * 2 * 12};
          const pg8::Epi2<pg8::EpiBf16<0, false, false>, pg8::EpiSlab> E2{E, pg8::EpiSlab{WSP(slab_t, WS_SLAB), NQKV}};
          pg8::gemm_phase<pg8::Epi2<pg8::EpiBf16<0, false, false>, pg8::EpiSlab>, pg8::SchedMix<pg8::SchedRC, pg8::SchedSK>>(C.lds, pg8::mk_gemm(D, D, D), SM, E2); }
        PH_SEAM(3); }
    if (PH_IN(4)) { qknorm_rope_phase(QKV, C.a.in[I_QG], C.a.in[I_KG], WSP(const f32x2, WS_ROPE), MT, C.gw, C.NGW, C.lane, WSP(const slab_t, WS_SLAB), 8, 0); PH_SEAM(4); }
    if (PH_IN(5)) { attn::attn_phase(QKV, AO, C.a.in[I_SINK], true, C.vcu, C.G, (char*)C.lds); PH_SEAM(5); }
    if (PH_IN(6)) { residual_gemm<true, false, float, xr_t>(C, AO, D, WSP(const bf16, WS_WO), D, D, pg8::mk_gemm(D, D, D), 0, 2, XR, 0, 1, 0, true, 8, 256, 0, 0, 0, 64, C.a.in[I_X]); PH_SEAM(6); }
    if (PH_IN(7)) { ctxfin(C, 8, 0, 2, 0, 1, 0); PH_SEAM(7); }
    if (PH_IN(8)) { gateup_gemm(C, 0, 66, 0); PH_SEAM(8); }
    if (PH_IN(9)) { down_gemm<false>(C, 0, true, 0, 0); PH_SEAM(9); }

    {
        bf16* XA = WSP(bf16, WS_AR + AR_XA); bf16* XB = WSP(bf16, WS_AR + AR_XB); bf16* XTC = WSP(bf16, WS_AR + AR_XTC); bf16* Y = WSP(bf16, WS_AR + AR_Y);
        if (PH_IN(10)) { modnorm_phase(XR, XR + (size_t)ML * D, nullptr, H, NORMG(1, 0), MXL(1), BAL(1), 0, MT, C.gw, C.NGW, C.lane, WSP(const slab_t, WS_SLAB), 11, MXL(0) + 5 * D, BAL(0) + 5 * D, XR); PH_SEAM(10); }
        if (PH_IN(11)) {
            { const SchedF S{(const char*)WSP(bf16, WS_DC2), (const char*)H, 0, C.G, (int)blockIdx.x}; const pg8::EpiF1 E{XA};
              pg8::Gemm g = pg8::mk_gemm(256, 128 * D, 256); g.bs_log2 = 6; g.ldb_hi = D; g.hsB = 2 * D;
              pg8::gemm_phase<pg8::EpiF1, SchedF>(C.lds, g, S, E); }
            { const SchedF S{(const char*)WSP(bf16, WS_DC2), (const char*)H, 1, C.G, C.G - 1 - (int)blockIdx.x}; const pg8::EpiBf16<0, false, false> E{XTC, 512, nullptr, 0, nullptr, nullptr, 0};
              pg8::gemm_phase<pg8::EpiBf16<0, false, false>, SchedF>(C.lds, pg8::mk_gemm(256, D, 256), S, E); }
            PH_SEAM(11); }
        if (PH_IN(12)) {
            { const SchedF S{(const char*)WSP(bf16, WS_DA), (const char*)XA, 2, C.G, (int)blockIdx.x}; const pg8::EpiFA E{XB};
              pg8::Gemm g = pg8::mk_gemm(256, 262144, 256); g.hsB = 256;
              pg8::gemm_phase<pg8::EpiFA, SchedF>(C.lds, g, S, E); }
            { const SchedF S{(const char*)WSP(bf16, WS_FC), (const char*)XTC, 4, C.G, C.G - 1 - (int)blockIdx.x}; const pg8::EpiBf16<0, false, false> E{Y, D, nullptr, 0, nullptr, nullptr, 0};
              pg8::gemm_phase<pg8::EpiBf16<0, false, false>, SchedF>(C.lds, pg8::mk_gemm(512, 512, 512), S, E); }
            PH_SEAM(12); }
        if (PH_IN(13)) {
            const SchedF S{(const char*)WSP(bf16, WS_DB), (const char*)XB, 3, C.G, (int)blockIdx.x}; const pg8::EpiFB E{Y};
            pg8::gemm_phase<pg8::EpiFB, SchedF>(C.lds, pg8::mk_gemm(512, 512, 512), S, E);
            PH_SEAM(13); }
        if (PH_IN(14)) { residual_gemm<true, false>(C, Y, D, WSP(const bf16, WS_WF), D, D, pg8::mk_gemm(D, D, D), 1, 2, XR, 1, 1, 1, true, 8, 256, 0, 0); PH_SEAM(14); }
    }
    if (PH_IN(15)) { ctxfin(C, 8, 1, 2, 1, 1, 1); PH_SEAM(15); }
    if (PH_IN(16)) { gateup_gemm(C, 1, 66, 1); PH_SEAM(16); }
    if (PH_IN(17)) { down_gemm<true>(C, 1, true, 2, 2); PH_SEAM(17); }
    if (PH_IN(18)) { ctxfin(C, 11, 1, 5, 2, 0, 2); PH_SEAM(18); }

    {
        bf16* Z = WSP(bf16, WS_AR + AR_Z); float* SSQ = (float*)(C.a.ws + WS_CTL) + CW_SSQ;
        constexpr size_t ZCS = (size_t)MT * 512; constexpr int LDZ = KCHUNK ? 512 : 2 * SGH;
        if (PH_IN(19)) { const pg8::EpiBf16<1, true, true> E{Z, LDZ, SSQ, 24, SSQX(2), WSP(const float, WS_Z2 + Z2_SWSI), 2 * SGH};
            { pg8::SchedRC S = pg8::make_rc(H, D, WSP(const bf16, WS_WSI), D, 64, 48, LDZ, 256, C.G, (int)blockIdx.x); if (KCHUNK) { S.ocl2 = 1; S.ocs = (long)ZCS; }
              pg8::gemm_phase<pg8::EpiBf16<1, true, true>, pg8::SchedRC>(C.lds, pg8::mk_gemm(D, D, D), S, E); }
            { pg8::SchedRC S = pg8::make_rc(H, D, WSP(const bf16, WS_WSI), D, 2, 48, LDZ, 256, C.G, C.G - 1 - (int)blockIdx.x); S.pm0 = 64; if (KCHUNK) { S.ocl2 = 1; S.ocs = (long)ZCS; }
              pg8::gemm_phase<pg8::EpiBf16<1, true, true>, pg8::SchedRC>(C.lds, pg8::mk_gemm(D, D, D), S, E); }
            PH_SEAM(19); }
        if (PH_IN(20)) { for (int uid = C.vcu; uid < (MT / 128) * 24; uid += C.G) { const int cg = uid / 3; attn::sgu_unit(Z, SSQ, C.a.in[I_WSS], C.a.in[I_BSS], C.a.in[I_SVG], cg >> 3, cg & 7, 2 * (uid - 3 * cg), (char*)C.lds); } PH_SEAM(20); }
        if (PH_IN(21)) { pg8::Gemm go = pg8::mk_gemm(LDZ, KCHUNK ? 512 : SGH, SGH); if (KCHUNK) { go.kcl2 = 3; go.acs = ZCS * 2; go.bcs = (size_t)D * 512 * 2; }
            residual_gemm<true, KCHUNK != 0>(C, Z, LDZ, WSP(const bf16, WS_WSO), KCHUNK ? 512 : SGH, SGH, go, 2, 2, XR, 2, 1, 3, true, 12, 512, KCHUNK ? ZCS * 2 : 0, KCHUNK ? (size_t)D * 512 * 2 : 0); PH_SEAM(21); }
    }
    if (PH_IN(22)) { ctxfin(C, 12, 2, 2, 2, 1, 3); PH_SEAM(22); }
    if (PH_IN(23)) { gateup_gemm(C, 2, 66, 3); PH_SEAM(23); }
    if (PH_IN(24)) { down_gemm<true>(C, 2, true, 3, 4); PH_SEAM(24); }
    if (PH_IN(25)) { ctxfin(C, 11, 2, 5, 3, 0, 4); PH_SEAM(25); }

    if (PH_IN(26)) { const bf16* Wq = WSP(const bf16, WS_WQKV + (size_t)12 * MiB);
        { const pg8::SchedRC S = pg8::make_rc(H, D, Wq, D, 64, 12, NQKV, 256, C.G, (int)blockIdx.x);
          const pg8::EpiBf16<0, false, true> E{QKV, NQKV, nullptr, 0, SSQX(4), WSP(const float, WS_Z2 + Z2_SWQ3), NQKV};
          const int cr = C.G - 1 - (int)blockIdx.x;
          const pg8::SchedSK SK{(const char*)H, (const char*)Wq, D, D, 8, 4, 8, NQKV, C.G, cr, (size_t)256 * 2, (size_t)256 * 2};
          const pg8::SchedMix<pg8::SchedRC, pg8::SchedSK> SM{S, SK, 4, cr < 8 * 2 * 4};
          const pg8::Epi2<pg8::EpiBf16<0, false, true>, pg8::EpiSlab> E2{E, pg8::EpiSlab{WSP(slab_t, WS_SLAB), NQKV}};
          pg8::gemm_phase<pg8::Epi2<pg8::EpiBf16<0, false, true>, pg8::EpiSlab>, pg8::SchedMix<pg8::SchedRC, pg8::SchedSK>>(C.lds, pg8::mk_gemm(D, D, D), SM, E2); }
        PH_SEAM(26); }
    if (PH_IN(27)) { qknorm_rope_phase(QKV, C.a.in[I_QG] + HD, C.a.in[I_KG] + HD, WSP(const f32x2, WS_ROPE), MT, C.gw, C.NGW, C.lane, WSP(const slab_t, WS_SLAB), 8, 4, SSQX(4), WSP(const float, WS_Z2 + Z2_SWQ3) + 2 * NQKV); PH_SEAM(27); }
    if (PH_IN(28)) { attn::attn_phase(QKV, AO, C.a.in[I_SINK] + NH, false, C.vcu, C.G, (char*)C.lds); PH_SEAM(28); }
    if (PH_IN(29)) { residual_gemm<true, false>(C, AO, D, WSP(const bf16, WS_WO + (size_t)8 * MiB), D, D, pg8::mk_gemm(D, D, D), 3, 2, XR, 3, 1, 5, false, 0, 0, 0, 0); PH_SEAM(29); }
    if (PH_IN(30)) { gateup_gemm(C, 3, 64, 5); PH_SEAM(30); }
    if (PH_IN(31)) { down_gemm<false, true>(C, 3, false, 0, 0); PH_SEAM(31); }
}

extern "C" void kernel_launch(void* const* d_in, const int* in_sizes, int n_in, void* d_out, int out_size, void* d_ws, size_t ws_size, hipStream_t stream) {
    static int grid = 0;
    if (grid == 0) {
        if (n_in != 21 || in_sizes[0] != ML * D || out_size != ML * D || ws_size < WS_END) { fprintf(stderr, "kernel_launch: unexpected shapes (n_in %d, in0 %d, out %d, ws %zu < %zu)\n", n_in, n_in > 0 ? in_sizes[0] : -1, out_size, ws_size, (size_t)WS_END); grid = -1; return; }
        int dev = 0, cus = 0, per_cu = 0;
        if (hipGetDevice(&dev) != hipSuccess || hipDeviceGetAttribute(&cus, hipDeviceAttributeMultiprocessorCount, dev) != hipSuccess) { grid = -1; return; }
        if (hipFuncSetAttribute((const void*)mega, hipFuncAttributeMaxDynamicSharedMemorySize, LDS_BYTES) != hipSuccess) { fprintf(stderr, "kernel_launch: hipFuncSetAttribute failed\n"); grid = -1; return; }
        if (hipOccupancyMaxActiveBlocksPerMultiprocessor(&per_cu, (const void*)mega, NWAVES * 64, LDS_BYTES) != hipSuccess || per_cu < 1) fprintf(stderr, "kernel_launch: occupancy query says %d\n", per_cu);
        (void)hipGetLastError();
        grid = cus;
    }
    if (grid < 0) return;
    if (hipMemsetAsync((char*)d_ws + WS_CTL, 0, CTL_ZERO_BYTES, stream) != hipSuccess) return;
    KArgs a{};
    for (int i = 0; i < 21; ++i) a.in[i] = (const float*)d_in[i];
    a.out = (float*)d_out; a.ws = (unsigned char*)d_ws;
#if MK_PER_PHASE
    for (int ph = 0; ph < NPH; ++ph) { a.ph_lo = ph; a.ph_hi = ph + 1; hipLaunchKernelGGL(mega, dim3(grid), dim3(NWAVES * 64), LDS_BYTES, stream, a); }
#else
    a.ph_lo = 0; a.ph_hi = NPH; hipLaunchKernelGGL(mega, dim3(grid), dim3(NWAVES * 64), LDS_BYTES, stream, a);
#endif
}
```

```cpp
#include <hip/hip_runtime.h>
#include <cstdio>
#include <cstdint>

#ifndef MK_PER_PHASE
#define MK_PER_PHASE 0
#endif

#ifndef KCHUNK
#define KCHUNK 0
#endif
#ifndef GLDS_SADDR
#define GLDS_SADDR 1
#endif
#ifndef SK_POS
#define SK_POS 0
#endif
#ifndef STAGGER_G
#define STAGGER_G 0
#endif
#ifndef PROBE_BAR2
#define PROBE_BAR2 0
#endif
#ifndef PROBE_PH
#define PROBE_PH 0ull
#endif
#ifndef PROBE_T
#define PROBE_T 0
#endif
#ifndef PROBE_DUP
#define PROBE_DUP 0
#endif
constexpr int D = 2048, NBATCH = 2, SEQ = 8192, CTXL = 256, DEPTH = 4;
constexpr int ML = NBATCH * SEQ, MC = NBATCH * CTXL, MT = ML + MC;
constexpr int NH = 16, NKV = 4, HD = 128, HQ = 2048, HKV = 512, NQKV = HQ + 2 * HKV;
constexpr int DFF = 5632, SGH = 6144, SGG = 768, NADA = 6 * D;
constexpr float EPS = 1e-6f;

constexpr size_t MiB = 1u << 20;
constexpr size_t WS_CTL = 0, CTL_ZERO_BYTES = 2 * MiB;
constexpr size_t WS_MX = 2 * MiB;
constexpr size_t WS_ROPE = 3 * MiB;
constexpr size_t WS_DC2 = 7 * MiB;
constexpr size_t WS_DB = WS_DC2 + 256 * 1024;
constexpr size_t WS_FC = WS_DC2 + 512 * 1024;
constexpr size_t WS_DA = WS_DC2 + 768 * 1024;
constexpr size_t WS_WGU = 8 * MiB;
constexpr size_t WS_WDN = WS_WGU + 4 * 44 * MiB;
constexpr int LDG_PAD = 5760;
constexpr size_t WDN_SLOT = 24 * MiB;
constexpr size_t WS_WQKV = WS_WDN + 4 * WDN_SLOT;
constexpr size_t WS_WO = WS_WQKV + 2 * 12 * MiB;
constexpr size_t WS_WF = WS_WO + 2 * 8 * MiB;
constexpr size_t WS_WSI = WS_WF + 8 * MiB;
constexpr size_t WS_WSO = WS_WSI + 48 * MiB;
constexpr size_t WS_XR = WS_WSO + 24 * MiB;
constexpr size_t WS_H = WS_XR + 132 * MiB;
constexpr size_t WS_AR = WS_H + 66 * MiB;
constexpr size_t AR_QKV = 0, AR_AO = 99 * MiB;
constexpr size_t AR_G = 0;
constexpr size_t AR_Z = 0;
constexpr size_t AR_XA = 0, AR_XB = 128 * MiB, AR_XTC = 256 * MiB, AR_Y = 260 * MiB;
constexpr size_t WS_SLAB = WS_AR + 396 * MiB;
constexpr size_t WS_Z2 = WS_CTL + 256 * 1024, Z2_BYTES = 1280 * 1024;
constexpr size_t Z2_SWGU = 0;
constexpr size_t Z2_SWSI = 540672;
constexpr size_t Z2_SWQ3 = Z2_SWSI + 147456;
constexpr size_t Z2_SSQX = 786432;
static_assert(Z2_SWQ3 + 36864 <= Z2_SSQX && Z2_SSQX + 6 * 16896 * 4 <= Z2_BYTES, "z2");
constexpr size_t WS_END = WS_SLAB + 72 * MiB;
constexpr int CW_TMO = 0;
constexpr int CW_BAR = 4096;
constexpr int CW_SSQ = 16384;
static_assert((size_t)(CW_SSQ + MT) * 4 <= WS_Z2 && WS_Z2 + Z2_BYTES <= WS_CTL + CTL_ZERO_BYTES, "ctl");

#define GAS __attribute__((address_space(1)))
#define LAS __attribute__((address_space(3)))
typedef unsigned short bf16;
typedef unsigned short bf16_t;
typedef short bf16x8 __attribute__((ext_vector_type(8)));
typedef short s16x4 __attribute__((ext_vector_type(4)));
typedef float f32x4 __attribute__((ext_vector_type(4)));
typedef float f32x2 __attribute__((ext_vector_type(2)));
typedef float f32x16 __attribute__((ext_vector_type(16)));
typedef unsigned u32x4 __attribute__((ext_vector_type(4)));
typedef unsigned u32x2 __attribute__((ext_vector_type(2)));

typedef _Float16 xr_t;
typedef _Float16 slab_t;
typedef _Float16 h16x4 __attribute__((ext_vector_type(4)));
__device__ __forceinline__ f32x4 ld4(const float* p) { return *(const f32x4*)p; }
__device__ __forceinline__ f32x4 ld4(const xr_t* p) { return __builtin_convertvector(*(const h16x4*)p, f32x4); }
__device__ __forceinline__ void st4(float* p, f32x4 v) { *(f32x4*)p = v; }
__device__ __forceinline__ void st4(xr_t* p, f32x4 v) { *(h16x4*)p = __builtin_convertvector(v, h16x4); }
typedef _Float16 h16x8 __attribute__((ext_vector_type(8)));
typedef float f32x8 __attribute__((ext_vector_type(8)));
__device__ __forceinline__ void ld8(const float* p, f32x4& a, f32x4& b) { a = *(const f32x4*)p; b = *(const f32x4*)(p + 4); }
__device__ __forceinline__ void ld8(const xr_t* p, f32x4& a, f32x4& b) { const f32x8 v = __builtin_convertvector(*(const h16x8*)p, f32x8); a = (f32x4){v[0], v[1], v[2], v[3]}; b = (f32x4){v[4], v[5], v[6], v[7]}; }
__device__ __forceinline__ void st8(float* p, f32x4 a, f32x4 b) { *(f32x4*)p = a; *(f32x4*)(p + 4) = b; }
__device__ __forceinline__ void st8(xr_t* p, f32x4 a, f32x4 b) { const f32x8 v = {a[0], a[1], a[2], a[3], b[0], b[1], b[2], b[3]}; *(h16x8*)p = __builtin_convertvector(v, h16x8); }
__device__ __forceinline__ unsigned cvt_pk_bf16(float lo, float hi) { unsigned r; asm volatile("v_cvt_pk_bf16_f32 %0, %1, %2" : "=v"(r) : "v"(lo), "v"(hi)); return r; }
__device__ __forceinline__ float bf2f(unsigned short b) { return __uint_as_float(((unsigned)b) << 16); }

namespace pg8 {
#define PG8_LAS __attribute__((address_space(3)))
constexpr int BM = 256, BK = 64, HALF = 128, HTB = HALF * BK * 2, STAGE_BYTES = 8 * HTB, NXCD = 8, WGM = 8;
__host__ __device__ __forceinline__ int lds_byte(int r, int c) { const int st = (r >> 4) * 2 + (c >> 5), rr = r & 15, cc = c & 31, ob = rr * 64 + cc * 2; return st * 1024 + (ob ^ (((ob >> 9) & 1) << 5)); }
__host__ __device__ __forceinline__ void stage_rc(int b, int& R, int& C) { const int st = b / 1024, sb = b % 1024, swz = sb ^ (((sb >> 9) & 1) << 5); R = (st >> 1) * 16 + swz / 64; C = (st & 1) * 32 + (swz % 64) / 2; }
__host__ __device__ __forceinline__ int perm32(int rho) { const int n = rho >> 4, i = rho & 15; return 8 * (i >> 2) + 4 * n + (i & 3); }

struct Unit { const char* a; const char* b; long o; int pm, pn, nt, kind; };
struct Gemm { int lda, ldb, K, bs_log2, ldb_hi; long hsB; int kcl2; size_t acs, bcs; };
__device__ __forceinline__ Gemm mk_gemm(int lda, int ldb, int K) { Gemm g; g.lda = lda; g.ldb = ldb; g.K = K; g.bs_log2 = 7; g.ldb_hi = 0; g.hsB = (long)HALF * ldb; g.kcl2 = 24; g.acs = 0; g.bcs = 0; return g; }

__device__ __forceinline__ void tile_of(int L, int nM, int nN, int& pm, int& pn, int wgm = WGM) {
    const int nwg = nM * nN; int wgid = L;
    { const int q = nwg / NXCD, r = nwg % NXCD, xcd = wgid % NXCD, off = wgid / NXCD; wgid = (xcd < r ? xcd * (q + 1) : r * (q + 1) + (xcd - r) * q) + off; }
    const int nig = wgm * nN, gid = wgid / nig, fm = gid * wgm, gsz = (nM - fm) < wgm ? (nM - fm) : wgm;
    pm = fm + ((wgid % nig) % gsz); pn = (wgid % nig) / gsz;
}

__device__ __forceinline__ f32x2 gelu_pk(f32x2 v) {
    const f32x2 av = __builtin_elementwise_abs(v), d = av * 0.2316418882f + 1.0f;
    f32x2 t; t.x = __builtin_amdgcn_rcpf(d.x); t.y = __builtin_amdgcn_rcpf(d.y);
    f32x2 q = t * 0.5307027145f + (-0.7265760135f); q = q * t + 0.7107068705f; q = q * t + (-0.142248368f); q = q * t + 0.127414796f; q = q * t;
    const f32x2 s = (v * v) * (-0.72134752044f);
    f32x2 e; e.x = __builtin_amdgcn_exp2f(s.x); e.y = __builtin_amdgcn_exp2f(s.y);
    const f32x2 m = v * (q * e), r = v - m;
    f32x2 o; o.x = v.x < 0.f ? m.x : r.x; o.y = v.y < 0.f ? m.y : r.y; return o;
}

template <class Epi, class Sched, bool KCH = false, bool ALIGN_EPI = true, bool SP2 = true, int TPROBE = 0>
__device__ __forceinline__ void gemm_phase(PG8_LAS unsigned char* lds, const Gemm g, const Sched& S, const Epi& E) {
    int tid = threadIdx.x; asm volatile("" : "+v"(tid));
    const int wid = __builtin_amdgcn_readfirstlane(tid >> 6), lane = tid & 63, wr = wid >> 2, wc = wid & 3, fr = lane & 15, fq = lane >> 4;
    const int K = g.K; int nt = K / BK;
    unsigned voffA[2], voffB[2];
#pragma unroll
    for (int i = 0; i < 2; ++i) { int R, C; stage_rc(tid * 16 + i * 8192, R, C); const int Rb = Epi::PERM ? ((R & ~31) + perm32(R & 31)) : R;
        voffA[i] = (unsigned)(R * g.lda + C) * 2u; voffB[i] = (unsigned)((Rb & ((1 << g.bs_log2) - 1)) * g.ldb + (Rb >> g.bs_log2) * g.ldb_hi + C) * 2u; }
    const size_t kstep = (size_t)(BK * 2);
    const size_t hstepA = (size_t)HALF * g.lda * 2, hstepB = (size_t)g.hsB * 2;
    const unsigned ldsw = (unsigned)wid * 1024u;
    const int aoff = lds_byte(wr * 64 + fr, fq * 8), boff = lds_byte(wc * 32 + fr, fq * 8);
#define PG8_SA(b, h) (((b) * 2 + (h)) * HTB)
#define PG8_SB(b, h) ((4 + (b) * 2 + (h)) * HTB)
#if GLDS_SADDR
    const unsigned lds0 = (unsigned)(uintptr_t)lds + ldsw;
#define PG8_STAGE(bufoff, gbase, voff) do { _Pragma("unroll") for (int _i = 0; _i < 2; ++_i) { unsigned keep_; \
        asm volatile("s_mov_b32 %0, m0\n\ts_mov_b32 m0, %3\n\ts_nop 0\n\tglobal_load_lds_dwordx4 %1, %2\n\ts_mov_b32 m0, %0" : "=&s"(keep_) : "v"((voff)[_i]), "s"((const char*)(gbase)), "s"((unsigned)__builtin_amdgcn_readfirstlane((int)(lds0 + (unsigned)(bufoff) + (unsigned)(_i * 8192)))) : "memory"); } } while (0)
#else
#define PG8_STAGE(bufoff, gbase, voff) do { _Pragma("unroll") for (int _i = 0; _i < 2; ++_i) \
        __builtin_amdgcn_global_load_lds((const unsigned*)((const char*)(gbase) + (voff)[_i]), (PG8_LAS unsigned*)(lds + (bufoff) + ldsw + _i * 8192), 16, 0, 0); } while (0)
#endif
#define PG8_LDA(dst, b, h) do { _Pragma("unroll") for (int m = 0; m < 4; ++m) _Pragma("unroll") for (int k = 0; k < 2; ++k) dst[m][k] = *(const PG8_LAS bf16x8*)(lds + PG8_SA(b, h) + aoff + m * 2048 + k * 1024); } while (0)
#define PG8_LDB(dst, b, h) do { _Pragma("unroll") for (int n = 0; n < 2; ++n) _Pragma("unroll") for (int k = 0; k < 2; ++k) dst[n][k] = *(const PG8_LAS bf16x8*)(lds + PG8_SB(b, h) + boff + n * 2048 + k * 1024); } while (0)
#define PG8_MMA(ai, bj, At, Bt) do { __builtin_amdgcn_s_setprio(1); _Pragma("unroll") for (int m = 0; m < 4; ++m) _Pragma("unroll") for (int n = 0; n < 2; ++n) _Pragma("unroll") for (int k = 0; k < 2; ++k) \
        acc[ai][bj][m][n] = __builtin_amdgcn_mfma_f32_16x16x32_bf16(Bt[n][k], At[m][k], acc[ai][bj][m][n], 0, 0, 0); __builtin_amdgcn_s_setprio(0); } while (0)
#define PG8_WAIT_V(n) asm volatile("s_waitcnt vmcnt(" #n ")" ::: "memory")
#define PG8_WAIT_L(n) asm volatile("s_waitcnt lgkmcnt(" #n ")" ::: "memory")
#define PG8_BAR __builtin_amdgcn_s_barrier()
#define PG8_SCHED __builtin_amdgcn_sched_barrier(0)
    Unit cur, nxt; int ui = 0;
    if (!S.next(0, cur)) return;
    if (cur.nt) nt = cur.nt;
    unsigned long long tp_acc = 0, tp_t0 = 0; if (TPROBE) tp_t0 = __builtin_amdgcn_s_memrealtime();
    f32x4 acc[2][2][4][2];
#pragma unroll
    for (int a = 0; a < 2; ++a)
#pragma unroll
        for (int b = 0; b < 2; ++b)
#pragma unroll
            for (int m = 0; m < 4; ++m)
#pragma unroll
                for (int n = 0; n < 2; ++n) acc[a][b][m][n] = (f32x4){0.f, 0.f, 0.f, 0.f};
    bf16x8 At[4][2], B0[2][2], B1[2][2];
    const char* cA = cur.a; const char* cB = cur.b;
    if constexpr (SP2) {
        PG8_STAGE(PG8_SB(0, 0), cB, voffB); PG8_STAGE(PG8_SB(0, 1), cB + hstepB, voffB); PG8_STAGE(PG8_SA(0, 0), cA, voffA); PG8_STAGE(PG8_SA(0, 1), cA + hstepA, voffA);
        if (wr == 1) PG8_BAR;
        PG8_WAIT_V(2); PG8_BAR;
        PG8_STAGE(PG8_SB(1, 0), cB + kstep, voffB); PG8_STAGE(PG8_SA(1, 0), cA + kstep, voffA); PG8_STAGE(PG8_SB(1, 1), cB + hstepB + kstep, voffB);
        PG8_WAIT_V(6); PG8_BAR;
    } else {
        PG8_STAGE(PG8_SB(0, 0), cB, voffB); PG8_STAGE(PG8_SA(0, 0), cA, voffA); PG8_STAGE(PG8_SB(0, 1), cB + hstepB, voffB); PG8_STAGE(PG8_SA(0, 1), cA + hstepA, voffA);
        if (wr == 1) PG8_BAR;
        PG8_WAIT_V(4); PG8_BAR;
        PG8_STAGE(PG8_SB(1, 0), cB + kstep, voffB); PG8_STAGE(PG8_SA(1, 0), cA + kstep, voffA); PG8_STAGE(PG8_SB(1, 1), cB + hstepB + kstep, voffB);
        PG8_WAIT_V(6); PG8_BAR;
    }
    for (;;) {
        const bool has_next = S.next(ui + 1, nxt);
        const char* nA = has_next ? nxt.a : cA; const char* nB = has_next ? nxt.b : cB;
        for (int t = 0; t < nt; t += 2) {
            const bool last = (t == nt - 2);
            const char* a1; const char* a2; const char* b2;
            if constexpr (KCH) { const int t2_ = t + 2, tc_ = t2_ >> g.kcl2, tr_ = t2_ & ((1 << g.kcl2) - 1);
                a1 = cA + (size_t)(t >> g.kcl2) * g.acs + (size_t)((t & ((1 << g.kcl2) - 1)) + 1) * kstep;
                a2 = last ? nA : cA + (size_t)tc_ * g.acs + (size_t)tr_ * kstep; b2 = last ? nB : cB + (size_t)tc_ * g.bcs + (size_t)tr_ * kstep;
            } else { a1 = cA + (size_t)(t + 1) * kstep; a2 = last ? nA : cA + (size_t)(t + 2) * kstep; b2 = last ? nB : cB + (size_t)(t + 2) * kstep; }
            const char* a3 = a2 + kstep; const char* b3 = b2 + kstep;
            if constexpr (SP2) {
            PG8_LDB(B0, 0, 0); PG8_LDB(B1, 0, 1); PG8_SCHED; PG8_LDA(At, 0, 0); PG8_STAGE(PG8_SA(1, 1), a1 + hstepA, voffA);
            PG8_WAIT_V(8); PG8_WAIT_L(0); PG8_BAR; PG8_MMA(0, 0, At, B0); PG8_MMA(0, 1, At, B1); PG8_BAR; PG8_SCHED;
            PG8_LDA(At, 0, 1); PG8_STAGE(PG8_SB(0, 0), b2, voffB); PG8_STAGE(PG8_SB(0, 1), b2 + hstepB, voffB); PG8_STAGE(PG8_SA(0, 0), a2, voffA);
            PG8_WAIT_V(8); PG8_WAIT_L(0); PG8_BAR; PG8_MMA(1, 0, At, B0); PG8_MMA(1, 1, At, B1); PG8_BAR; PG8_SCHED;
            PG8_LDB(B0, 1, 0); PG8_LDB(B1, 1, 1); PG8_SCHED; PG8_LDA(At, 1, 0); PG8_STAGE(PG8_SA(0, 1), a2 + hstepA, voffA);
            PG8_WAIT_V(8); PG8_WAIT_L(0); PG8_BAR; PG8_MMA(0, 0, At, B0); PG8_MMA(0, 1, At, B1); PG8_BAR; PG8_SCHED;
            PG8_LDA(At, 1, 1); PG8_STAGE(PG8_SB(1, 0), b3, voffB); PG8_STAGE(PG8_SB(1, 1), b3 + hstepB, voffB); PG8_STAGE(PG8_SA(1, 0), a3, voffA);
            PG8_WAIT_V(8); PG8_WAIT_L(0); PG8_BAR; PG8_MMA(1, 0, At, B0); PG8_MMA(1, 1, At, B1); PG8_BAR; PG8_SCHED;
            } else {
            PG8_LDB(B0, 0, 0); PG8_SCHED; PG8_LDA(At, 0, 0); PG8_STAGE(PG8_SA(1, 1), a1 + hstepA, voffA);
            PG8_WAIT_L(8); PG8_BAR; PG8_WAIT_L(0); PG8_MMA(0, 0, At, B0); PG8_BAR; PG8_SCHED;
            PG8_LDB(B1, 0, 1); PG8_STAGE(PG8_SB(0, 0), b2, voffB);
            PG8_BAR; PG8_WAIT_L(0); PG8_MMA(0, 1, At, B1); PG8_BAR;
            PG8_LDA(At, 0, 1); PG8_STAGE(PG8_SA(0, 0), a2, voffA);
            PG8_BAR; PG8_WAIT_L(0); PG8_MMA(1, 0, At, B0); PG8_BAR; PG8_SCHED;
            PG8_STAGE(PG8_SB(0, 1), b2 + hstepB, voffB);
            PG8_WAIT_V(6); PG8_BAR; PG8_MMA(1, 1, At, B1); PG8_BAR;
            PG8_LDB(B0, 1, 0); PG8_SCHED; PG8_LDA(At, 1, 0); PG8_STAGE(PG8_SA(0, 1), a2 + hstepA, voffA);
            PG8_WAIT_L(8); PG8_BAR; PG8_WAIT_L(0); PG8_MMA(0, 0, At, B0); PG8_BAR; PG8_SCHED;
            PG8_LDB(B1, 1, 1); PG8_STAGE(PG8_SB(1, 0), b3, voffB);
            PG8_BAR; PG8_WAIT_L(0); PG8_MMA(0, 1, At, B1); PG8_BAR;
            PG8_LDA(At, 1, 1); PG8_STAGE(PG8_SA(1, 0), a3, voffA);
            PG8_BAR; PG8_WAIT_L(0); PG8_MMA(1, 0, At, B0); PG8_BAR; PG8_SCHED;
            PG8_STAGE(PG8_SB(1, 1), b3 + hstepB, voffB);
            PG8_WAIT_V(6); PG8_BAR; PG8_MMA(1, 1, At, B1); PG8_BAR;
            }
        }
        if (TPROBE == 2) { const unsigned long long t_ = __builtin_amdgcn_s_memrealtime(); tp_acc += t_ - tp_t0; }
        if (TPROBE == 1) tp_t0 = __builtin_amdgcn_s_memrealtime();
        if constexpr (ALIGN_EPI) { if (wr == 0) PG8_BAR; }
        E(acc, cur, wr, wc, fr, fq);
        if (!has_next) { if (TPROBE == 1) { const unsigned long long t_ = __builtin_amdgcn_s_memrealtime(); tp_acc += t_ - tp_t0; } break; }
#pragma unroll
        for (int a = 0; a < 2; ++a)
#pragma unroll
            for (int b = 0; b < 2; ++b)
#pragma unroll
                for (int m = 0; m < 4; ++m)
#pragma unroll
                    for (int n = 0; n < 2; ++n) acc[a][b][m][n] = (f32x4){0.f, 0.f, 0.f, 0.f};
        cur = nxt; cA = nA; cB = nB; ++ui; nt = cur.nt ? cur.nt : K / BK;
        if constexpr (ALIGN_EPI) { if (wr == 1) PG8_BAR; }
        if (TPROBE == 1) { const unsigned long long t_ = __builtin_amdgcn_s_memrealtime(); tp_acc += t_ - tp_t0; }
        if (TPROBE == 2) tp_t0 = __builtin_amdgcn_s_memrealtime();
    }
    PG8_WAIT_V(0);
    if constexpr (!ALIGN_EPI) { if (wr == 0) PG8_BAR; }
    PG8_BAR;
    if (TPROBE) { if (wid == 0) { const unsigned long long t1_ = __builtin_amdgcn_s_memrealtime(); while (__builtin_amdgcn_s_memrealtime() - t1_ < tp_acc) __builtin_amdgcn_s_sleep(8); } PG8_BAR; }
#undef PG8_SA
#undef PG8_SB
#undef PG8_STAGE
#undef PG8_LDA
#undef PG8_LDB
#undef PG8_MMA
#undef PG8_WAIT_V
#undef PG8_WAIT_L
#undef PG8_BAR
#undef PG8_SCHED
}
}
namespace pg8 {
__device__ __forceinline__ int bsel_of(int pm) { return pm < 32 ? 0 : (pm < 64 ? 1 : 2); }

template <int ACT, bool SSQ, bool FUSED = false> struct EpiBf16 {
    static constexpr bool PERM = true;
    bf16_t* O; int ldc; float* ssq; int ssq_pn0; const float* nssq; const float* nsw; int nswN;
    __device__ __forceinline__ void operator()(const f32x4 (&acc)[2][2][4][2], const Unit& u, int wr, int wc, int fr, int fq) const {
        bf16_t* base = O + u.o + (size_t)(wr * 64 + fr) * ldc + wc * 32 + 8 * fq;
        const bool do_ssq = SSQ && (u.pn >= ssq_pn0);
        f32x4 swv[2][2];
        if (FUSED) { const float* sp = nsw + (size_t)bsel_of(u.pm) * nswN + u.pn * BM + wc * 32 + 8 * fq;
#pragma unroll
            for (int bj = 0; bj < 2; ++bj) { swv[bj][0] = *(const f32x4*)(sp + bj * HALF); swv[bj][1] = *(const f32x4*)(sp + bj * HALF + 4); } }
#pragma unroll
        for (int ai = 0; ai < 2; ++ai)
#pragma unroll
            for (int m = 0; m < 4; ++m) { bf16_t* rowp = base + (size_t)(ai * HALF + m * 16) * ldc; float s = 0.f;
                float rr = 1.f; if (FUSED) rr = __builtin_amdgcn_rsqf(nssq[u.pm * BM + ai * HALF + wr * 64 + m * 16 + fr] * (1.0f / D) + EPS);
#pragma unroll
                for (int bj = 0; bj < 2; ++bj) { f32x4 v0 = acc[ai][bj][m][0], v1 = acc[ai][bj][m][1];
                    if (FUSED) { v0 = v0 * rr + swv[bj][0]; v1 = v1 * rr + swv[bj][1]; }
                    if (ACT == 1) { f32x2 a = gelu_pk((f32x2){v0[0], v0[1]}), b = gelu_pk((f32x2){v0[2], v0[3]}), c = gelu_pk((f32x2){v1[0], v1[1]}), d = gelu_pk((f32x2){v1[2], v1[3]});
                        v0 = (f32x4){a.x, a.y, b.x, b.y}; v1 = (f32x4){c.x, c.y, d.x, d.y}; }
                    if (SSQ) s += (v0[0] * v0[0] + v0[1] * v0[1]) + (v0[2] * v0[2] + v0[3] * v0[3]) + (v1[0] * v1[0] + v1[1] * v1[1]) + (v1[2] * v1[2] + v1[3] * v1[3]);
                    u32x4 w; w.x = cvt_pk_bf16(v0[0], v0[1]); w.y = cvt_pk_bf16(v0[2], v0[3]); w.z = cvt_pk_bf16(v1[0], v1[1]); w.w = cvt_pk_bf16(v1[2], v1[3]);
                    *(u32x4*)(rowp + bj * HALF) = w; }
                if (SSQ) { if (do_ssq) { s += __shfl_xor(s, 16); s += __shfl_xor(s, 32);
                    if (fq == 0) atomicAdd(ssq + u.pm * BM + ai * HALF + wr * 64 + m * 16 + fr, s); } }
            }
    }
};

template <bool NEXT, class TIN, class TOUT> struct EpiRes {
    static constexpr bool PERM = true;
    const TIN* rin; TOUT* rout; const float* gmx; const float* gb;
    bf16_t* hq; const float* ng; const float* nmx; const float* nb; float* nssq;
    __device__ __forceinline__ void operator()(const f32x4 (&acc)[2][2][4][2], const Unit& u, int wr, int wc, int fr, int fq) const {
        const int bs = bsel_of(u.pm); const int col0 = u.pn * BM + wc * 32 + 8 * fq;
        f32x4 gv[2][2], gn[2][2];
#pragma unroll
        for (int bj = 0; bj < 2; ++bj)
#pragma unroll
            for (int n = 0; n < 2; ++n) { const int cc = col0 + bj * HALF + n * 4; gv[bj][n] = *(const f32x4*)(gmx + bs * NADA + cc) + *(const f32x4*)(gb + cc);
                if (NEXT) gn[bj][n] = *(const f32x4*)(ng + cc) * (*(const f32x4*)(nmx + bs * NADA + cc) + *(const f32x4*)(nb + cc) + 1.0f); }
        f32x4 xr[2][2][2];
#define ER_LOAD(g) do { const size_t off_ = (size_t)(u.pm * BM + ((g) >> 2) * HALF + wr * 64 + ((g) & 3) * 16 + fr) * D + col0; \
            _Pragma("unroll") for (int bj = 0; bj < 2; ++bj) ld8(rin + off_ + bj * HALF, xr[(g) & 1][bj][0], xr[(g) & 1][bj][1]); } while (0)
        ER_LOAD(0);
#pragma unroll
        for (int g = 0; g < 8; ++g) { const int ai = g >> 2, m = g & 3;
            if (g + 1 < 8) ER_LOAD(g + 1);
            const int row = u.pm * BM + ai * HALF + wr * 64 + m * 16 + fr; const size_t off = (size_t)row * D + col0; float s = 0.f;
#pragma unroll
            for (int bj = 0; bj < 2; ++bj) { const f32x4 o0 = xr[g & 1][bj][0] + gv[bj][0] * acc[ai][bj][m][0], o1 = xr[g & 1][bj][1] + gv[bj][1] * acc[ai][bj][m][1];
                st8(rout + off + bj * HALF, o0, o1);
                if (NEXT) { s += (o0[0] * o0[0] + o0[1] * o0[1]) + (o0[2] * o0[2] + o0[3] * o0[3]) + (o1[0] * o1[0] + o1[1] * o1[1]) + (o1[2] * o1[2] + o1[3] * o1[3]);
                    const f32x4 h0 = o0 * gn[bj][0], h1 = o1 * gn[bj][1]; u32x4 w; w.x = cvt_pk_bf16(h0[0], h0[1]); w.y = cvt_pk_bf16(h0[2], h0[3]); w.z = cvt_pk_bf16(h1[0], h1[1]); w.w = cvt_pk_bf16(h1[2], h1[3]);
                    *(u32x4*)(hq + off + bj * HALF) = w; } }
            if (NEXT) { s += __shfl_xor(s, 16); s += __shfl_xor(s, 32); if (fq == 0) atomicAdd(nssq + row, s); }
            asm volatile("" ::: "memory"); }
#undef ER_LOAD
    }
};

template <bool FUSED> struct EpiSwiGLU {
    static constexpr bool PERM = true;
    bf16_t* G; int ldg; const float* nssq; const float* nsw;
    __device__ __forceinline__ void operator()(const f32x4 (&acc)[2][2][4][2], const Unit& u, int wr, int wc, int fr, int fq) const {
        bf16_t* base = G + u.o + (size_t)(wr * 64 + fr) * ldg + wc * 32 + 8 * fq;
        f32x4 swv[2][2];
        if (FUSED) { const float* sp = nsw + (size_t)bsel_of(u.pm) * (2 * DFF) + u.pn * BM + wc * 32 + 8 * fq;
#pragma unroll
            for (int bj = 0; bj < 2; ++bj) { swv[bj][0] = *(const f32x4*)(sp + bj * HALF); swv[bj][1] = *(const f32x4*)(sp + bj * HALF + 4); } }
#pragma unroll
        for (int ai = 0; ai < 2; ++ai)
#pragma unroll
            for (int m = 0; m < 4; ++m) { bf16_t* rowp = base + (size_t)(ai * HALF + m * 16) * ldg;
                float rr = 1.f; if (FUSED) rr = __builtin_amdgcn_rsqf(nssq[u.pm * BM + ai * HALF + wr * 64 + m * 16 + fr] * (1.0f / D) + EPS);
                u32x4 w;
#pragma unroll
                for (int bj = 0; bj < 2; ++bj) { f32x4 g = acc[ai][bj][m][0], up = acc[ai][bj][m][1]; f32x4 o;
                    if (FUSED) { g = g * rr + swv[bj][0]; up = up * rr + swv[bj][1]; }
#pragma unroll
                    for (int e = 0; e < 4; ++e) { const float sg = __builtin_amdgcn_rcpf(1.f + __builtin_amdgcn_exp2f(-1.4426950408889634f * g[e])); o[e] = g[e] * sg * up[e]; }
                    w[2 * bj] = cvt_pk_bf16(o[0], o[1]); w[2 * bj + 1] = cvt_pk_bf16(o[2], o[3]); }
                *(u32x4*)rowp = w; }
    }
};

struct EpiF1 {
    static constexpr bool PERM = true;
    bf16_t* O;
    __device__ __forceinline__ void operator()(const f32x4 (&acc)[2][2][4][2], const Unit& u, int wr, int wc, int fr, int fq) const {
        bf16_t* base = O + u.o + (size_t)(wr * 64 + fr) * 256 + (size_t)(wc >> 1) * 262144 + 32 * (wc & 1) + 8 * fq;
#pragma unroll
        for (int ai = 0; ai < 2; ++ai)
#pragma unroll
            for (int m = 0; m < 4; ++m)
#pragma unroll
                for (int bj = 0; bj < 2; ++bj) { const f32x4 v0 = acc[ai][bj][m][0], v1 = acc[ai][bj][m][1];
                    u32x4 w; w.x = cvt_pk_bf16(v0[0], v0[1]); w.y = cvt_pk_bf16(v0[2], v0[3]); w.z = cvt_pk_bf16(v1[0], v1[1]); w.w = cvt_pk_bf16(v1[2], v1[3]);
                    *(u32x4*)(base + (size_t)(ai * HALF + m * 16) * 256 + (size_t)bj * 2 * 262144) = w; }
    }
};
struct EpiFA {
    static constexpr bool PERM = true;
    bf16_t* O;
    __device__ __forceinline__ void operator()(const f32x4 (&acc)[2][2][4][2], const Unit& u, int wr, int wc, int fr, int fq) const {
        const int t20 = 32 * wc + 8 * fq;
        bf16_t* base = O + u.o + (size_t)wr * 256 + t20;
#pragma unroll
        for (int m = 0; m < 4; ++m) { int k1 = 16 * m + fr; asm volatile("" : "+v"(k1));     u32x4 wre[2], wim[2];
#pragma unroll
            for (int e2 = 0; e2 < 4; ++e2) { float cs[2], sn[2];
#pragma unroll
                for (int q = 0; q < 2; ++q) { const float fr_ = (float)((k1 * (t20 + 2 * e2 + q)) & 8191) * (1.0f / 8192.0f); cs[q] = __builtin_amdgcn_cosf(fr_); sn[q] = __builtin_amdgcn_sinf(fr_); }
#pragma unroll
                for (int bj = 0; bj < 2; ++bj) { float zr[2], zi[2];
#pragma unroll
                    for (int q = 0; q < 2; ++q) { const int e = 2 * e2 + q; const float a = acc[0][bj][m][e >> 2][e & 3], b = acc[1][bj][m][e >> 2][e & 3];
                        zr[q] = a * cs[q] + b * sn[q]; zi[q] = b * cs[q] - a * sn[q]; }
                    wre[bj][e2] = cvt_pk_bf16(zr[0], zr[1]); wim[bj][e2] = cvt_pk_bf16(zi[0], zi[1]); }
                __builtin_amdgcn_sched_barrier(0); }
#pragma unroll
            for (int bj = 0; bj < 2; ++bj) { bf16_t* p = base + (size_t)k1 * 524288 + (size_t)bj * 512; *(u32x4*)p = wre[bj]; *(u32x4*)(p + 128) = wim[bj]; } }
    }
};
struct EpiFB {
    static constexpr bool PERM = true;
    bf16_t* O;
    __device__ __forceinline__ void operator()(const f32x4 (&acc)[2][2][4][2], const Unit& u, int wr, int wc, int fr, int fq) const {
        bf16_t* base = O + u.o + (size_t)(64 * wr + fr) * (64 * D) + wc * 32 + 8 * fq;
#pragma unroll
        for (int ai = 0; ai < 2; ++ai)
#pragma unroll
            for (int m = 0; m < 4; ++m)
#pragma unroll
                for (int bj = 0; bj < 2; ++bj) { const f32x4 v0 = acc[ai][bj][m][0], v1 = acc[ai][bj][m][1];
                    u32x4 w; w.x = cvt_pk_bf16(v0[0], v0[1]); w.y = cvt_pk_bf16(v0[2], v0[3]); w.z = cvt_pk_bf16(v1[0], v1[1]); w.w = cvt_pk_bf16(v1[2], v1[3]);
                    *(u32x4*)(base + (size_t)(16 * m) * (64 * D) + ai * 1024 + bj * HALF) = w; }
    }
};

struct EpiSlab {
    static constexpr bool PERM = true;
    slab_t* O; int ldc;
    __device__ __forceinline__ void operator()(const f32x4 (&acc)[2][2][4][2], const Unit& u, int wr, int wc, int fr, int fq) const {
        slab_t* base = O + u.o + (size_t)(wr * 64 + fr) * ldc + wc * 32 + 8 * fq;
#pragma unroll
        for (int ai = 0; ai < 2; ++ai)
#pragma unroll
            for (int m = 0; m < 4; ++m) { slab_t* rowp = base + (size_t)(ai * HALF + m * 16) * ldc;
#pragma unroll
                for (int bj = 0; bj < 2; ++bj) st8(rowp + bj * HALF, acc[ai][bj][m][0], acc[ai][bj][m][1]); }
    }
};
struct SchedSK {
    const char* A; const char* B; int lda, ldb, ns, nN, pn0, N, G, c; size_t aks, bks;
    __device__ __forceinline__ bool next(int i, Unit& u) const {
        const int L = i * G + c; if (L >= ns * 2 * nN) return false;
        const int s = L % ns, t = L / ns, pmc = t & 1, pn = pn0 + (t >> 1);
        u.a = A + (size_t)(ML + pmc * 256) * lda * 2 + (size_t)s * aks; u.b = B + (size_t)pn * 256 * ldb * 2 + (size_t)s * bks;
        u.o = ((long)s * MC + pmc * 256) * N + pn * 256; u.pm = 64 + pmc; u.pn = pn; u.nt = 0; u.kind = 0; return true;
    }
};

template <class EA, class EB> struct Epi2 {
    static constexpr bool PERM = EA::PERM; static_assert(EA::PERM == EB::PERM, "Epi2: layouts differ");
    EA ea; EB eb;
    __device__ __forceinline__ void operator()(const f32x4 (&acc)[2][2][4][2], const Unit& u, int wr, int wc, int fr, int fq) const { if (u.kind) eb(acc, u, wr, wc, fr, fq); else ea(acc, u, wr, wc, fr, fq); }
};
template <class SA  , class SB  > struct SchedMix {
    SA lat; SB sk; int nt_sk; bool has;
    __device__ __forceinline__ bool next(int i, Unit& u) const {
        if (has) { if (i == SK_POS) { sk.next(0, u); u.nt = nt_sk; u.kind = 1; return true; } return lat.next(i < SK_POS ? i : i - 1, u); }
        return lat.next(i, u);
    }
};

struct SchedRC {
    const char* A; const char* B; size_t atile, btile; long ldo, ocs; int ow, nM, nN, G, c, wgm, ocl2, pm0, pmsplit, pmjump, pnflip;
    __device__ __forceinline__ bool next(int i, Unit& u) const {
        const long L = (long)i * G + c; if (L >= (long)nM * nN) return false;
        int pm, pn; tile_of((int)L, nM, nN, pm, pn, wgm); pm += pm0 + (pm >= pmsplit ? pmjump : 0); if (pnflip) pn = nN - 1 - pn;
        u.a = A + (size_t)pm * atile; u.b = B + (size_t)pn * btile; u.o = (long)(pn >> ocl2) * ocs + (long)pm * BM * ldo + (long)(pn & ((1 << ocl2) - 1)) * ow; u.pm = pm; u.pn = pn; u.nt = 0; u.kind = 0; return true;
    }
};
__device__ __forceinline__ SchedRC make_rc(const bf16_t* A, int lda, const bf16_t* B, int ldb, int nM, int nN, long ldo, int ow, int G, int c, int wgm = WGM) {
    SchedRC s; s.pnflip = 0; s.wgm = wgm; s.ocl2 = 24; s.ocs = 0; s.pm0 = 0; s.pmsplit = 1 << 20; s.pmjump = 0; s.A = (const char*)A; s.B = (const char*)B; s.atile = (size_t)BM * lda * 2; s.btile = (size_t)BM * ldb * 2; s.ldo = ldo; s.ow = ow; s.nM = nM; s.nN = nN; s.G = G; s.c = c; return s;
}
}
typedef GAS unsigned gu32;
#define RLX_AGENT __ATOMIC_RELAXED, __HIP_MEMORY_SCOPE_AGENT
#define XB_TMO      128
#define XB_XCNT(j)  (256  + 64 * (j))
#define XB_XSUB(j)  (1280 + 64 * (j))
#define XB_XGEN(j)  (2304 + 64 * (j))
#define XB_TOP      3328
#define XB_TOPGEN   3392
#define XCD_BAR_WORDS 3456
#define XB_SPIN_CAP (1u << 18)
__device__ __forceinline__ unsigned xb_ld(unsigned* p)              { return __hip_atomic_load(p, __ATOMIC_RELAXED, __HIP_MEMORY_SCOPE_AGENT); }
__device__ __forceinline__ unsigned xb_add(unsigned* p, unsigned v) { return __hip_atomic_fetch_add(p, v, __ATOMIC_RELAXED, __HIP_MEMORY_SCOPE_AGENT); }
__device__ __forceinline__ unsigned xb_xcc_id() { return (unsigned)__builtin_amdgcn_s_getreg((3 << 11) | 20) & 0xFu; }
#define XB_SPIN(cond, bar) do { unsigned _sp = 0; while (cond) { __builtin_amdgcn_s_sleep(1); \
    if ((++_sp & 255u) == 0u) { if (xb_ld(&(bar)[XB_TMO])) break; if (_sp > XB_SPIN_CAP) { atomicAdd(&(bar)[XB_TMO], 1u); break; } } } } while (0)
struct XcdBarrier { unsigned* bar; unsigned x; volatile LAS unsigned* st; };
__device__ __forceinline__ XcdBarrier xcd_barrier_post(unsigned* bar, volatile LAS unsigned* st) {
    XcdBarrier b; b.bar = bar; b.x = xb_xcc_id(); b.st = st;
    if (threadIdx.x == 0) (void)xb_add(&bar[XB_XCNT(b.x)], 1u);
    return b;
}
__device__ __forceinline__ void xcd_barrier_complete(unsigned* bar, unsigned x, unsigned& nloc, unsigned& nx) {
    const unsigned G = gridDim.x * gridDim.y * gridDim.z;
    unsigned sum, cnt, mine, sp = 0u;
    for (;;) {
        sum = 0u; cnt = 0u; mine = 0u;
#pragma unroll
        for (unsigned j = 0; j < 16; ++j) { const unsigned c = xb_ld(&bar[XB_XCNT(j)]); sum += c; cnt += (c > 0u) ? 1u : 0u; mine = (j == x) ? c : mine; }
        if (sum == G) break;
        __builtin_amdgcn_s_sleep(1);
        if ((++sp & 255u) == 0u) { if (xb_ld(&bar[XB_TMO])) break; if (sp > XB_SPIN_CAP) { atomicAdd(&bar[XB_TMO], 1u); break; } }
    }
    nloc = mine > 0u ? mine : 1u; nx = cnt > 0u ? cnt : 1u;
}
__device__ __forceinline__ void xcd_barrier(const XcdBarrier& b) {
    asm volatile("s_waitcnt vmcnt(0)" ::: "memory");
    __syncthreads();
    if (threadIdx.x == 0) {
        unsigned* bar = b.bar;
        __builtin_amdgcn_s_waitcnt(0);
        unsigned nloc = b.st[0], nx = b.st[1];
        if (nloc == 0u) { xcd_barrier_complete(bar, b.x, nloc, nx); b.st[0] = nloc; b.st[1] = nx; }
        const unsigned old = xb_add(&bar[XB_XSUB(b.x)], 1u);
        const unsigned gen = old / nloc;
        if (old + 1u == (gen + 1u) * nloc) {
            __builtin_amdgcn_fence(__ATOMIC_RELEASE, "agent");
            asm volatile("s_waitcnt vmcnt(0)" ::: "memory");
            const unsigned og = xb_add(&bar[XB_TOP], 1u);
            const unsigned tg = og / nx;
            if (og + 1u == (tg + 1u) * nx) xb_add(&bar[XB_TOPGEN], 1u);
            else XB_SPIN(xb_ld(&bar[XB_TOPGEN]) == tg, bar);
            __builtin_amdgcn_fence(__ATOMIC_ACQUIRE, "agent");
            xb_add(&bar[XB_XGEN(b.x)], 1u);
            asm volatile("s_waitcnt vmcnt(0)" ::: "memory");
        } else {
            XB_SPIN(xb_ld(&bar[XB_XGEN(b.x)]) == gen, bar);
            __builtin_amdgcn_fence(__ATOMIC_ACQUIRE, "agent");
            asm volatile("s_waitcnt vmcnt(0)" ::: "memory");
        }
    }
    __syncthreads();
}
#define LDS_WAIT() asm volatile("s_waitcnt lgkmcnt(0)" ::: "memory")
#define VM_WAIT() asm volatile("s_waitcnt vmcnt(0)" ::: "memory")
__device__ __forceinline__ float wave_sum(float v) {
#pragma unroll
    for (int o = 1; o < 64; o <<= 1) v += __shfl_xor(v, o);
    return v;
}
__device__ __forceinline__ float silu_f(float x) { return x / (1.f + __expf(-x)); }

template <class TX> __device__ __forceinline__ void modnorm_phase(const TX* xlat, const TX* xctx, xr_t* xr_out, bf16* H, const float* g, const float* mxl, const float* bl,
                                              int which, int nrows, int gw, int NGW, int lane, const slab_t* fin_slab = nullptr, int fin_ns = 0, const float* fin_gmx = nullptr, const float* fin_gb = nullptr, xr_t* fin_xr = nullptr) {
    asm volatile("" : "+v"(lane));
    int cur_bs = -1; f32x4 gs[8], sh[8];
    const int csh = (which * 3) * D, csc = (which * 3 + 1) * D;
    int row = gw;
    if (row < ML) {
        f32x4 v[8], vn[8];
#pragma unroll
        for (int j = 0; j < 8; ++j) v[j] = ld4(xlat + (size_t)row * D + 4 * lane + 256 * j);
        for (; row < ML; row += NGW) {
            const int nrow = row + NGW;
            if (nrow < ML) {
#pragma unroll
                for (int j = 0; j < 8; ++j) vn[j] = ld4(xlat + (size_t)nrow * D + 4 * lane + 256 * j);
            }
            const int bs = row < SEQ ? 0 : 1;
            if (bs != cur_bs) {
#pragma unroll
                for (int j = 0; j < 8; ++j) { const int col = 4 * lane + 256 * j;
                    const f32x4 gg = *(const f32x4*)(g + col);
                    const f32x4 sc = *(const f32x4*)(mxl + bs * NADA + csc + col) + *(const f32x4*)(bl + csc + col);
                    sh[j] = *(const f32x4*)(mxl + bs * NADA + csh + col) + *(const f32x4*)(bl + csh + col);
                    gs[j] = gg * (sc + 1.0f); }
                cur_bs = bs;
            }
            float s = 0.f;
#pragma unroll
            for (int j = 0; j < 8; ++j) s += (v[j].x * v[j].x + v[j].y * v[j].y) + (v[j].z * v[j].z + v[j].w * v[j].w);
            const float r = 1.0f / sqrtf(wave_sum(s) * (1.0f / D) + EPS);
            bf16* hrow = H + (size_t)row * D;
#pragma unroll
            for (int j = 0; j < 8; ++j) { const f32x4 o = v[j] * r * gs[j] + sh[j]; u32x2 w; w.x = cvt_pk_bf16(o.x, o.y); w.y = cvt_pk_bf16(o.z, o.w);
                *(u32x2*)(hrow + 4 * lane + 256 * j) = w; }
#pragma unroll
            for (int j = 0; j < 8; ++j) v[j] = vn[j];
        }
    }
    for (; row < nrows; row += NGW) {
        const int bs = row < SEQ ? 0 : (row < ML ? 1 : 2);
        if (bs != cur_bs) {
#pragma unroll
            for (int j = 0; j < 8; ++j) { const int col = 4 * lane + 256 * j;
                const f32x4 gg = *(const f32x4*)(g + col);
                const f32x4 sc = *(const f32x4*)(mxl + bs * NADA + csc + col) + *(const f32x4*)(bl + csc + col);
                sh[j] = *(const f32x4*)(mxl + bs * NADA + csh + col) + *(const f32x4*)(bl + csh + col);
                gs[j] = gg * (sc + 1.0f); }
            cur_bs = bs;
        }
        const TX* src = row < ML ? xlat + (size_t)row * D : xctx + (size_t)(row - ML) * D;
        f32x4 v[8]; float s = 0.f;
#pragma unroll
        for (int j = 0; j < 8; ++j) v[j] = ld4(src + 4 * lane + 256 * j);
        if (fin_slab && row >= ML) {
            f32x4 a[8];
#pragma unroll
            for (int j = 0; j < 8; ++j) a[j] = (f32x4){0.f, 0.f, 0.f, 0.f};
            const slab_t* sp = fin_slab + (size_t)(row - ML) * D + 4 * lane;
            for (int sidx = 0; sidx < fin_ns; ++sidx) {
                f32x4 t0[8];
#pragma unroll
                for (int j = 0; j < 8; ++j) t0[j] = ld4(sp + (size_t)sidx * MC * D + 256 * j);
#pragma unroll
                for (int j = 0; j < 8; ++j) a[j] += t0[j];
            }
#pragma unroll
            for (int j = 0; j < 8; ++j) { const int col = 4 * lane + 256 * j;
                const f32x4 gt = *(const f32x4*)(fin_gmx + 2 * NADA + col) + *(const f32x4*)(fin_gb + col);
                v[j] += gt * a[j]; st4(fin_xr + (size_t)row * D + col, v[j]); }
        }
#pragma unroll
        for (int j = 0; j < 8; ++j) s += (v[j].x * v[j].x + v[j].y * v[j].y) + (v[j].z * v[j].z + v[j].w * v[j].w);
        const float r = 1.0f / sqrtf(wave_sum(s) * (1.0f / D) + EPS);
        bf16* hrow = H + (size_t)row * D;
#pragma unroll
        for (int j = 0; j < 8; ++j) { const f32x4 o = v[j] * r * gs[j] + sh[j]; u32x2 w; w.x = cvt_pk_bf16(o.x, o.y); w.y = cvt_pk_bf16(o.z, o.w);
            *(u32x2*)(hrow + 4 * lane + 256 * j) = w; }
        if (xr_out && row >= ML) {
#pragma unroll
            for (int j = 0; j < 8; ++j) st4(xr_out + (size_t)row * D + 4 * lane + 256 * j, v[j]);
        }
    }
}

__device__ __forceinline__ void ctxfin_phase(const slab_t* slab, int ns, const float* gmx, const float* gb, xr_t* XR, bf16* H, const float* ng, const float* nmx, const float* nb, float* nssq, int gw, int NGW, int lane) {
    asm volatile("" : "+v"(lane));
    for (int it = gw; it < MC * 4; it += NGW) { const int r = it >> 2, q = it & 3, row = ML + r, c0 = q * 512 + 4 * lane;
        f32x4 a[2], v[2];
#pragma unroll
        for (int j = 0; j < 2; ++j) { a[j] = (f32x4){0.f, 0.f, 0.f, 0.f}; v[j] = ld4(XR + (size_t)row * D + c0 + 256 * j); }
        const slab_t* sp = slab + (size_t)r * D + c0;
        for (int s0 = 0; s0 < ns; s0 += 4) { f32x4 t0[4][2];
#pragma unroll
            for (int k = 0; k < 4; ++k) { const int sidx = s0 + k < ns ? s0 + k : s0;
#pragma unroll
                for (int j = 0; j < 2; ++j) t0[k][j] = ld4(sp + (size_t)sidx * MC * D + 256 * j); }
#pragma unroll
            for (int k = 0; k < 4; ++k) if (s0 + k < ns) { a[0] += t0[k][0]; a[1] += t0[k][1]; } }
        float s = 0.f;
#pragma unroll
        for (int j = 0; j < 2; ++j) { const int col = c0 + 256 * j;
            const f32x4 gt = *(const f32x4*)(gmx + 2 * NADA + col) + *(const f32x4*)(gb + col);
            v[j] += gt * a[j]; st4(XR + (size_t)row * D + col, v[j]);
            s += (v[j].x * v[j].x + v[j].y * v[j].y) + (v[j].z * v[j].z + v[j].w * v[j].w);
            const f32x4 h = v[j] * (*(const f32x4*)(ng + col) * (*(const f32x4*)(nmx + 2 * NADA + col) + *(const f32x4*)(nb + col) + 1.0f));
            u32x2 w; w.x = cvt_pk_bf16(h.x, h.y); w.y = cvt_pk_bf16(h.z, h.w); *(u32x2*)(H + (size_t)row * D + col) = w; }
        s = wave_sum(s); if (lane == 0) atomicAdd(nssq + row, s);
    }
}

__device__ __forceinline__ void qknorm_rope_phase(bf16* QKV, const float* qg, const float* kg, const f32x2* rope, int nrows, int gw, int NGW, int lane, const slab_t* slab = nullptr, int ns = 0, int ctx_it0 = 0, const float* fssq = nullptr, const float* fsw = nullptr, int row0 = 0) {
    asm volatile("" : "+v"(lane));
    const int hl = lane >> 4, dl = (lane & 15) * 8;
    if (row0 < ML) {
        const f32x4 gq0 = *(const f32x4*)(qg + dl), gq1 = *(const f32x4*)(qg + dl + 4), gk0 = *(const f32x4*)(kg + dl), gk1 = *(const f32x4*)(kg + dl + 4);
        u32x4 cur[5], nxt[5]; f32x4 ccs[4], ncs[4];
        int row = row0 + gw;
#define QK_LOAD(dst, dcs, r_) do { const bf16* rp_ = QKV + (size_t)(r_) * NQKV + hl * HD + dl; _Pragma("unroll") for (int it = 0; it < 5; ++it) dst[it] = *(const u32x4*)(rp_ + it * 4 * HD); \
            const f32x4* cp_ = (const f32x4*)(rope + (size_t)((r_) & (SEQ - 1)) * 64 + (dl & 63)); _Pragma("unroll") for (int e = 0; e < 4; ++e) dcs[e] = cp_[e]; } while (0)
        if (row < ML) QK_LOAD(cur, ccs, row);
        while (row < ML) {
            const int nrow = row + NGW; const bool more = nrow < ML;
            if (more) QK_LOAD(nxt, ncs, nrow);
            bf16* rp = QKV + (size_t)row * NQKV + hl * HD + dl;
#pragma unroll
            for (int it = 0; it < 5; ++it) { float v[8];
#pragma unroll
                for (int e = 0; e < 4; ++e) { v[2 * e] = __uint_as_float(cur[it][e] << 16); v[2 * e + 1] = __uint_as_float(cur[it][e] & 0xffff0000u); }
                float s = 0.f;
#pragma unroll
                for (int e = 0; e < 8; ++e) s += v[e] * v[e];
                s += __shfl_xor(s, 1); s += __shfl_xor(s, 2); s += __shfl_xor(s, 4); s += __shfl_xor(s, 8);
                const float r = __builtin_amdgcn_rsqf(s * (1.0f / HD) + EPS);
                const f32x4 g0 = it < 4 ? gq0 : gk0, g1 = it < 4 ? gq1 : gk1;
#pragma unroll
                for (int e = 0; e < 4; ++e) { v[e] *= r * g0[e]; v[4 + e] *= r * g1[e]; }
                float o[8];
#pragma unroll
                for (int e = 0; e < 8; ++e) { const float pr = __shfl_xor(v[e], 8); const float cc = ccs[e >> 1][(e & 1) * 2], ss = ccs[e >> 1][(e & 1) * 2 + 1]; o[e] = v[e] * cc + ((lane & 8) ? pr : -pr) * ss; }
                u32x4 w; w.x = cvt_pk_bf16(o[0], o[1]); w.y = cvt_pk_bf16(o[2], o[3]); w.z = cvt_pk_bf16(o[4], o[5]); w.w = cvt_pk_bf16(o[6], o[7]);
                *(u32x4*)(rp + it * 4 * HD) = w; }
            if (more) {
#pragma unroll
                for (int it = 0; it < 5; ++it) cur[it] = nxt[it];
#pragma unroll
                for (int e = 0; e < 4; ++e) ccs[e] = ncs[e]; }
            row = nrow;
        }
#undef QK_LOAD
    }
    for (int row = (row0 < ML ? ML : row0) + gw; row < nrows; row += NGW) {
        bf16* rp = QKV + (size_t)row * NQKV;
        const bool lat = row < ML; const int t = row & (SEQ - 1);
        const bool fin = (slab != nullptr) && !lat;
        if (fin) {
            const slab_t* sp = slab + (size_t)(row - ML) * NQKV + HQ + HKV + lane * 8; f32x4 t0[8], t1[8];
#pragma unroll
            for (int sidx = 0; sidx < 8; ++sidx) ld8(sp + (size_t)sidx * MC * NQKV, t0[sidx], t1[sidx]);
            f32x4 a0 = t0[0], a1 = t1[0];
#pragma unroll
            for (int sidx = 1; sidx < 8; ++sidx) { a0 += t0[sidx]; a1 += t1[sidx]; }
            if (fssq) { const float rr = __builtin_amdgcn_rsqf(fssq[row] * (1.0f / D) + EPS); const float* swp = fsw + HQ + HKV + lane * 8; a0 = a0 * rr + *(const f32x4*)swp; a1 = a1 * rr + *(const f32x4*)(swp + 4); }
            u32x4 w; w.x = cvt_pk_bf16(a0[0], a0[1]); w.y = cvt_pk_bf16(a0[2], a0[3]); w.z = cvt_pk_bf16(a1[0], a1[1]); w.w = cvt_pk_bf16(a1[2], a1[3]);
            *(u32x4*)(rp + HQ + HKV + lane * 8) = w;
        }
#pragma unroll
        for (int it = 0; it < 5; ++it) {
            if (fin && it < ctx_it0) continue;
            const int head = it * 4 + hl; bf16* p = rp + head * HD + dl;
            float v[8];
            if (fin) { const slab_t* sp = slab + (size_t)(row - ML) * NQKV + head * HD + dl; f32x4 t0[8], t1[8];
#pragma unroll
                for (int sidx = 0; sidx < 8; ++sidx) ld8(sp + (size_t)sidx * MC * NQKV, t0[sidx], t1[sidx]);
                f32x4 a0 = t0[0], a1 = t1[0];
#pragma unroll
                for (int sidx = 1; sidx < 8; ++sidx) { a0 += t0[sidx]; a1 += t1[sidx]; }
                if (fssq) { const float rr = __builtin_amdgcn_rsqf(fssq[row] * (1.0f / D) + EPS); const float* swp = fsw + head * HD + dl; a0 = a0 * rr + *(const f32x4*)swp; a1 = a1 * rr + *(const f32x4*)(swp + 4); }
#pragma unroll
                for (int e = 0; e < 4; ++e) { v[e] = a0[e]; v[4 + e] = a1[e]; }
            } else { const u32x4 raw = *(const u32x4*)p;
#pragma unroll
                for (int e = 0; e < 4; ++e) { v[2 * e] = __uint_as_float(raw[e] << 16); v[2 * e + 1] = __uint_as_float(raw[e] & 0xffff0000u); } }
            float s = 0.f;
#pragma unroll
            for (int e = 0; e < 8; ++e) s += v[e] * v[e];
            s += __shfl_xor(s, 1); s += __shfl_xor(s, 2); s += __shfl_xor(s, 4); s += __shfl_xor(s, 8);
            const float r = 1.0f / sqrtf(s * (1.0f / HD) + EPS);
            const float* gp = (it < 4 ? qg : kg) + dl;
            const f32x4 g0 = *(const f32x4*)gp, g1 = *(const f32x4*)(gp + 4);
#pragma unroll
            for (int e = 0; e < 4; ++e) { v[e] *= r * g0[e]; v[4 + e] *= r * g1[e]; }
            float o[8];
            if (lat) {
                const f32x2* cs = rope + (size_t)t * 64 + (dl & 63);
#pragma unroll
                for (int e = 0; e < 8; ++e) { const float pr = __shfl_xor(v[e], 8); const f32x2 c = cs[e]; o[e] = v[e] * c.x + ((lane & 8) ? pr : -pr) * c.y; }
            } else {
#pragma unroll
                for (int e = 0; e < 8; ++e) o[e] = v[e];
            }
            u32x4 w; w.x = cvt_pk_bf16(o[0], o[1]); w.y = cvt_pk_bf16(o[2], o[3]); w.z = cvt_pk_bf16(o[4], o[5]); w.w = cvt_pk_bf16(o[6], o[7]);
            *(u32x4*)p = w;
        }
    }
}

__device__ __forceinline__ int dst_row_map(int n, int mode) { if (mode == 0) return n; const int j = n & 127; return (n >> 7) * 256 + 128 * ((j >> 2) & 1) + 32 * (j >> 5) + 8 * ((j >> 3) & 3) + (j & 3) + (mode == 2 ? 4 : 0); }
__device__ __forceinline__ void transpose_item(const float* W, int K, int N, bf16* WT, int mode, LAS float* scr, int item, int lane, int kchunk = 0, f32x4* swacc = nullptr, const float* shmx = nullptr, const float* shb = nullptr, int ldk = 0) {
    const bool sw = swacc != nullptr;
    const int nblk = N / 32, nkb = K / 64, kb = sw ? item % nkb : item / nblk, nb = sw ? item / nkb : item % nblk, k0 = 64 * kb, n0 = 32 * nb;
    const int lr = lane >> 3, lc = (lane & 7) * 4;
    f32x4 t[8];
#pragma unroll
    for (int i = 0; i < 8; ++i) t[i] = *(const f32x4*)(W + (size_t)(k0 + 8 * i + lr) * N + n0 + lc);
#pragma unroll
    for (int i = 0; i < 8; ++i) { LAS float* s = scr + (8 * i + lr) * 33 + lc; s[0] = t[i].x; s[1] = t[i].y; s[2] = t[i].z; s[3] = t[i].w; }
    if (sw) { const float bq = shb[k0 + lane]; LAS float* shs = scr + 64 * 33;
        const int tp = (lane & 7) * 8 + (lane >> 3);
        shs[tp] = shmx[k0 + lane] + bq; shs[64 + tp] = shmx[NADA + k0 + lane] + bq; shs[128 + tp] = shmx[2 * NADA + k0 + lane] + bq; }
    LDS_WAIT(); asm volatile("" ::: "memory");
    if (sw) {
        const LAS float* shs = scr + 64 * 33 + lr * 8;
#pragma unroll
        for (int bs = 0; bs < 3; ++bs) { const f32x4 s0 = *(const LAS f32x4*)(shs + 64 * bs), s1 = *(const LAS f32x4*)(shs + 64 * bs + 4);
            swacc[bs] += t[0] * s0[0] + t[1] * s0[1] + t[2] * s0[2] + t[3] * s0[3] + t[4] * s1[0] + t[5] * s1[1] + t[6] * s1[2] + t[7] * s1[3]; }
    }
    const int c = lane & 7;
#pragma unroll
    for (int j = 0; j < 4; ++j) { const int n = (lane >> 3) + 8 * j; const LAS float* s = scr + (8 * c) * 33 + n;
        u32x4 o; o.x = cvt_pk_bf16(s[0 * 33], s[1 * 33]); o.y = cvt_pk_bf16(s[2 * 33], s[3 * 33]); o.z = cvt_pk_bf16(s[4 * 33], s[5 * 33]); o.w = cvt_pk_bf16(s[6 * 33], s[7 * 33]);
        const int dr = dst_row_map(n0 + n, mode);
        bf16* dp = kchunk ? WT + ((size_t)(k0 / kchunk) * N + dr) * kchunk + (k0 % kchunk) + 8 * c : WT + (size_t)dr * (ldk ? ldk : K) + k0 + 8 * c;
        *(u32x4*)dp = o; }
    LDS_WAIT(); asm volatile("" ::: "memory");
}
template <bool SW>
__device__ __forceinline__ void transpose_group(const float* W, int K, int N, bf16* WT, int mode, LAS float* scr, int item0, int lane, f32x4* swacc, const float* shmx, const float* shb, int ldk) {
    asm volatile("" : "+v"(lane));
    const int nblk = N / 32, nkb = K / 64, kb0 = SW ? item0 % nkb : item0 / nblk, nb0 = SW ? item0 / nkb : item0 % nblk;
    const int lr = lane >> 3, lc = (lane & 7) * 4, c = lane & 7;
    const float* src = W + (size_t)(64 * kb0 + lr) * N + 32 * nb0 + lc;
    const size_t istep = SW ? (size_t)64 * N : (size_t)32;
#define TRG_LOAD(T, i) do { const float* p_ = src + (size_t)(i) * istep; _Pragma("unroll") for (int e = 0; e < 8; ++e) T[e] = __builtin_nontemporal_load((const f32x4*)(p_ + (size_t)(8 * e) * N)); } while (0)
#define TRG_FIN(T, i) do { const int k0 = 64 * (kb0 + (SW ? (i) : 0)), n0 = 32 * (nb0 + (SW ? 0 : (i))); \
        _Pragma("unroll") for (int e = 0; e < 8; ++e) { LAS float* s_ = scr + (8 * e + lr) * 33 + lc; s_[0] = T[e].x; s_[1] = T[e].y; s_[2] = T[e].z; s_[3] = T[e].w; } \
        LDS_WAIT(); asm volatile("" ::: "memory"); \
        if (SW) { const LAS float* shs_ = scr + 64 * 33 + (i) * 192 + lr * 8; \
            _Pragma("unroll") for (int bs = 0; bs < 3; ++bs) { const f32x4 s0 = *(const LAS f32x4*)(shs_ + 64 * bs), s1 = *(const LAS f32x4*)(shs_ + 64 * bs + 4); \
                swacc[bs] += T[0] * s0[0] + T[1] * s0[1] + T[2] * s0[2] + T[3] * s0[3] + T[4] * s1[0] + T[5] * s1[1] + T[6] * s1[2] + T[7] * s1[3]; } } \
        _Pragma("unroll") for (int j = 0; j < 4; ++j) { const int n = (lane >> 3) + 8 * j; const LAS float* s_ = scr + (8 * c) * 33 + n; \
            u32x4 o; o.x = cvt_pk_bf16(s_[0 * 33], s_[1 * 33]); o.y = cvt_pk_bf16(s_[2 * 33], s_[3 * 33]); o.z = cvt_pk_bf16(s_[4 * 33], s_[5 * 33]); o.w = cvt_pk_bf16(s_[6 * 33], s_[7 * 33]); \
            __builtin_nontemporal_store(o, (u32x4*)(WT + (size_t)dst_row_map(n0 + n, mode) * ldk + k0 + 8 * c)); } \
        LDS_WAIT(); asm volatile("" ::: "memory"); } while (0)
    f32x4 ta[8], tb[8];
    if (SW) {
        float bq[8], h0[8], h1[8], h2[8];
#pragma unroll
        for (int i = 0; i < 8; ++i) { const int k = 64 * (kb0 + i) + lane; bq[i] = shb[k]; h0[i] = shmx[k]; h1[i] = shmx[NADA + k]; h2[i] = shmx[2 * NADA + k]; }
        TRG_LOAD(ta, 0); asm volatile("" ::: "memory");
        const int tp = (lane & 7) * 8 + (lane >> 3); LAS float* shs = scr + 64 * 33;
#pragma unroll
        for (int i = 0; i < 8; ++i) { shs[i * 192 + tp] = h0[i] + bq[i]; shs[i * 192 + 64 + tp] = h1[i] + bq[i]; shs[i * 192 + 128 + tp] = h2[i] + bq[i]; }
    } else { TRG_LOAD(ta, 0); }
#pragma unroll 1
    for (int i = 0; i < 8; i += 2) {
        TRG_LOAD(tb, i + 1);
        TRG_FIN(ta, i);
        if (i + 2 < 8) TRG_LOAD(ta, i + 2);
        TRG_FIN(tb, i + 1);
    }
#undef TRG_LOAD
#undef TRG_FIN
}
__device__ __forceinline__ void sw_flush(f32x4* swacc, float* sw, int swN, int n0, int mode, int lane) {
    const int lr = lane >> 3, lc = (lane & 7) * 4;
#pragma unroll
    for (int bs = 0; bs < 3; ++bs) { float pick = 0.f;
#pragma unroll
        for (int e = 0; e < 4; ++e) { float v = swacc[bs][e]; v += __shfl_xor(v, 8); v += __shfl_xor(v, 16); v += __shfl_xor(v, 32); if (lr == e) pick = v; }
        if (lr < 4) atomicAdd(sw + (size_t)bs * swN + dst_row_map(n0 + lc + lr, mode), pick);
        swacc[bs] = (f32x4){0.f, 0.f, 0.f, 0.f}; }
}
struct KArgs { const float* in[21]; float* out; unsigned char* ws; int ph_lo, ph_hi; };
enum { I_X = 0, I_C, I_CTX, I_CCTX, I_WADA, I_BADA, I_NORMG, I_WG, I_WU, I_WD, I_WQKV, I_WO, I_QG, I_KG, I_SINK, I_WF, I_WSI, I_SVG, I_WSS, I_BSS, I_WSOUT };
constexpr int CW_QUEUE = 64;
constexpr int TR_FFN = 5632;
constexpr float F_SCALE_LAT = 0.00069053396600248786f;
constexpr float F_SCALE_CTX = 0.00390625f;
constexpr int ITA_TR = 4 * TR_FFN + 3072 + 4096 + 2048 + 6144, IT_F = 384, IT_DC = 256, IT_FC = 256, IT_ROPE = 1024, ITA_TOTAL = ITA_TR + IT_F + IT_DC + IT_FC + IT_ROPE;
constexpr int ITB_TOTAL = 8 * TR_FFN + 12288 + 3072;

__device__ __forceinline__ void prologue_group_b(const KArgs& a, int r0, LAS float* scr, int lane) {
    unsigned char* ws = a.ws; const float* MX = (const float*)(ws + WS_MX); const float* BA = a.in[I_BADA];
    const float* W; bf16* WT; int N, mode; float* sw; int swN; const float* shmx; const float* shb; int r = r0;
    if (r < 8 * TR_FFN) { const int kind = r / (4 * TR_FFN), l = (r / TR_FFN) & 3; r = r % TR_FFN;
        W = a.in[kind ? I_WU : I_WG] + (size_t)l * D * DFF; WT = (bf16*)(ws + WS_WGU + (size_t)l * 44 * MiB); N = DFF; mode = kind ? 2 : 1;
        sw = (float*)(ws + WS_Z2 + Z2_SWGU) + (size_t)l * 3 * 2 * DFF; swN = 2 * DFF; shmx = MX + (size_t)l * 3 * NADA + 3 * D; shb = BA + (size_t)l * NADA + 3 * D; }
    else { r -= 8 * TR_FFN;
        if (r < 12288) { W = a.in[I_WSI]; WT = (bf16*)(ws + WS_WSI); N = 2 * SGH; mode = 0; sw = (float*)(ws + WS_Z2 + Z2_SWSI); swN = 2 * SGH; shmx = MX + (size_t)2 * 3 * NADA; shb = BA + (size_t)2 * NADA; }
        else { r -= 12288; W = a.in[I_WQKV] + (size_t)D * NQKV; WT = (bf16*)(ws + WS_WQKV + (size_t)12 * MiB); N = NQKV; mode = 0; sw = (float*)(ws + WS_Z2 + Z2_SWQ3); swN = NQKV; shmx = MX + (size_t)3 * 3 * NADA; shb = BA + (size_t)3 * NADA; } }
    f32x4 swacc[3] = {{0.f, 0.f, 0.f, 0.f}, {0.f, 0.f, 0.f, 0.f}, {0.f, 0.f, 0.f, 0.f}};
    const int gidx = r >> 3, nblk = N / 32, nb = gidx % nblk, kb8 = gidx / nblk;
    transpose_group<true>(W, D, N, WT, mode, scr, nb * 32 + kb8 * 8, lane, swacc, shmx, shb, D);
    sw_flush(swacc, sw, swN, 32 * nb, mode, lane);
}
__device__ __forceinline__ void prologue_group_a(const KArgs& a, int r, LAS float* scr, int lane) {
    unsigned char* ws = a.ws; const float* W; bf16* WT; int K, N, ldk;
    if (r < 4 * TR_FFN) { const int l = r / TR_FFN; r = r % TR_FFN; W = a.in[I_WD] + (size_t)l * DFF * D; K = DFF; N = D; WT = (bf16*)(ws + WS_WDN + (size_t)l * WDN_SLOT); ldk = LDG_PAD; }
    else { r -= 4 * TR_FFN;
        if (r < 3072) { W = a.in[I_WQKV]; K = D; N = NQKV; WT = (bf16*)(ws + WS_WQKV); ldk = D; }
        else { r -= 3072;
            if (r < 4096) { const int j = r / 2048; r = r % 2048; W = a.in[I_WO] + (size_t)j * HQ * D; K = HQ; N = D; WT = (bf16*)(ws + WS_WO + (size_t)j * 8 * MiB); ldk = HQ; }
            else { r -= 4096;
                if (r < 2048) { W = a.in[I_WF]; K = D; N = D; WT = (bf16*)(ws + WS_WF); ldk = D; }
                else { r -= 2048; W = a.in[I_WSOUT]; K = SGH; N = D; WT = (bf16*)(ws + WS_WSO); ldk = SGH; } } } }
    f32x4 dummy[3];
    transpose_group<false>(W, K, N, WT, 0, scr, r, lane, dummy, nullptr, nullptr, ldk);
}
__device__ __forceinline__ void prologue_item(const KArgs& a, int r, LAS float* scr, int lane) {
    unsigned char* ws = a.ws;
    r -= ITA_TR;
    if (r < IT_F) {
        float v[8];
        if (r < 128) {
            const int e0 = r * 512 + lane * 8, i = e0 >> 8, kk0 = e0 & 255, rp = i >> 7, cp = (i >> 6) & 1, k1 = i & 63;
#pragma unroll
            for (int e = 0; e < 8; ++e) { const int kk = kk0 + e, cpi = kk >> 7, re = (kk >> 6) & 1, t1 = kk & 63; const float fr = (float)((k1 * t1) & 63) * (1.0f / 64.0f);
                float c = (rp == re) ? __builtin_amdgcn_cosf(fr) : -__builtin_amdgcn_sinf(fr); if (rp == 1 && re == 1) c = -c; v[e] = (cp == cpi) ? c : 0.f; }
            u32x4 w; w.x = cvt_pk_bf16(v[0], v[1]); w.y = cvt_pk_bf16(v[2], v[3]); w.z = cvt_pk_bf16(v[4], v[5]); w.w = cvt_pk_bf16(v[6], v[7]);
            *(u32x4*)((bf16*)(ws + WS_DA) + e0) = w;
        } else {
            const int e0 = (r - 128) * 512 + lane * 8, i = e0 >> 9, kk0 = e0 & 511, cp = i >> 7, k2 = i & 127;
#pragma unroll
            for (int e = 0; e < 8; ++e) { const int kk = kk0 + e, cpi = kk >> 8, re = (kk >> 7) & 1, t2 = kk & 127; const float fr = (float)((k2 * t2) & 127) * (1.0f / 128.0f);
                const float c = re ? __builtin_amdgcn_sinf(fr) : __builtin_amdgcn_cosf(fr); v[e] = (cp == cpi) ? F_SCALE_LAT * c : 0.f; }
            u32x4 w; w.x = cvt_pk_bf16(v[0], v[1]); w.y = cvt_pk_bf16(v[2], v[3]); w.z = cvt_pk_bf16(v[4], v[5]); w.w = cvt_pk_bf16(v[6], v[7]);
            *(u32x4*)((bf16*)(ws + WS_DB) + e0) = w;
        }
        return; }
    r -= IT_F;
    if (r < IT_DC) {
        const int e0 = r * 512 + lane * 8, row = e0 >> 8, c0 = e0 & 255, m = row & 255, reim = row >> 8; float v[8];
#pragma unroll
        for (int e = 0; e < 8; ++e) { const float fr = (float)((m * (c0 + e)) & 255) * (1.0f / 256.0f); v[e] = reim ? __builtin_amdgcn_sinf(fr) : __builtin_amdgcn_cosf(fr); }
        u32x4 w; w.x = cvt_pk_bf16(v[0], v[1]); w.y = cvt_pk_bf16(v[2], v[3]); w.z = cvt_pk_bf16(v[4], v[5]); w.w = cvt_pk_bf16(v[6], v[7]);
        *(u32x4*)((bf16*)(ws + WS_DC2) + e0) = w; return; }
    r -= IT_DC;
    if (r < IT_FC) {
        const int e0 = r * 512 + lane * 8, k = e0 >> 9, c0 = e0 & 511, reim = c0 >> 8, l0 = c0 & 255; float v[8];
#pragma unroll
        for (int e = 0; e < 8; ++e) { const int idx = ((k * (l0 + e)) + reim * 64) & 255; v[e] = F_SCALE_CTX * __builtin_amdgcn_cosf((float)idx * (1.0f / 256.0f)); }
        u32x4 w; w.x = cvt_pk_bf16(v[0], v[1]); w.y = cvt_pk_bf16(v[2], v[3]); w.z = cvt_pk_bf16(v[4], v[5]); w.w = cvt_pk_bf16(v[6], v[7]);
        *(u32x4*)((bf16*)(ws + WS_FC) + e0) = w; return; }
    r -= IT_FC;
    {
        f32x2* dst = (f32x2*)(ws + WS_ROPE) + (size_t)r * 512 + lane * 8;
#pragma unroll
        for (int e = 0; e < 8; ++e) { const int idx = r * 512 + lane * 8 + e, t = idx >> 6, f = idx & 63;
            const float inv = __builtin_amdgcn_exp2f(-(float)(f & 31) * (13.287712379549449f / 32.0f));
            const float ang = (float)(f < 32 ? (t >> 6) : (t & 63)) * inv, rev = ang * 0.15915494309189535f;
            dst[e] = (f32x2){__builtin_amdgcn_cosf(rev), __builtin_amdgcn_sinf(rev)}; }
    }
}

template <int PART> __device__ __forceinline__ void prologue_phase(const KArgs& a, LAS unsigned char* lds, gu32* ctl, int tid, int lane, int wave) {
    asm volatile("" : "+v"(tid), "+v"(lane));
    if (PART == 0) {
        LAS float* sl = (LAS float*)lds;
        LAS float* part = (LAS float*)(lds + 24576);
        for (int i = tid; i < 3 * D; i += 512) { const int r = i / D, k = i % D; const float cv = r < 2 ? a.in[I_C][r * D + k] : a.in[I_CCTX][k]; sl[i] = silu_f(cv); }
        __syncthreads();
        const int sub = lane >> 4, lc = (lane & 15) * 4;
        for (int item = blockIdx.x; item < 4 * 192; item += gridDim.x) {
            const int l = item / 192, jb = item % 192;
            const float* wp = a.in[I_WADA] + ((size_t)l * D + wave * 256 + sub) * NADA + jb * 64 + lc;
            f32x4 a0 = {0.f, 0.f, 0.f, 0.f}, a1 = a0, a2 = a0;
            for (int k = 0; k < 256; k += 32) { f32x4 w[8];
#pragma unroll
                for (int e = 0; e < 8; ++e) w[e] = *(const f32x4*)(wp + (size_t)(k + 4 * e) * NADA);
#pragma unroll
                for (int e = 0; e < 8; ++e) { const int kk = wave * 256 + k + 4 * e + sub; a0 += w[e] * sl[kk]; a1 += w[e] * sl[D + kk]; a2 += w[e] * sl[2 * D + kk]; } }
#pragma unroll
            for (int e = 0; e < 4; ++e) { a0[e] += __shfl_xor(a0[e], 16); a0[e] += __shfl_xor(a0[e], 32); a1[e] += __shfl_xor(a1[e], 16); a1[e] += __shfl_xor(a1[e], 32); a2[e] += __shfl_xor(a2[e], 16); a2[e] += __shfl_xor(a2[e], 32); }
            if (sub == 0) { *(LAS f32x4*)(part + (wave * 3 + 0) * 64 + lc) = a0; *(LAS f32x4*)(part + (wave * 3 + 1) * 64 + lc) = a1; *(LAS f32x4*)(part + (wave * 3 + 2) * 64 + lc) = a2; }
            __syncthreads();
            if (tid < 192) { const int r = tid >> 6, j = tid & 63; float s = 0.f;
#pragma unroll
                for (int w = 0; w < 8; ++w) s += part[(w * 3 + r) * 64 + j];
                ((float*)(a.ws + WS_MX))[((size_t)l * 3 + r) * NADA + jb * 64 + j] = s; }
            __syncthreads();
        }
        return;
    }
    LAS float* scr = (LAS float*)(lds + wave * 16384);
    for (;;) {
        unsigned base = 0; if (lane == 0) base = __hip_atomic_fetch_add((unsigned*)(ctl + CW_QUEUE + 64), 8u, RLX_AGENT);
        base = (unsigned)__builtin_amdgcn_readfirstlane((int)base);
        if (base >= (unsigned)ITB_TOTAL) break;
        prologue_group_b(a, (int)base, scr, lane);
    }
    for (;;) {
        unsigned base = 0; if (lane == 0) base = __hip_atomic_fetch_add((unsigned*)(ctl + CW_QUEUE), 8u, RLX_AGENT);
        base = (unsigned)__builtin_amdgcn_readfirstlane((int)base);
        if (base >= (unsigned)ITA_TOTAL) break;
        if (base < (unsigned)ITA_TR) prologue_group_a(a, (int)base, scr, lane);
        else for (int i = 0; i < 8; ++i) { const int it = (int)base + i; if (it < ITA_TOTAL) prologue_item(a, it, scr, lane); }
    }
}
namespace attn {
constexpr float SCALE = 0.08838834764831845f;
constexpr float THR = 8.f;
constexpr int SHM_K = 64 * 128 * 2, SHM_V = 64 * 128 * 2;
constexpr int OFF_V = 0, OFF_K = 2 * SHM_V, OFF_WS = 2 * SHM_V + 2 * SHM_K, LDS_BYTES = OFF_WS + 8 * 64 * 4;
#define KSWZ(row, colB) ((row) * 256 + ((colB) ^ (((row) & 7) << 4)))
#define SBAR() __builtin_amdgcn_sched_barrier(0)
__device__ __forceinline__ int v_st(int k, int c) { const int kk = (k & ~0xC) | ((k & 4) << 1) | ((k & 8) >> 1); return ((kk >> 3) * 4 + (c >> 5)) * 512 + ((kk & 7) * 32 + (c & 31)) * 2; }
__device__ __forceinline__ int v_rd_base(int lane) { return ((lane & 3) << 3) | (((lane >> 2) & 3) << 6) | (((lane >> 4) & 1) << 5) | (((lane >> 5) & 1) << 8); }
__device__ __forceinline__ int crow(int r, int hi) { return (r & 3) + 8 * (r >> 2) + 4 * hi; }
__device__ __forceinline__ void mask_tile(f32x16& p0, f32x16& p1, int dq, unsigned W) {
    const float NEG = -__builtin_inff();
#pragma unroll
    for (int r = 0; r < 16; ++r) { const int c = (r & 3) + 8 * (r >> 2);
        if ((unsigned)(dq - c) >= W) p0[r] = NEG;
        if ((unsigned)(dq - c - 32) >= W) p1[r] = NEG; }
}
__device__ __forceinline__ void partialSM(f32x16& p0, f32x16& p1, float& m_reg, float& mn, float& alpha) {
    float pmax = p0[0];
#pragma unroll
    for (int r = 1; r < 16; ++r) pmax = fmaxf(pmax, p0[r]);
#pragma unroll
    for (int r = 0; r < 16; ++r) pmax = fmaxf(pmax, p1[r]);
    { auto rr = __builtin_amdgcn_permlane32_swap(__float_as_uint(pmax), __float_as_uint(pmax), false, false);
      pmax = fmaxf(__uint_as_float(rr[0]), __uint_as_float(rr[1])); }
    constexpr float C2 = 1.4426950408889634f * SCALE;
    if (__builtin_expect(__all((pmax - m_reg) * SCALE <= THR), 1)) { mn = m_reg; alpha = 1.f; }
    else { mn = fmaxf(m_reg, pmax); alpha = __builtin_amdgcn_exp2f((m_reg - mn) * C2); m_reg = mn; }
    const float mnL = -mn * C2;
#pragma unroll
    for (int r = 0; r < 16; ++r) p0[r] = fmaf(p0[r], C2, mnL);
#pragma unroll
    for (int r = 0; r < 16; ++r) p1[r] = fmaf(p1[r], C2, mnL);
#pragma unroll
    for (int r = 0; r < 16; ++r) p0[r] = __builtin_amdgcn_exp2f(p0[r]);
}
__device__ __forceinline__ void finishSM(f32x16& p0, f32x16& p1, float alpha, float& l_reg, bf16x8& pa0, bf16x8& pa1, bf16x8& pa2, bf16x8& pa3) {
#pragma unroll
    for (int r = 0; r < 16; ++r) p1[r] = __builtin_amdgcn_exp2f(p1[r]);
    float ps = 0;
#pragma unroll
    for (int r = 0; r < 16; ++r) ps += p0[r];
#pragma unroll
    for (int r = 0; r < 16; ++r) ps += p1[r];
    { auto rr = __builtin_amdgcn_permlane32_swap(__float_as_uint(ps), __float_as_uint(ps), false, false);
      ps = __uint_as_float(rr[0]) + __uint_as_float(rr[1]); }
    l_reg = l_reg * alpha + ps;
#define PK4(P, B_, OUT) do { unsigned a0 = cvt_pk_bf16(P[B_+0], P[B_+1]), a1 = cvt_pk_bf16(P[B_+2], P[B_+3]);                          \
        unsigned b0 = cvt_pk_bf16(P[B_+4], P[B_+5]), b1 = cvt_pk_bf16(P[B_+6], P[B_+7]);                                             \
        auto r0 = __builtin_amdgcn_permlane32_swap(a0, b0, false, false); auto r1 = __builtin_amdgcn_permlane32_swap(a1, b1, false, false); \
        u32x4 w = {r0[0], r1[0], r0[1], r1[1]}; OUT = *reinterpret_cast<bf16x8*>(&w); } while (0)
    PK4(p0, 0, pa0); PK4(p0, 8, pa1); PK4(p1, 0, pa2); PK4(p1, 8, pa3);
#undef PK4
}
template <int KB>
__device__ __forceinline__ void qkt(f32x16& p0, f32x16& p1, const char* K_lds, int r32, int hi, const bf16x8* qr) {
    p0 = f32x16{}; p1 = f32x16{};
    const char* kb[4];
#pragma unroll
    for (int dd = 0; dd < 4; ++dd) kb[dd] = K_lds + KB * SHM_K + KSWZ(r32, (dd * 16 + hi * 8) * 2);
#pragma unroll
    for (int d0 = 0; d0 < 8; ++d0) { const char* a = kb[d0 & 3] + (d0 >> 2) * 128;
        bf16x8 b0 = *reinterpret_cast<const bf16x8*>(a);
        bf16x8 b1 = *reinterpret_cast<const bf16x8*>(a + 32 * 256);
        p0 = __builtin_amdgcn_mfma_f32_32x32x16_bf16(b0, qr[d0], p0, 0, 0, 0);
        p1 = __builtin_amdgcn_mfma_f32_32x32x16_bf16(b1, qr[d0], p1, 0, 0, 0); }
}
#define TRRD(dst, off) asm volatile("ds_read_b64_tr_b16 %0, %1 offset:%2" : "=&v"(dst) : "v"(vb0), "i"(off) : "memory")
#define PV_D0(oacc, vbuf, d0, pa0, pa1, pa2, pa3) do { s16x4 l0, l1, l2, l3, h0, h1, h2, h3; constexpr int b_ = (vbuf) + (d0) * 512; \
        TRRD(l0, b_); TRRD(h0, b_ + 2048); TRRD(l1, b_ + 4096); TRRD(h1, b_ + 6144); TRRD(l2, b_ + 8192); TRRD(h2, b_ + 10240); TRRD(l3, b_ + 12288); TRRD(h3, b_ + 14336); \
        asm volatile("s_waitcnt lgkmcnt(0)" ::: "memory"); SBAR(); \
        oacc = __builtin_amdgcn_mfma_f32_32x32x16_bf16(pa0, (bf16x8){l0[0], l0[1], l0[2], l0[3], h0[0], h0[1], h0[2], h0[3]}, oacc, 0, 0, 0);   \
        oacc = __builtin_amdgcn_mfma_f32_32x32x16_bf16(pa1, (bf16x8){l1[0], l1[1], l1[2], l1[3], h1[0], h1[1], h1[2], h1[3]}, oacc, 0, 0, 0);   \
        oacc = __builtin_amdgcn_mfma_f32_32x32x16_bf16(pa2, (bf16x8){l2[0], l2[1], l2[2], l2[3], h2[0], h2[1], h2[2], h2[3]}, oacc, 0, 0, 0);   \
        oacc = __builtin_amdgcn_mfma_f32_32x32x16_bf16(pa3, (bf16x8){l3[0], l3[1], l3[2], l3[3], h3[0], h3[1], h3[2], h3[3]}, oacc, 0, 0, 0); } while (0)
template <int VB>
__device__ __forceinline__ void pv_tile(f32x16* o, int vb0, bf16x8 pa0, bf16x8 pa1, bf16x8 pa2, bf16x8 pa3) {
    PV_D0(o[0], VB * SHM_V, 0, pa0, pa1, pa2, pa3); PV_D0(o[1], VB * SHM_V, 1, pa0, pa1, pa2, pa3);
    PV_D0(o[2], VB * SHM_V, 2, pa0, pa1, pa2, pa3); PV_D0(o[3], VB * SHM_V, 3, pa0, pa1, pa2, pa3);
}

struct AUnit { int qrow0, klat0, kctx0, kh, tb; };

__device__ __forceinline__ void attn_unit(const bf16* QKV, bf16* AO, const float* sink, const AUnit u, char* lds) {
    int tid = threadIdx.x; asm volatile("" : "+v"(tid));
    const int wid = __builtin_amdgcn_readfirstlane(tid >> 6), lane = tid & 63, r32 = lane & 31, hi = lane >> 5;
    const int hq = u.kh * 4 + (wid >> 1), half = wid & 1;
    char* V_lds = lds + OFF_V; char* K_lds = lds + OFF_K;
    float* wsc = (float*)(lds + OFF_WS) + wid * 64; float* li_l = wsc; float* al_l = wsc + 32;
    const int sr = tid >> 4, sc = (tid & 15) * 8, vst0 = v_st(sr, sc), vst1 = v_st(32 + sr, sc), kws = KSWZ(sr, sc * 2);
    const int vb0 = (int)(uintptr_t)V_lds + v_rd_base(lane);
    int jlo = 0, nwin = 0;
    if (u.tb >= 0) { jlo = u.tb - 2 < 0 ? 0 : u.tb - 2; const int jhi = u.tb + 2 > SEQ / 64 - 1 ? SEQ / 64 - 1 : u.tb + 2; nwin = jhi - jlo + 1; }
    const int NT = 4 + nwin;
    const bf16* kvbase = QKV + HQ + u.kh * HD + sc;
    bf16x8 st_k0, st_k1, st_v0, st_v1;
#define A_KROW(t) ((t) < 4 ? u.kctx0 + 64 * (t) : u.klat0 + 64 * (jlo + (t) - 4))
#define A_LOADK(t) do { const bf16* p_ = kvbase + (size_t)(A_KROW(t) + sr) * NQKV; st_k0 = *(const bf16x8*)p_; st_k1 = *(const bf16x8*)(p_ + (size_t)32 * NQKV); } while (0)
#define A_LOADV(t) do { const bf16* p_ = kvbase + (size_t)(A_KROW(t) + sr) * NQKV + HKV; st_v0 = *(const bf16x8*)p_; st_v1 = *(const bf16x8*)(p_ + (size_t)32 * NQKV); } while (0)
#define A_WRITEK(bf) do { *(bf16x8*)(K_lds + (bf) * SHM_K + kws) = st_k0; *(bf16x8*)(K_lds + (bf) * SHM_K + kws + 32 * 256) = st_k1; } while (0)
#define A_WRITEV(bf) do { *(bf16x8*)(V_lds + (bf) * SHM_V + vst0) = st_v0; *(bf16x8*)(V_lds + (bf) * SHM_V + vst1) = st_v1; } while (0)
    A_LOADK(0); A_LOADV(0);
    bf16x8 qr[8];
    { const bf16* qp = QKV + (size_t)(u.qrow0 + 32 * half + r32) * NQKV + hq * HD + hi * 8;
#pragma unroll
      for (int d0 = 0; d0 < 8; ++d0) qr[d0] = *(const bf16x8*)(qp + d0 * 16); }
    float m_reg = sink[hq] * (1.0f / SCALE), l_reg = 1.0f; f32x16 o[4] = {};
    const int qpos128 = 64 * u.tb + 32 * half + r32 + 128 - 4 * hi;
    VM_WAIT(); A_WRITEK(0); A_WRITEV(0);
    A_LOADK(1); VM_WAIT(); A_WRITEK(1);
    __syncthreads();
    f32x16 pA0, pA1, pB0, pB1;
    qkt<0>(pA0, pA1, K_lds, r32, hi, qr);
    __syncthreads();
#define A_RESC(a) do { if (__any((a) < 1.f)) { if (hi == 0) al_l[r32] = (a); asm volatile("s_waitcnt lgkmcnt(0)" ::: "memory");              \
                     _Pragma("unroll") for (int d_ = 0; d_ < 4; ++d_) _Pragma("unroll") for (int r = 0; r < 16; ++r) o[d_][r] *= al_l[crow(r, hi)]; } } while (0)
#define A_STEP(PX0, PX1, PY0, PY1, t, KBN, VB) do { float mn, alpha; bf16x8 pa0, pa1, pa2, pa3; \
        if ((t) + 2 < NT) A_LOADK((t) + 2); if ((t) + 1 < NT) A_LOADV((t) + 1); \
        if ((t) + 1 < NT) qkt<KBN>(PY0, PY1, K_lds, r32, hi, qr); \
        if ((t) >= 4) { const int blk = jlo + (t) - 4; if (blk == u.tb - 2 || blk == u.tb + 2) mask_tile(PX0, PX1, qpos128 - 64 * blk, 257u); } \
        partialSM(PX0, PX1, m_reg, mn, alpha); A_RESC(alpha); finishSM(PX0, PX1, alpha, l_reg, pa0, pa1, pa2, pa3); SBAR(); \
        pv_tile<VB>(o, vb0, pa0, pa1, pa2, pa3); \
        VM_WAIT(); if ((t) + 2 < NT) A_WRITEK(VB); if ((t) + 1 < NT) A_WRITEV(KBN); \
        __syncthreads(); } while (0)
    for (int t = 0; t < NT; t += 2) {
        A_STEP(pA0, pA1, pB0, pB1, t, 1, 0);
        if (t + 1 >= NT) break;
        A_STEP(pB0, pB1, pA0, pA1, t + 1, 0, 1);
    }
    if (hi == 0) li_l[r32] = l_reg; asm volatile("s_waitcnt lgkmcnt(0)" ::: "memory");
    bf16* Ow = AO + (size_t)(u.qrow0 + 32 * half) * D + hq * HD;
    char* stg = lds + wid * 8192;
#pragma unroll
    for (int r = 0; r < 16; ++r) { const int orow = crow(r, hi); const float rl = __builtin_amdgcn_rcpf(li_l[orow]);
#pragma unroll
        for (int d0 = 0; d0 < 4; ++d0) { const float v = o[d0][r] * rl; const float vn = __shfl_xor(v, 1);
            if ((r32 & 1) == 0) *(unsigned*)(stg + orow * 256 + (d0 * 32 + r32) * 2) = cvt_pk_bf16(v, vn); } }
    asm volatile("s_waitcnt lgkmcnt(0)" ::: "memory");
#pragma unroll
    for (int i = 0; i < 8; ++i) { const int row = i * 4 + (lane >> 4), ch = lane & 15; const u32x4 v = *(const u32x4*)(stg + row * 256 + ch * 16); *(u32x4*)(Ow + (size_t)row * D + ch * 8) = v; }
    asm volatile("s_waitcnt lgkmcnt(0)" ::: "memory");
    __syncthreads();
#undef A_KROW
#undef A_LOADK
#undef A_LOADV
#undef A_WRITEK
#undef A_WRITEV
#undef A_RESC
#undef A_STEP
}

__device__ __forceinline__ void attn_phase(const bf16* QKV, bf16* AO, const float* sink, bool with_ctx, int vcu, int G, char* lds) {
    for (int uid = vcu * 4; uid < 1024; uid += G * 4) {
        for (int i = 0; i < 4; ++i) { const int id = uid + i, bk = id >> 7, b = bk >> 2; AUnit u; u.kh = bk & 3; u.tb = id & 127;
            u.qrow0 = b * SEQ + 64 * u.tb; u.klat0 = b * SEQ; u.kctx0 = ML + b * CTXL; attn_unit(QKV, AO, sink, u, lds); }
    }
    if (with_ctx) for (int id = vcu; id < 32; id += G) { AUnit u; const int b = id >> 4; u.kh = (id >> 2) & 3; u.tb = -1; u.qrow0 = ML + b * CTXL + 64 * (id & 3); u.klat0 = 0; u.kctx0 = ML + b * CTXL;
        attn_unit(QKV, AO, sink, u, lds); }
}

constexpr int SG_T = 2 * SHM_V, SG_TP = 132;
__device__ __forceinline__ void sgu_unit(bf16* Z, const float* ssq, const float* wsp, const float* bsp, const float* gvv, int chunk, int g, int db0, char* lds, long store_off = 0) {
    int tid = threadIdx.x; asm volatile("" : "+v"(tid));
    const int wid = __builtin_amdgcn_readfirstlane(tid >> 6), lane = tid & 63, r32 = lane & 31, hi = lane >> 5;
    const int pb = wid & 3, dh = wid >> 2, R0 = chunk * 128;
    char* V_lds = lds; float* T = (float*)(lds + SG_T);
    const int sr = tid >> 4, sc = (tid & 15) * 8, vst0 = v_st(sr, sc), vst1 = v_st(32 + sr, sc);
    const int vb0 = (int)(uintptr_t)V_lds + v_rd_base(lane);
    bf16x8 pa[8];
    { const float* wrow = wsp + ((size_t)(g * 128 + pb * 32 + r32)) * 128 + 8 * hi; const float* sq = ssq + R0 + 8 * hi;
#pragma unroll
      for (int ks = 0; ks < 8; ++ks) { const f32x4 w0 = *(const f32x4*)(wrow + ks * 16), w1 = *(const f32x4*)(wrow + ks * 16 + 4); const f32x4 s0 = *(const f32x4*)(sq + ks * 16), s1 = *(const f32x4*)(sq + ks * 16 + 4);
          float v[8];
#pragma unroll
          for (int e = 0; e < 4; ++e) { v[e] = w0[e] * __builtin_amdgcn_rsqf(s0[e] * (1.0f / SGH) + EPS); v[4 + e] = w1[e] * __builtin_amdgcn_rsqf(s1[e] * (1.0f / SGH) + EPS); }
          u32x4 w; w.x = cvt_pk_bf16(v[0], v[1]); w.y = cvt_pk_bf16(v[2], v[3]); w.z = cvt_pk_bf16(v[4], v[5]); w.w = cvt_pk_bf16(v[6], v[7]); pa[ks] = *reinterpret_cast<bf16x8*>(&w); } }
    float bias[16];
#pragma unroll
    for (int r = 0; r < 16; ++r) bias[r] = bsp[g * 128 + pb * 32 + crow(r, hi)];
#if KCHUNK
#define ZADDR(row, col) (((size_t)((col) >> 9) * MT + (row)) * 512 + ((col) & 511))
#define ZLD 512
#else
#define ZADDR(row, col) ((size_t)(row) * (2 * SGH) + (col))
#define ZLD (2 * SGH)
#endif
    bf16x8 s00, s01, s10, s11;
#define S_LOAD(db) do { const bf16* p_ = Z + ZADDR(R0 + sr, SGH + g * SGG + (db) * 128 + sc); s00 = *(const bf16x8*)p_; s01 = *(const bf16x8*)(p_ + (size_t)32 * ZLD); \
                        s10 = *(const bf16x8*)(p_ + (size_t)64 * ZLD); s11 = *(const bf16x8*)(p_ + (size_t)96 * ZLD); } while (0)
#define S_WRITE() do { *(bf16x8*)(V_lds + vst0) = s00; *(bf16x8*)(V_lds + vst1) = s01; *(bf16x8*)(V_lds + SHM_V + vst0) = s10; *(bf16x8*)(V_lds + SHM_V + vst1) = s11; } while (0)
    S_LOAD(db0);
    for (int db = db0; db < db0 + 2; ++db) {
        VM_WAIT(); S_WRITE();
        __syncthreads();
        u32x4 ur[4]; bf16* usrc = Z + ZADDR(R0 + sr, g * SGG + db * 128 + sc);
#pragma unroll
        for (int ps = 0; ps < 4; ++ps) ur[ps] = *(const u32x4*)(usrc + (size_t)32 * ps * ZLD);
        if (db + 1 < db0 + 2) S_LOAD(db + 1);
        f32x16 o0 = {}, o1 = {};
        if (dh == 0) { PV_D0(o0, 0, 0, pa[0], pa[1], pa[2], pa[3]); PV_D0(o0, SHM_V, 0, pa[4], pa[5], pa[6], pa[7]); PV_D0(o1, 0, 1, pa[0], pa[1], pa[2], pa[3]); PV_D0(o1, SHM_V, 1, pa[4], pa[5], pa[6], pa[7]); }
        else         { PV_D0(o0, 0, 2, pa[0], pa[1], pa[2], pa[3]); PV_D0(o0, SHM_V, 2, pa[4], pa[5], pa[6], pa[7]); PV_D0(o1, 0, 3, pa[0], pa[1], pa[2], pa[3]); PV_D0(o1, SHM_V, 3, pa[4], pa[5], pa[6], pa[7]); }
        { const int colb = g * SGG + db * 128 + dh * 64 + r32; const float gv0 = gvv[colb], gv1 = gvv[colb + 32];
          float* tp = T + (size_t)(pb * 32) * SG_TP + dh * 64 + r32;
#pragma unroll
          for (int r = 0; r < 16; ++r) { const int p = crow(r, hi); tp[p * SG_TP] = gv0 * o0[r] + bias[r]; tp[p * SG_TP + 32] = gv1 * o1[r] + bias[r]; } }
        __syncthreads();
#pragma unroll
        for (int ps = 0; ps < 4; ++ps) { const float* tr = T + (size_t)(32 * ps + sr) * SG_TP + sc; const f32x4 t0 = *(const f32x4*)tr, t1 = *(const f32x4*)(tr + 4); const u32x4 u = ur[ps];
            u32x4 w; w.x = cvt_pk_bf16(__uint_as_float(u.x << 16) * t0[0], __uint_as_float(u.x & 0xffff0000u) * t0[1]); w.y = cvt_pk_bf16(__uint_as_float(u.y << 16) * t0[2], __uint_as_float(u.y & 0xffff0000u) * t0[3]);
            w.z = cvt_pk_bf16(__uint_as_float(u.z << 16) * t1[0], __uint_as_float(u.z & 0xffff0000u) * t1[1]); w.w = cvt_pk_bf16(__uint_as_float(u.w << 16) * t1[2], __uint_as_float(u.w & 0xffff0000u) * t1[3]);
            *(u32x4*)(usrc + store_off + (size_t)32 * ps * ZLD) = w; }
    }
    __syncthreads();
#undef S_LOAD
#undef S_WRITE
#undef ZADDR
#undef ZLD
}
#undef TRRD
}
constexpr int NWAVES = 8;
constexpr int RING_BYTES = 131072, LDSCTL_OFF = RING_BYTES, LDS_BYTES = 147456;
constexpr int NPH = 32;

struct Ctx { KArgs a; LAS unsigned char* lds; gu32* ctl; XcdBarrier bar; int tid, lane, wave, vcu, G, gw, NGW, lo, hi; unsigned long long tlast; };
#define PH_IN(k) (C.lo <= (k) && (k) < C.hi)
#define PH_SEAM(k) do { if (PROBE_PH) { if (C.wave == 0) { const unsigned long long n_ = __builtin_amdgcn_s_memrealtime(), d_ = n_ - C.tlast; if ((PROBE_PH >> (k)) & 1ull) { while (__builtin_amdgcn_s_memrealtime() - n_ < d_) __builtin_amdgcn_s_sleep(8); } } } \
    if (!MK_PER_PHASE && (k) + 1 < C.hi) xcd_barrier(C.bar); if (PROBE_PH) C.tlast = __builtin_amdgcn_s_memrealtime(); } while (0)
#define WSP(T, off) ((T*)(C.a.ws + (off)))

struct SchedF {
    const char* A; const char* B; int mode, G, c;
    __device__ __forceinline__ bool next(int i, pg8::Unit& u) const {
        const int L = i * G + c; u.pm = 0; u.pn = 0; u.nt = 0; u.kind = 0;
        if (mode == 0) { if (L >= 1024) return false; const int b = L >> 9, rem = L & 511, gr = rem & 15, tq = rem >> 4, g = gr >> 1, reim = gr & 1;
            u.a = A + (size_t)reim * 256 * 256 * 2; u.b = B + ((size_t)(b * SEQ + 4 * tq) * D + g * 256) * 2;
            u.o = ((((long)(b * 128 + 4 * tq) * 1024 + (g & 3) * 256) * 2 + (g >> 2)) * 2 + reim) * 64; return true; }
        if (mode == 1) { if (L >= 32) return false; const int b = L >> 4, gr = L & 15, g = gr >> 1, reim = gr & 1;
            u.a = A + (size_t)reim * 256 * 256 * 2; u.b = B + ((size_t)(ML + b * CTXL) * D + g * 256) * 2; u.o = (long)(b * D + g * 256) * 512 + reim * 256; return true; }
        if (mode == 2) { if (L >= 1024) return false; const int b = L >> 9, cp = L & 511;
            u.a = A; u.b = B + ((size_t)b * 33554432 + (size_t)cp * 512) * 2; u.o = (long)b * 33554432 + (long)cp * 1024; return true; }
        if (mode == 3) { if (L >= 512) return false; const int b = L >> 8, k1 = (L >> 2) & 63, cb = L & 3;
            u.a = A; u.b = B + ((size_t)(b * 64 + k1) * 1024 + cb * 256) * 512 * 2; u.o = (long)(b * SEQ + k1) * D + cb * 256; return true; }
        if (L >= 16) return false; { const int b = L >> 3, pn = L & 7;
            u.a = A; u.b = B + (size_t)(b * D + pn * 256) * 512 * 2; u.o = (long)(ML + b * CTXL) * D + pn * 256; return true; }
    }
};

__device__ __forceinline__ void ctx_splitk(Ctx& C, const bf16* A, int lda, const bf16* B, int ldb, int Ks, int ns, int nN, int pn0, int N, size_t aks = 0, size_t bks = 0, int gsub = 0) {
    const int cr = C.G - 1 - (int)blockIdx.x; const int Gs = gsub ? gsub : C.G; const int cs = (cr < Gs) ? cr : (1 << 28);
    const pg8::SchedSK S{(const char*)A, (const char*)B, lda, ldb, ns, nN, pn0, N, Gs, cs, aks ? aks : (size_t)Ks * 2, bks ? bks : (size_t)Ks * 2};
    const pg8::EpiSlab E{WSP(slab_t, WS_SLAB), N};
    pg8::gemm_phase<pg8::EpiSlab, pg8::SchedSK>(C.lds, pg8::mk_gemm(lda, ldb, Ks), S, E);
}
#define MXL(l) (WSP(const float, WS_MX) + (size_t)(l) * 3 * NADA)
#define BAL(l) (C.a.in[I_BADA] + (size_t)(l) * NADA)
#define SSQX(site) (WSP(float, WS_Z2 + Z2_SSQX) + (size_t)(site) * MT)
#define NORMG(l, w) (C.a.in[I_NORMG] + (size_t)((l) * 2 + (w)) * D)

template <bool NEXT, bool KCH, class TIN = xr_t, class TOUT = xr_t> __device__ __forceinline__ void residual_gemm(Ctx& C, const bf16* A, int lda, const bf16* Bt, int ldb, int K, pg8::Gemm g, int l, int gchunk, TOUT* rout, int nl, int nw, int site,
                                                                              bool ctx, int ns, int Ks, size_t aks, size_t bks, int pm0 = 0, int npan = 64, const TIN* rin = nullptr) {
    const TIN* XR = rin ? rin : (const TIN*)WSP(const xr_t, WS_XR);
    pg8::SchedRC S = pg8::make_rc(A, lda, Bt, ldb, npan, 8, D, 256, C.G, (int)blockIdx.x); S.pm0 = pm0;
    const pg8::EpiRes<NEXT, TIN, TOUT> E{XR, rout, MXL(l) + gchunk * D, BAL(l) + gchunk * D, WSP(bf16, WS_H), NORMG(nl, nw), MXL(nl) + (nw * 3 + 1) * D, BAL(nl) + (nw * 3 + 1) * D, SSQX(site)};
    if (ctx && !KCH) {
        const int cr = C.G - 1 - (int)blockIdx.x;
        const pg8::SchedSK SK{(const char*)A, (const char*)Bt, lda, ldb, ns, 8, 0, D, C.G, cr, aks ? aks : (size_t)Ks * 2, bks ? bks : (size_t)Ks * 2};
        const pg8::SchedMix<pg8::SchedRC, pg8::SchedSK> SM{S, SK, Ks / 64, cr < ns * 2 * 8};
        const pg8::Epi2<pg8::EpiRes<NEXT, TIN, TOUT>, pg8::EpiSlab> E2{E, pg8::EpiSlab{WSP(slab_t, WS_SLAB), D}};
        pg8::gemm_phase<pg8::Epi2<pg8::EpiRes<NEXT, TIN, TOUT>, pg8::EpiSlab>, pg8::SchedMix<pg8::SchedRC, pg8::SchedSK>, false>(C.lds, g, SM, E2);
    } else {
        if (ctx) ctx_splitk(C, A, lda, Bt, ldb, Ks, ns, 8, 0, D, aks, bks, STAGGER_G);
        pg8::gemm_phase<pg8::EpiRes<NEXT, TIN, TOUT>, pg8::SchedRC, KCH>(C.lds, g, S, E);
    }
}
__device__ __forceinline__ void ctxfin(Ctx& C, int ns, int l, int gchunk, int nl, int nw, int site) {
    ctxfin_phase(WSP(const slab_t, WS_SLAB), ns, MXL(l) + gchunk * D, BAL(l) + gchunk * D, WSP(xr_t, WS_XR), WSP(bf16, WS_H), NORMG(nl, nw), MXL(nl) + (nw * 3 + 1) * D, BAL(nl) + (nw * 3 + 1) * D, SSQX(site), C.gw, C.NGW, C.lane);
}
__device__ __forceinline__ void gateup_gemm(Ctx& C, int l, int nM, int site) {
    constexpr size_t GCS = (size_t)MT * 512;
    const pg8::EpiSwiGLU<true> E{WSP(bf16, WS_AR + AR_G), KCHUNK ? 512 : LDG_PAD, SSQX(site), WSP(const float, WS_Z2 + Z2_SWGU) + (size_t)l * 3 * 2 * DFF};
    { pg8::SchedRC S = pg8::make_rc(WSP(const bf16, WS_H), D, WSP(const bf16, WS_WGU + (size_t)l * 44 * MiB), D, 64, 44, KCHUNK ? 512 : LDG_PAD, 128, C.G, (int)blockIdx.x); S.pnflip = 1; if (KCHUNK) { S.ocl2 = 2; S.ocs = (long)GCS; }
      pg8::gemm_phase<pg8::EpiSwiGLU<true>, pg8::SchedRC>(C.lds, pg8::mk_gemm(D, D, D), S, E); }
    if (nM == 66) { pg8::SchedRC S = pg8::make_rc(WSP(const bf16, WS_H), D, WSP(const bf16, WS_WGU + (size_t)l * 44 * MiB), D, 2, 44, KCHUNK ? 512 : LDG_PAD, 128, C.G, C.G - 1 - (int)blockIdx.x); S.pm0 = 64; S.pnflip = 1; if (KCHUNK) { S.ocl2 = 2; S.ocs = (long)GCS; }
      pg8::gemm_phase<pg8::EpiSwiGLU<true>, pg8::SchedRC>(C.lds, pg8::mk_gemm(D, D, D), S, E); }
}
template <bool NEXT, bool LAST = false> __device__ __forceinline__ void down_gemm(Ctx& C, int l, bool ctx, int nl, int site, int pm0 = 0, int npan = 64) {
    constexpr size_t GCS = (size_t)MT * 512; constexpr int LDG = KCHUNK ? 512 : LDG_PAD;
    pg8::Gemm gd = pg8::mk_gemm(LDG, LDG, DFF); if (KCHUNK) { gd.kcl2 = 3; gd.acs = GCS * 2; gd.bcs = (size_t)D * 512 * 2; }
    if constexpr (LAST) residual_gemm<NEXT, KCHUNK != 0, xr_t, float>(C, WSP(const bf16, WS_AR + AR_G), LDG, WSP(const bf16, WS_WDN + (size_t)l * WDN_SLOT), LDG, DFF, gd, l, 5, C.a.out, nl, 0, site,
                                     ctx, 11, 512, KCHUNK ? GCS * 2 : 0, KCHUNK ? (size_t)D * 512 * 2 : 0, pm0, npan);
    else residual_gemm<NEXT, KCHUNK != 0>(C, WSP(const bf16, WS_AR + AR_G), LDG, WSP(const bf16, WS_WDN + (size_t)l * WDN_SLOT), LDG, DFF, gd, l, 5, WSP(xr_t, WS_XR), nl, 0, site,
                                     ctx, 11, 512, KCHUNK ? GCS * 2 : 0, KCHUNK ? (size_t)D * 512 * 2 : 0, pm0, npan);
}

__global__ void __launch_bounds__(NWAVES * 64, 2) mega(KArgs args) {
    extern __shared__ __attribute__((aligned(16))) unsigned char lds_raw[];
    Ctx C; C.a = args; C.lds = (LAS unsigned char*)lds_raw; C.ctl = (gu32*)(args.ws + WS_CTL);
    C.tid = threadIdx.x; C.lane = C.tid & 63; C.wave = __builtin_amdgcn_readfirstlane(C.tid >> 6);
    C.G = gridDim.x; { const int bx = blockIdx.x; C.vcu = (C.G % 8 == 0) ? (bx % 8) * (C.G / 8) + bx / 8 : bx; }
    C.gw = C.vcu * NWAVES + C.wave; C.NGW = C.G * NWAVES; C.lo = args.ph_lo; C.hi = args.ph_hi;
    volatile LAS unsigned* MISC = (volatile LAS unsigned*)(C.lds + LDSCTL_OFF);
    for (int u = C.tid; u < (LDS_BYTES - LDSCTL_OFF) / 4; u += NWAVES * 64) ((LAS unsigned*)(C.lds + LDSCTL_OFF))[u] = 0u;
    __syncthreads();
    C.bar.bar = (unsigned*)(C.ctl + CW_BAR); C.bar.x = 0; C.bar.st = nullptr;
    if (!MK_PER_PHASE) C.bar = xcd_barrier_post((unsigned*)(C.ctl + CW_BAR), MISC + 8);
    C.tlast = PROBE_PH ? __builtin_amdgcn_s_memrealtime() : 0ull;

    xr_t* XR = WSP(xr_t, WS_XR); bf16* H = WSP(bf16, WS_H);
    bf16* QKV = WSP(bf16, WS_AR + AR_QKV); bf16* AO = WSP(bf16, WS_AR + AR_AO);
    if (PH_IN(0)) { prologue_phase<0>(C.a, C.lds, C.ctl, C.tid, C.lane, C.wave); PH_SEAM(0); }
    if (PH_IN(1)) { prologue_phase<1>(C.a, C.lds, C.ctl, C.tid, C.lane, C.wave);
        if (!MK_PER_PHASE || true) { asm volatile("s_waitcnt vmcnt(0) lgkmcnt(0)" ::: "memory"); __syncthreads(); modnorm_phase(C.a.in[I_X], C.a.in[I_CTX], XR, H, NORMG(0, 0), MXL(0), BAL(0), 0, MT, C.gw, C.NGW, C.lane); }
        PH_SEAM(1); }

    if (PH_IN(3)) { const bf16* Wq = WSP(const bf16, WS_WQKV);
        { const pg8::SchedRC S = pg8::make_rc(H, D, Wq, D, 64, 12, NQKV, 256, C.G, (int)blockIdx.x);
          const pg8::EpiBf16<0, false, false> E{QKV, NQKV, nullptr, 0, nullptr, nullptr, 0};
          const int cr = C.G - 1 - (int)blockIdx.x;
          const pg8::SchedSK SK{(const char*)H, (const char*)Wq, D, D, 8, 12, 0, NQKV, C.G, cr, (size_t)256 * 2, (size_t)256 * 2};
          const pg8::SchedMix<pg8::SchedRC, pg8::SchedSK> SM{S, SK, 4, cr < 8 * 2 * 12};
          const pg8::Epi2<pg8::EpiBf16<0, false, false>, pg8::EpiSlab> E2{E, pg8::EpiSlab{WSP(slab_t, WS_SLAB), NQKV}};
          pg8::gemm_phase<pg8::Epi2<pg8::EpiBf16<0, false, false>, pg8::EpiSlab>, pg8::SchedMix<pg8::SchedRC, pg8::SchedSK>>(C.lds, pg8::mk_gemm(D, D, D), SM, E2); }
        PH_SEAM(3); }
    if (PH_IN(4)) { qknorm_rope_phase(QKV, C.a.in[I_QG], C.a.in[I_KG], WSP(const f32x2, WS_ROPE), MT, C.gw, C.NGW, C.lane, WSP(const slab_t, WS_SLAB), 8, 0); PH_SEAM(4); }
    if (PH_IN(5)) { attn::attn_phase(QKV, AO, C.a.in[I_SINK], true, C.vcu, C.G, (char*)C.lds); PH_SEAM(5); }
    if (PH_IN(6)) { residual_gemm<true, false, float, xr_t>(C, AO, D, WSP(const bf16, WS_WO), D, D, pg8::mk_gemm(D, D, D), 0, 2, XR, 0, 1, 0, true, 8, 256, 0, 0, 0, 64, C.a.in[I_X]); PH_SEAM(6); }
    if (PH_IN(7)) { ctxfin(C, 8, 0, 2, 0, 1, 0); PH_SEAM(7); }
    if (PH_IN(8)) { gateup_gemm(C, 0, 66, 0); PH_SEAM(8); }
    if (PH_IN(9)) { down_gemm<false>(C, 0, true, 0, 0); PH_SEAM(9); }

    {
        bf16* XA = WSP(bf16, WS_AR + AR_XA); bf16* XB = WSP(bf16, WS_AR + AR_XB); bf16* XTC = WSP(bf16, WS_AR + AR_XTC); bf16* Y = WSP(bf16, WS_AR + AR_Y);
        if (PH_IN(10)) { modnorm_phase(XR, XR + (size_t)ML * D, nullptr, H, NORMG(1, 0), MXL(1), BAL(1), 0, MT, C.gw, C.NGW, C.lane, WSP(const slab_t, WS_SLAB), 11, MXL(0) + 5 * D, BAL(0) + 5 * D, XR); PH_SEAM(10); }
        if (PH_IN(11)) {
            { const SchedF S{(const char*)WSP(bf16, WS_DC2), (const char*)H, 0, C.G, (int)blockIdx.x}; const pg8::EpiF1 E{XA};
              pg8::Gemm g = pg8::mk_gemm(256, 128 * D, 256); g.bs_log2 = 6; g.ldb_hi = D; g.hsB = 2 * D;
              pg8::gemm_phase<pg8::EpiF1, SchedF>(C.lds, g, S, E); }
            { const SchedF S{(const char*)WSP(bf16, WS_DC2), (const char*)H, 1, C.G, C.G - 1 - (int)blockIdx.x}; const pg8::EpiBf16<0, false, false> E{XTC, 512, nullptr, 0, nullptr, nullptr, 0};
              pg8::gemm_phase<pg8::EpiBf16<0, false, false>, SchedF>(C.lds, pg8::mk_gemm(256, D, 256), S, E); }
            PH_SEAM(11); }
        if (PH_IN(12)) {
            { const SchedF S{(const char*)WSP(bf16, WS_DA), (const char*)XA, 2, C.G, (int)blockIdx.x}; const pg8::EpiFA E{XB};
              pg8::Gemm g = pg8::mk_gemm(256, 262144, 256); g.hsB = 256;
              pg8::gemm_phase<pg8::EpiFA, SchedF>(C.lds, g, S, E); }
            { const SchedF S{(const char*)WSP(bf16, WS_FC), (const char*)XTC, 4, C.G, C.G - 1 - (int)blockIdx.x}; const pg8::EpiBf16<0, false, false> E{Y, D, nullptr, 0, nullptr, nullptr, 0};
              pg8::gemm_phase<pg8::EpiBf16<0, false, false>, SchedF>(C.lds, pg8::mk_gemm(512, 512, 512), S, E); }
            PH_SEAM(12); }
        if (PH_IN(13)) {
            const SchedF S{(const char*)WSP(bf16, WS_DB), (const char*)XB, 3, C.G, (int)blockIdx.x}; const pg8::EpiFB E{Y};
            pg8::gemm_phase<pg8::EpiFB, SchedF>(C.lds, pg8::mk_gemm(512, 512, 512), S, E);
            PH_SEAM(13); }
        if (PH_IN(14)) { residual_gemm<true, false>(C, Y, D, WSP(const bf16, WS_WF), D, D, pg8::mk_gemm(D, D, D), 1, 2, XR, 1, 1, 1, true, 8, 256, 0, 0); PH_SEAM(14); }
    }
    if (PH_IN(15)) { ctxfin(C, 8, 1, 2, 1, 1, 1); PH_SEAM(15); }
    if (PH_IN(16)) { gateup_gemm(C, 1, 66, 1); PH_SEAM(16); }
    if (PH_IN(17)) { down_gemm<true>(C, 1, true, 2, 2); PH_SEAM(17); }
    if (PH_IN(18)) { ctxfin(C, 11, 1, 5, 2, 0, 2); PH_SEAM(18); }

    {
        bf16* Z = WSP(bf16, WS_AR + AR_Z); float* SSQ = (float*)(C.a.ws + WS_CTL) + CW_SSQ;
        constexpr size_t ZCS = (size_t)MT * 512; constexpr int LDZ = KCHUNK ? 512 : 2 * SGH;
        if (PH_IN(19)) { const pg8::EpiBf16<1, true, true> E{Z, LDZ, SSQ, 24, SSQX(2), WSP(const float, WS_Z2 + Z2_SWSI), 2 * SGH};
            { pg8::SchedRC S = pg8::make_rc(H, D, WSP(const bf16, WS_WSI), D, 64, 48, LDZ, 256, C.G, (int)blockIdx.x); if (KCHUNK) { S.ocl2 = 1; S.ocs = (long)ZCS; }
              pg8::gemm_phase<pg8::EpiBf16<1, true, true>, pg8::SchedRC>(C.lds, pg8::mk_gemm(D, D, D), S, E); }
            { pg8::SchedRC S = pg8::make_rc(H, D, WSP(const bf16, WS_WSI), D, 2, 48, LDZ, 256, C.G, C.G - 1 - (int)blockIdx.x); S.pm0 = 64; if (KCHUNK) { S.ocl2 = 1; S.ocs = (long)ZCS; }
              pg8::gemm_phase<pg8::EpiBf16<1, true, true>, pg8::SchedRC>(C.lds, pg8::mk_gemm(D, D, D), S, E); }
            PH_SEAM(19); }
        if (PH_IN(20)) { for (int uid = C.vcu; uid < (MT / 128) * 24; uid += C.G) { const int cg = uid / 3; attn::sgu_unit(Z, SSQ, C.a.in[I_WSS], C.a.in[I_BSS], C.a.in[I_SVG], cg >> 3, cg & 7, 2 * (uid - 3 * cg), (char*)C.lds); } PH_SEAM(20); }
        if (PH_IN(21)) { pg8::Gemm go = pg8::mk_gemm(LDZ, KCHUNK ? 512 : SGH, SGH); if (KCHUNK) { go.kcl2 = 3; go.acs = ZCS * 2; go.bcs = (size_t)D * 512 * 2; }
            residual_gemm<true, KCHUNK != 0>(C, Z, LDZ, WSP(const bf16, WS_WSO), KCHUNK ? 512 : SGH, SGH, go, 2, 2, XR, 2, 1, 3, true, 12, 512, KCHUNK ? ZCS * 2 : 0, KCHUNK ? (size_t)D * 512 * 2 : 0); PH_SEAM(21); }
    }
    if (PH_IN(22)) { ctxfin(C, 12, 2, 2, 2, 1, 3); PH_SEAM(22); }
    if (PH_IN(23)) { gateup_gemm(C, 2, 66, 3); PH_SEAM(23); }
    if (PH_IN(24)) { down_gemm<true>(C, 2, true, 3, 4); PH_SEAM(24); }
    if (PH_IN(25)) { ctxfin(C, 11, 2, 5, 3, 0, 4); PH_SEAM(25); }

    if (PH_IN(26)) { const bf16* Wq = WSP(const bf16, WS_WQKV + (size_t)12 * MiB);
        { const pg8::SchedRC S = pg8::make_rc(H, D, Wq, D, 64, 12, NQKV, 256, C.G, (int)blockIdx.x);
          const pg8::EpiBf16<0, false, true> E{QKV, NQKV, nullptr, 0, SSQX(4), WSP(const float, WS_Z2 + Z2_SWQ3), NQKV};
          const int cr = C.G - 1 - (int)blockIdx.x;
          const pg8::SchedSK SK{(const char*)H, (const char*)Wq, D, D, 8, 4, 8, NQKV, C.G, cr, (size_t)256 * 2, (size_t)256 * 2};
          const pg8::SchedMix<pg8::SchedRC, pg8::SchedSK> SM{S, SK, 4, cr < 8 * 2 * 4};
          const pg8::Epi2<pg8::EpiBf16<0, false, true>, pg8::EpiSlab> E2{E, pg8::EpiSlab{WSP(slab_t, WS_SLAB), NQKV}};
          pg8::gemm_phase<pg8::Epi2<pg8::EpiBf16<0, false, true>, pg8::EpiSlab>, pg8::SchedMix<pg8::SchedRC, pg8::SchedSK>>(C.lds, pg8::mk_gemm(D, D, D), SM, E2); }
        PH_SEAM(26); }
    if (PH_IN(27)) { qknorm_rope_phase(QKV, C.a.in[I_QG] + HD, C.a.in[I_KG] + HD, WSP(const f32x2, WS_ROPE), MT, C.gw, C.NGW, C.lane, WSP(const slab_t, WS_SLAB), 8, 4, SSQX(4), WSP(const float, WS_Z2 + Z2_SWQ3) + 2 * NQKV); PH_SEAM(27); }
    if (PH_IN(28)) { attn::attn_phase(QKV, AO, C.a.in[I_SINK] + NH, false, C.vcu, C.G, (char*)C.lds); PH_SEAM(28); }
    if (PH_IN(29)) { residual_gemm<true, false>(C, AO, D, WSP(const bf16, WS_WO + (size_t)8 * MiB), D, D, pg8::mk_gemm(D, D, D), 3, 2, XR, 3, 1, 5, false, 0, 0, 0, 0); PH_SEAM(29); }
    if (PH_IN(30)) { gateup_gemm(C, 3, 64, 5); PH_SEAM(30); }
    if (PH_IN(31)) { down_gemm<false, true>(C, 3, false, 0, 0); PH_SEAM(31); }
}

extern "C" void kernel_launch(void* const* d_in, const int* in_sizes, int n_in, void* d_out, int out_size, void* d_ws, size_t ws_size, hipStream_t stream) {
    static int grid = 0;
    if (grid == 0) {
        if (n_in != 21 || in_sizes[0] != ML * D || out_size != ML * D || ws_size < WS_END) { fprintf(stderr, "kernel_launch: unexpected shapes (n_in %d, in0 %d, out %d, ws %zu < %zu)\n", n_in, n_in > 0 ? in_sizes[0] : -1, out_size, ws_size, (size_t)WS_END); grid = -1; return; }
        int dev = 0, cus = 0, per_cu = 0;
        if (hipGetDevice(&dev) != hipSuccess || hipDeviceGetAttribute(&cus, hipDeviceAttributeMultiprocessorCount, dev) != hipSuccess) { grid = -1; return; }
        if (hipFuncSetAttribute((const void*)mega, hipFuncAttributeMaxDynamicSharedMemorySize, LDS_BYTES) != hipSuccess) { fprintf(stderr, "kernel_launch: hipFuncSetAttribute failed\n"); grid = -1; return; }
        if (hipOccupancyMaxActiveBlocksPerMultiprocessor(&per_cu, (const void*)mega, NWAVES * 64, LDS_BYTES) != hipSuccess || per_cu < 1) fprintf(stderr, "kernel_launch: occupancy query says %d\n", per_cu);
        (void)hipGetLastError();
        grid = cus;
    }
    if (grid < 0) return;
    if (hipMemsetAsync((char*)d_ws + WS_CTL, 0, CTL_ZERO_BYTES, stream) != hipSuccess) return;
    KArgs a{};
    for (int i = 0; i < 21; ++i) a.in[i] = (const float*)d_in[i];
    a.out = (float*)d_out; a.ws = (unsigned char*)d_ws;
#if MK_PER_PHASE
    for (int ph = 0; ph < NPH; ++ph) { a.ph_lo = ph; a.ph_hi = ph + 1; hipLaunchKernelGGL(mega, dim3(grid), dim3(NWAVES * 64), LDS_BYTES, stream, a); }
#else
    a.ph_lo = 0; a.ph_hi = NPH; hipLaunchKernelGGL(mega, dim3(grid), dim3(NWAVES * 64), LDS_BYTES, stream, a);
#endif
}
```

```cpp
#include <hip/hip_runtime.h>
#include <cstdio>
#include <cstdint>

#ifndef MK_PER_PHASE
#define MK_PER_PHASE 0
#endif

#ifndef KCHUNK
#define KCHUNK 0
#endif
#ifndef GLDS_SADDR
#define GLDS_SADDR 1
#endif
#ifndef SK_POS
#define SK_POS 0
#endif
#ifndef STAGGER_G
#define STAGGER_G 0
#endif
#ifndef PROBE_BAR2
#define PROBE_BAR2 0
#endif
#ifndef PROBE_PH
#define PROBE_PH 0ull
#endif
#ifndef PROBE_T
#define PROBE_T 0
#endif
#ifndef PROBE_DUP
#define PROBE_DUP 0
#endif
constexpr int D = 2048, NBATCH = 2, SEQ = 8192, CTXL = 256, DEPTH = 4;
constexpr int ML = NBATCH * SEQ, MC = NBATCH * CTXL, MT = ML + MC;
constexpr int NH = 16, NKV = 4, HD = 128, HQ = 2048, HKV = 512, NQKV = HQ + 2 * HKV;
constexpr int DFF = 5632, SGH = 6144, SGG = 768, NADA = 6 * D;
constexpr float EPS = 1e-6f;

constexpr size_t MiB = 1u << 20;
constexpr size_t WS_CTL = 0, CTL_ZERO_BYTES = 2 * MiB;
constexpr size_t WS_MX = 2 * MiB;
constexpr size_t WS_ROPE = 3 * MiB;
constexpr size_t WS_DC2 = 7 * MiB;
constexpr size_t WS_DB = WS_DC2 + 256 * 1024;
constexpr size_t WS_FC = WS_DC2 + 512 * 1024;
constexpr size_t WS_DA = WS_DC2 + 768 * 1024;
constexpr size_t WS_WGU = 8 * MiB;
constexpr size_t WS_WDN = WS_WGU + 4 * 44 * MiB;
constexpr int LDG_PAD = 5760;
constexpr size_t WDN_SLOT = 24 * MiB;
constexpr size_t WS_WQKV = WS_WDN + 4 * WDN_SLOT;
constexpr size_t WS_WO = WS_WQKV + 2 * 12 * MiB;
constexpr size_t WS_WF = WS_WO + 2 * 8 * MiB;
constexpr size_t WS_WSI = WS_WF + 8 * MiB;
constexpr size_t WS_WSO = WS_WSI + 48 * MiB;
constexpr size_t WS_XR = WS_WSO + 24 * MiB;
constexpr size_t WS_H = WS_XR + 132 * MiB;
constexpr size_t WS_AR = WS_H + 66 * MiB;
constexpr size_t AR_QKV = 0, AR_AO = 99 * MiB;
constexpr size_t AR_G = 0;
constexpr size_t AR_Z = 0;
constexpr size_t AR_XA = 0, AR_XB = 128 * MiB, AR_XTC = 256 * MiB, AR_Y = 260 * MiB;
constexpr size_t WS_SLAB = WS_AR + 396 * MiB;
constexpr size_t WS_Z2 = WS_CTL + 256 * 1024, Z2_BYTES = 1280 * 1024;
constexpr size_t Z2_SWGU = 0;
constexpr size_t Z2_SWSI = 540672;
constexpr size_t Z2_SWQ3 = Z2_SWSI + 147456;
constexpr size_t Z2_SSQX = 786432;
static_assert(Z2_SWQ3 + 36864 <= Z2_SSQX && Z2_SSQX + 6 * 16896 * 4 <= Z2_BYTES, "z2");
constexpr size_t WS_END = WS_SLAB + 72 * MiB;
constexpr int CW_TMO = 0;
constexpr int CW_BAR = 4096;
constexpr int CW_SSQ = 16384;
static_assert((size_t)(CW_SSQ + MT) * 4 <= WS_Z2 && WS_Z2 + Z2_BYTES <= WS_CTL + CTL_ZERO_BYTES, "ctl");

#define GAS __attribute__((address_space(1)))
#define LAS __attribute__((address_space(3)))
typedef unsigned short bf16;
typedef unsigned short bf16_t;
typedef short bf16x8 __attribute__((ext_vector_type(8)));
typedef short s16x4 __attribute__((ext_vector_type(4)));
typedef float f32x4 __attribute__((ext_vector_type(4)));
typedef float f32x2 __attribute__((ext_vector_type(2)));
typedef float f32x16 __attribute__((ext_vector_type(16)));
typedef unsigned u32x4 __attribute__((ext_vector_type(4)));
typedef unsigned u32x2 __attribute__((ext_vector_type(2)));

typedef _Float16 xr_t;
typedef _Float16 slab_t;
typedef _Float16 h16x4 __attribute__((ext_vector_type(4)));
__device__ __forceinline__ f32x4 ld4(const float* p) { return *(const f32x4*)p; }
__device__ __forceinline__ f32x4 ld4(const xr_t* p) { return __builtin_convertvector(*(const h16x4*)p, f32x4); }
__device__ __forceinline__ void st4(float* p, f32x4 v) { *(f32x4*)p = v; }
__device__ __forceinline__ void st4(xr_t* p, f32x4 v) { *(h16x4*)p = __builtin_convertvector(v, h16x4); }
typedef _Float16 h16x8 __attribute__((ext_vector_type(8)));
typedef float f32x8 __attribute__((ext_vector_type(8)));
__device__ __forceinline__ void ld8(const float* p, f32x4& a, f32x4& b) { a = *(const f32x4*)p; b = *(const f32x4*)(p + 4); }
__device__ __forceinline__ void ld8(const xr_t* p, f32x4& a, f32x4& b) { const f32x8 v = __builtin_convertvector(*(const h16x8*)p, f32x8); a = (f32x4){v[0], v[1], v[2], v[3]}; b = (f32x4){v[4], v[5], v[6], v[7]}; }
__device__ __forceinline__ void st8(float* p, f32x4 a, f32x4 b) { *(f32x4*)p = a; *(f32x4*)(p + 4) = b; }
__device__ __forceinline__ void st8(xr_t* p, f32x4 a, f32x4 b) { const f32x8 v = {a[0], a[1], a[2], a[3], b[0], b[1], b[2], b[3]}; *(h16x8*)p = __builtin_convertvector(v, h16x8); }
__device__ __forceinline__ unsigned cvt_pk_bf16(float lo, float hi) { unsigned r; asm volatile("v_cvt_pk_bf16_f32 %0, %1, %2" : "=v"(r) : "v"(lo), "v"(hi)); return r; }
__device__ __forceinline__ float bf2f(unsigned short b) { return __uint_as_float(((unsigned)b) << 16); }

namespace pg8 {
#define PG8_LAS __attribute__((address_space(3)))
constexpr int BM = 256, BK = 64, HALF = 128, HTB = HALF * BK * 2, STAGE_BYTES = 8 * HTB, NXCD = 8, WGM = 8;
__host__ __device__ __forceinline__ int lds_byte(int r, int c) { const int st = (r >> 4) * 2 + (c >> 5), rr = r & 15, cc = c & 31, ob = rr * 64 + cc * 2; return st * 1024 + (ob ^ (((ob >> 9) & 1) << 5)); }
__host__ __device__ __forceinline__ void stage_rc(int b, int& R, int& C) { const int st = b / 1024, sb = b % 1024, swz = sb ^ (((sb >> 9) & 1) << 5); R = (st >> 1) * 16 + swz / 64; C = (st & 1) * 32 + (swz % 64) / 2; }
__host__ __device__ __forceinline__ int perm32(int rho) { const int n = rho >> 4, i = rho & 15; return 8 * (i >> 2) + 4 * n + (i & 3); }

struct Unit { const char* a; const char* b; long o; int pm, pn, nt, kind; };
struct Gemm { int lda, ldb, K, bs_log2, ldb_hi; long hsB; int kcl2; size_t acs, bcs; };
__device__ __forceinline__ Gemm mk_gemm(int lda, int ldb, int K) { Gemm g; g.lda = lda; g.ldb = ldb; g.K = K; g.bs_log2 = 7; g.ldb_hi = 0; g.hsB = (long)HALF * ldb; g.kcl2 = 24; g.acs = 0; g.bcs = 0; return g; }

__device__ __forceinline__ void tile_of(int L, int nM, int nN, int& pm, int& pn, int wgm = WGM) {
    const int nwg = nM * nN; int wgid = L;
    { const int q = nwg / NXCD, r = nwg % NXCD, xcd = wgid % NXCD, off = wgid / NXCD; wgid = (xcd < r ? xcd * (q + 1) : r * (q + 1) + (xcd - r) * q) + off; }
    const int nig = wgm * nN, gid = wgid / nig, fm = gid * wgm, gsz = (nM - fm) < wgm ? (nM - fm) : wgm;
    pm = fm + ((wgid % nig) % gsz); pn = (wgid % nig) / gsz;
}

__device__ __forceinline__ f32x2 gelu_pk(f32x2 v) {
    const f32x2 av = __builtin_elementwise_abs(v), d = av * 0.2316418882f + 1.0f;
    f32x2 t; t.x = __builtin_amdgcn_rcpf(d.x); t.y = __builtin_amdgcn_rcpf(d.y);
    f32x2 q = t * 0.5307027145f + (-0.7265760135f); q = q * t + 0.7107068705f; q = q * t + (-0.142248368f); q = q * t + 0.127414796f; q = q * t;
    const f32x2 s = (v * v) * (-0.72134752044f);
    f32x2 e; e.x = __builtin_amdgcn_exp2f(s.x); e.y = __builtin_amdgcn_exp2f(s.y);
    const f32x2 m = v * (q * e), r = v - m;
    f32x2 o; o.x = v.x < 0.f ? m.x : r.x; o.y = v.y < 0.f ? m.y : r.y; return o;
}

template <class Epi, class Sched, bool KCH = false, bool ALIGN_EPI = true, bool SP2 = true, int TPROBE = 0>
__device__ __forceinline__ void gemm_phase(PG8_LAS unsigned char* lds, const Gemm g, const Sched& S, const Epi& E) {
    int tid = threadIdx.x; asm volatile("" : "+v"(tid));
    const int wid = __builtin_amdgcn_readfirstlane(tid >> 6), lane = tid & 63, wr = wid >> 2, wc = wid & 3, fr = lane & 15, fq = lane >> 4;
    const int K = g.K; int nt = K / BK;
    unsigned voffA[2], voffB[2];
#pragma unroll
    for (int i = 0; i < 2; ++i) { int R, C; stage_rc(tid * 16 + i * 8192, R, C); const int Rb = Epi::PERM ? ((R & ~31) + perm32(R & 31)) : R;
        voffA[i] = (unsigned)(R * g.lda + C) * 2u; voffB[i] = (unsigned)((Rb & ((1 << g.bs_log2) - 1)) * g.ldb + (Rb >> g.bs_log2) * g.ldb_hi + C) * 2u; }
    const size_t kstep = (size_t)(BK * 2);
    const size_t hstepA = (size_t)HALF * g.lda * 2, hstepB = (size_t)g.hsB * 2;
    const unsigned ldsw = (unsigned)wid * 1024u;
    const int aoff = lds_byte(wr * 64 + fr, fq * 8), boff = lds_byte(wc * 32 + fr, fq * 8);
#define PG8_SA(b, h) (((b) * 2 + (h)) * HTB)
#define PG8_SB(b, h) ((4 + (b) * 2 + (h)) * HTB)
#if GLDS_SADDR
    const unsigned lds0 = (unsigned)(uintptr_t)lds + ldsw;
#define PG8_STAGE(bufoff, gbase, voff) do { _Pragma("unroll") for (int _i = 0; _i < 2; ++_i) { unsigned keep_; \
        asm volatile("s_mov_b32 %0, m0\n\ts_mov_b32 m0, %3\n\ts_nop 0\n\tglobal_load_lds_dwordx4 %1, %2\n\ts_mov_b32 m0, %0" : "=&s"(keep_) : "v"((voff)[_i]), "s"((const char*)(gbase)), "s"((unsigned)__builtin_amdgcn_readfirstlane((int)(lds0 + (unsigned)(bufoff) + (unsigned)(_i * 8192)))) : "memory"); } } while (0)
#else
#define PG8_STAGE(bufoff, gbase, voff) do { _Pragma("unroll") for (int _i = 0; _i < 2; ++_i) \
        __builtin_amdgcn_global_load_lds((const unsigned*)((const char*)(gbase) + (voff)[_i]), (PG8_LAS unsigned*)(lds + (bufoff) + ldsw + _i * 8192), 16, 0, 0); } while (0)
#endif
#define PG8_LDA(dst, b, h) do { _Pragma("unroll") for (int m = 0; m < 4; ++m) _Pragma("unroll") for (int k = 0; k < 2; ++k) dst[m][k] = *(const PG8_LAS bf16x8*)(lds + PG8_SA(b, h) + aoff + m * 2048 + k * 1024); } while (0)
#define PG8_LDB(dst, b, h) do { _Pragma("unroll") for (int n = 0; n < 2; ++n) _Pragma("unroll") for (int k = 0; k < 2; ++k) dst[n][k] = *(const PG8_LAS bf16x8*)(lds + PG8_SB(b, h) + boff + n * 2048 + k * 1024); } while (0)
#define PG8_MMA(ai, bj, At, Bt) do { __builtin_amdgcn_s_setprio(1); _Pragma("unroll") for (int m = 0; m < 4; ++m) _Pragma("unroll") for (int n = 0; n < 2; ++n) _Pragma("unroll") for (int k = 0; k < 2; ++k) \
        acc[ai][bj][m][n] = __builtin_amdgcn_mfma_f32_16x16x32_bf16(Bt[n][k], At[m][k], acc[ai][bj][m][n], 0, 0, 0); __builtin_amdgcn_s_setprio(0); } while (0)
#define PG8_WAIT_V(n) asm volatile("s_waitcnt vmcnt(" #n ")" ::: "memory")
#define PG8_WAIT_L(n) asm volatile("s_waitcnt lgkmcnt(" #n ")" ::: "memory")
#define PG8_BAR __builtin_amdgcn_s_barrier()
#define PG8_SCHED __builtin_amdgcn_sched_barrier(0)
    Unit cur, nxt; int ui = 0;
    if (!S.next(0, cur)) return;
    if (cur.nt) nt = cur.nt;
    unsigned long long tp_acc = 0, tp_t0 = 0; if (TPROBE) tp_t0 = __builtin_amdgcn_s_memrealtime();
    f32x4 acc[2][2][4][2];
#pragma unroll
    for (int a = 0; a < 2; ++a)
#pragma unroll
        for (int b = 0; b < 2; ++b)
#pragma unroll
            for (int m = 0; m < 4; ++m)
#pragma unroll
                for (int n = 0; n < 2; ++n) acc[a][b][m][n] = (f32x4){0.f, 0.f, 0.f, 0.f};
    bf16x8 At[4][2], B0[2][2], B1[2][2];
    const char* cA = cur.a; const char* cB = cur.b;
    if constexpr (SP2) {
        PG8_STAGE(PG8_SB(0, 0), cB, voffB); PG8_STAGE(PG8_SB(0, 1), cB + hstepB, voffB); PG8_STAGE(PG8_SA(0, 0), cA, voffA); PG8_STAGE(PG8_SA(0, 1), cA + hstepA, voffA);
        if (wr == 1) PG8_BAR;
        PG8_WAIT_V(2); PG8_BAR;
        PG8_STAGE(PG8_SB(1, 0), cB + kstep, voffB); PG8_STAGE(PG8_SA(1, 0), cA + kstep, voffA); PG8_STAGE(PG8_SB(1, 1), cB + hstepB + kstep, voffB);
        PG8_WAIT_V(6); PG8_BAR;
    } else {
        PG8_STAGE(PG8_SB(0, 0), cB, voffB); PG8_STAGE(PG8_SA(0, 0), cA, voffA); PG8_STAGE(PG8_SB(0, 1), cB + hstepB, voffB); PG8_STAGE(PG8_SA(0, 1), cA + hstepA, voffA);
        if (wr == 1) PG8_BAR;
        PG8_WAIT_V(4); PG8_BAR;
        PG8_STAGE(PG8_SB(1, 0), cB + kstep, voffB); PG8_STAGE(PG8_SA(1, 0), cA + kstep, voffA); PG8_STAGE(PG8_SB(1, 1), cB + hstepB + kstep, voffB);
        PG8_WAIT_V(6); PG8_BAR;
    }
    for (;;) {
        const bool has_next = S.next(ui + 1, nxt);
        const char* nA = has_next ? nxt.a : cA; const char* nB = has_next ? nxt.b : cB;
        for (int t = 0; t < nt; t += 2) {
            const bool last = (t == nt - 2);
            const char* a1; const char* a2; const char* b2;
            if constexpr (KCH) { const int t2_ = t + 2, tc_ = t2_ >> g.kcl2, tr_ = t2_ & ((1 << g.kcl2) - 1);
                a1 = cA + (size_t)(t >> g.kcl2) * g.acs + (size_t)((t & ((1 << g.kcl2) - 1)) + 1) * kstep;
                a2 = last ? nA : cA + (size_t)tc_ * g.acs + (size_t)tr_ * kstep; b2 = last ? nB : cB + (size_t)tc_ * g.bcs + (size_t)tr_ * kstep;
            } else { a1 = cA + (size_t)(t + 1) * kstep; a2 = last ? nA : cA + (size_t)(t + 2) * kstep; b2 = last ? nB : cB + (size_t)(t + 2) * kstep; }
            const char* a3 = a2 + kstep; const char* b3 = b2 + kstep;
            if constexpr (SP2) {
            PG8_LDB(B0, 0, 0); PG8_LDB(B1, 0, 1); PG8_SCHED; PG8_LDA(At, 0, 0); PG8_STAGE(PG8_SA(1, 1), a1 + hstepA, voffA);
            PG8_WAIT_V(8); PG8_WAIT_L(0); PG8_BAR; PG8_MMA(0, 0, At, B0); PG8_MMA(0, 1, At, B1); PG8_BAR; PG8_SCHED;
            PG8_LDA(At, 0, 1); PG8_STAGE(PG8_SB(0, 0), b2, voffB); PG8_STAGE(PG8_SB(0, 1), b2 + hstepB, voffB); PG8_STAGE(PG8_SA(0, 0), a2, voffA);
            PG8_WAIT_V(8); PG8_WAIT_L(0); PG8_BAR; if (cur.kind < 2) { PG8_MMA(1, 0, At, B0); PG8_MMA(1, 1, At, B1); } PG8_BAR; PG8_SCHED;
            PG8_LDB(B0, 1, 0); PG8_LDB(B1, 1, 1); PG8_SCHED; PG8_LDA(At, 1, 0); PG8_STAGE(PG8_SA(0, 1), a2 + hstepA, voffA);
            PG8_WAIT_V(8); PG8_WAIT_L(0); PG8_BAR; PG8_MMA(0, 0, At, B0); PG8_MMA(0, 1, At, B1); PG8_BAR; PG8_SCHED;
            PG8_LDA(At, 1, 1); PG8_STAGE(PG8_SB(1, 0), b3, voffB); PG8_STAGE(PG8_SB(1, 1), b3 + hstepB, voffB); PG8_STAGE(PG8_SA(1, 0), a3, voffA);
            PG8_WAIT_V(8); PG8_WAIT_L(0); PG8_BAR; if (cur.kind < 2) { PG8_MMA(1, 0, At, B0); PG8_MMA(1, 1, At, B1); } PG8_BAR; PG8_SCHED;
            } else {
            PG8_LDB(B0, 0, 0); PG8_SCHED; PG8_LDA(At, 0, 0); PG8_STAGE(PG8_SA(1, 1), a1 + hstepA, voffA);
            PG8_WAIT_L(8); PG8_BAR; PG8_WAIT_L(0); PG8_MMA(0, 0, At, B0); PG8_BAR; PG8_SCHED;
            PG8_LDB(B1, 0, 1); PG8_STAGE(PG8_SB(0, 0), b2, voffB);
            PG8_BAR; PG8_WAIT_L(0); PG8_MMA(0, 1, At, B1); PG8_BAR;
            PG8_LDA(At, 0, 1); PG8_STAGE(PG8_SA(0, 0), a2, voffA);
            PG8_BAR; PG8_WAIT_L(0); PG8_MMA(1, 0, At, B0); PG8_BAR; PG8_SCHED;
            PG8_STAGE(PG8_SB(0, 1), b2 + hstepB, voffB);
            PG8_WAIT_V(6); PG8_BAR; PG8_MMA(1, 1, At, B1); PG8_BAR;
            PG8_LDB(B0, 1, 0); PG8_SCHED; PG8_LDA(At, 1, 0); PG8_STAGE(PG8_SA(0, 1), a2 + hstepA, voffA);
            PG8_WAIT_L(8); PG8_BAR; PG8_WAIT_L(0); PG8_MMA(0, 0, At, B0); PG8_BAR; PG8_SCHED;
            PG8_LDB(B1, 1, 1); PG8_STAGE(PG8_SB(1, 0), b3, voffB);
            PG8_BAR; PG8_WAIT_L(0); PG8_MMA(0, 1, At, B1); PG8_BAR;
            PG8_LDA(At, 1, 1); PG8_STAGE(PG8_SA(1, 0), a3, voffA);
            PG8_BAR; PG8_WAIT_L(0); PG8_MMA(1, 0, At, B0); PG8_BAR; PG8_SCHED;
            PG8_STAGE(PG8_SB(1, 1), b3 + hstepB, voffB);
            PG8_WAIT_V(6); PG8_BAR; PG8_MMA(1, 1, At, B1); PG8_BAR;
            }
        }
        if (TPROBE == 2) { const unsigned long long t_ = __builtin_amdgcn_s_memrealtime(); tp_acc += t_ - tp_t0; }
        if (TPROBE == 1) tp_t0 = __builtin_amdgcn_s_memrealtime();
        if constexpr (ALIGN_EPI) { if (wr == 0) PG8_BAR; }
        E(acc, cur, wr, wc, fr, fq);
        if (!has_next) { if (TPROBE == 1) { const unsigned long long t_ = __builtin_amdgcn_s_memrealtime(); tp_acc += t_ - tp_t0; } break; }
#pragma unroll
        for (int a = 0; a < 2; ++a)
#pragma unroll
            for (int b = 0; b < 2; ++b)
#pragma unroll
                for (int m = 0; m < 4; ++m)
#pragma unroll
                    for (int n = 0; n < 2; ++n) acc[a][b][m][n] = (f32x4){0.f, 0.f, 0.f, 0.f};
        cur = nxt; cA = nA; cB = nB; ++ui; nt = cur.nt ? cur.nt : K / BK;
        if constexpr (ALIGN_EPI) { if (wr == 1) PG8_BAR; }
        if (TPROBE == 1) { const unsigned long long t_ = __builtin_amdgcn_s_memrealtime(); tp_acc += t_ - tp_t0; }
        if (TPROBE == 2) tp_t0 = __builtin_amdgcn_s_memrealtime();
    }
    PG8_WAIT_V(0);
    if constexpr (!ALIGN_EPI) { if (wr == 0) PG8_BAR; }
    PG8_BAR;
    if (TPROBE) { if (wid == 0) { const unsigned long long t1_ = __builtin_amdgcn_s_memrealtime(); while (__builtin_amdgcn_s_memrealtime() - t1_ < tp_acc) __builtin_amdgcn_s_sleep(8); } PG8_BAR; }
#undef PG8_SA
#undef PG8_SB
#undef PG8_STAGE
#undef PG8_LDA
#undef PG8_LDB
#undef PG8_MMA
#undef PG8_WAIT_V
#undef PG8_WAIT_L
#undef PG8_BAR
#undef PG8_SCHED
}
}
namespace pg8 {
__device__ __forceinline__ int bsel_of(int pm) { return pm < 32 ? 0 : (pm < 64 ? 1 : 2); }

template <int ACT, bool SSQ, bool FUSED = false> struct EpiBf16 {
    static constexpr bool PERM = true;
    bf16_t* O; int ldc; float* ssq; int ssq_pn0; const float* nssq; const float* nsw; int nswN;
    __device__ __forceinline__ void operator()(const f32x4 (&acc)[2][2][4][2], const Unit& u, int wr, int wc, int fr, int fq) const {
        bf16_t* base = O + u.o + (size_t)(wr * 64 + fr) * ldc + wc * 32 + 8 * fq;
        const bool do_ssq = SSQ && (u.pn >= ssq_pn0);
        f32x4 swv[2][2];
        if (FUSED) { const float* sp = nsw + (size_t)bsel_of(u.pm) * nswN + u.pn * BM + wc * 32 + 8 * fq;
#pragma unroll
            for (int bj = 0; bj < 2; ++bj) { swv[bj][0] = *(const f32x4*)(sp + bj * HALF); swv[bj][1] = *(const f32x4*)(sp + bj * HALF + 4); } }
#pragma unroll
        for (int ai = 0; ai < 2; ++ai) { if (ai == 1 && u.kind >= 2) break;
#pragma unroll
            for (int m = 0; m < 4; ++m) { bf16_t* rowp = base + (size_t)(ai * HALF + m * 16) * ldc; float s = 0.f;
                float rr = 1.f; if (FUSED) rr = __builtin_amdgcn_rsqf(nssq[u.pm * BM + (u.kind == 3 ? HALF : 0) + ai * HALF + wr * 64 + m * 16 + fr] * (1.0f / D) + EPS);
#pragma unroll
                for (int bj = 0; bj < 2; ++bj) { f32x4 v0 = acc[ai][bj][m][0], v1 = acc[ai][bj][m][1];
                    if (FUSED) { v0 = v0 * rr + swv[bj][0]; v1 = v1 * rr + swv[bj][1]; }
                    if (ACT == 1) { f32x2 a = gelu_pk((f32x2){v0[0], v0[1]}), b = gelu_pk((f32x2){v0[2], v0[3]}), c = gelu_pk((f32x2){v1[0], v1[1]}), d = gelu_pk((f32x2){v1[2], v1[3]});
                        v0 = (f32x4){a.x, a.y, b.x, b.y}; v1 = (f32x4){c.x, c.y, d.x, d.y}; }
                    if (SSQ) s += (v0[0] * v0[0] + v0[1] * v0[1]) + (v0[2] * v0[2] + v0[3] * v0[3]) + (v1[0] * v1[0] + v1[1] * v1[1]) + (v1[2] * v1[2] + v1[3] * v1[3]);
                    u32x4 w; w.x = cvt_pk_bf16(v0[0], v0[1]); w.y = cvt_pk_bf16(v0[2], v0[3]); w.z = cvt_pk_bf16(v1[0], v1[1]); w.w = cvt_pk_bf16(v1[2], v1[3]);
                    *(u32x4*)(rowp + bj * HALF) = w; }
                if (SSQ) { if (do_ssq) { s += __shfl_xor(s, 16); s += __shfl_xor(s, 32);
                    if (fq == 0) atomicAdd(ssq + u.pm * BM + (u.kind == 3 ? HALF : 0) + ai * HALF + wr * 64 + m * 16 + fr, s); } }
            } }
    }
};

template <bool NEXT, class TIN, class TOUT> struct EpiRes {
    static constexpr bool PERM = true;
    const TIN* rin; TOUT* rout; const float* gmx; const float* gb;
    bf16_t* hq; const float* ng; const float* nmx; const float* nb; float* nssq;
    __device__ __forceinline__ void operator()(const f32x4 (&acc)[2][2][4][2], const Unit& u, int wr, int wc, int fr, int fq) const {
        const int bs = bsel_of(u.pm); const int col0 = u.pn * BM + wc * 32 + 8 * fq;
        f32x4 gv[2][2], gn[2][2];
#pragma unroll
        for (int bj = 0; bj < 2; ++bj)
#pragma unroll
            for (int n = 0; n < 2; ++n) { const int cc = col0 + bj * HALF + n * 4; gv[bj][n] = *(const f32x4*)(gmx + bs * NADA + cc) + *(const f32x4*)(gb + cc);
                if (NEXT) gn[bj][n] = *(const f32x4*)(ng + cc) * (*(const f32x4*)(nmx + bs * NADA + cc) + *(const f32x4*)(nb + cc) + 1.0f); }
        f32x4 xr[2][2][2];
#define ER_LOAD(g) do { const size_t off_ = (size_t)(u.pm * BM + ((g) >> 2) * HALF + wr * 64 + ((g) & 3) * 16 + fr) * D + col0; \
            _Pragma("unroll") for (int bj = 0; bj < 2; ++bj) ld8(rin + off_ + bj * HALF, xr[(g) & 1][bj][0], xr[(g) & 1][bj][1]); } while (0)
        ER_LOAD(0);
#pragma unroll
        for (int g = 0; g < 8; ++g) { const int ai = g >> 2, m = g & 3;
            if (g + 1 < 8) ER_LOAD(g + 1);
            const int row = u.pm * BM + ai * HALF + wr * 64 + m * 16 + fr; const size_t off = (size_t)row * D + col0; float s = 0.f;
#pragma unroll
            for (int bj = 0; bj < 2; ++bj) { const f32x4 o0 = xr[g & 1][bj][0] + gv[bj][0] * acc[ai][bj][m][0], o1 = xr[g & 1][bj][1] + gv[bj][1] * acc[ai][bj][m][1];
                st8(rout + off + bj * HALF, o0, o1);
                if (NEXT) { s += (o0[0] * o0[0] + o0[1] * o0[1]) + (o0[2] * o0[2] + o0[3] * o0[3]) + (o1[0] * o1[0] + o1[1] * o1[1]) + (o1[2] * o1[2] + o1[3] * o1[3]);
                    const f32x4 h0 = o0 * gn[bj][0], h1 = o1 * gn[bj][1]; u32x4 w; w.x = cvt_pk_bf16(h0[0], h0[1]); w.y = cvt_pk_bf16(h0[2], h0[3]); w.z = cvt_pk_bf16(h1[0], h1[1]); w.w = cvt_pk_bf16(h1[2], h1[3]);
                    *(u32x4*)(hq + off + bj * HALF) = w; } }
            if (NEXT) { s += __shfl_xor(s, 16); s += __shfl_xor(s, 32); if (fq == 0) atomicAdd(nssq + row, s); }
            asm volatile("" ::: "memory"); }
#undef ER_LOAD
    }
};

template <bool FUSED> struct EpiSwiGLU {
    static constexpr bool PERM = true;
    bf16_t* G; int ldg; const float* nssq; const float* nsw;
    __device__ __forceinline__ void operator()(const f32x4 (&acc)[2][2][4][2], const Unit& u, int wr, int wc, int fr, int fq) const {
        bf16_t* base = G + u.o + (size_t)(wr * 64 + fr) * ldg + wc * 32 + 8 * fq;
        f32x4 swv[2][2];
        if (FUSED) { const float* sp = nsw + (size_t)bsel_of(u.pm) * (2 * DFF) + u.pn * BM + wc * 32 + 8 * fq;
#pragma unroll
            for (int bj = 0; bj < 2; ++bj) { swv[bj][0] = *(const f32x4*)(sp + bj * HALF); swv[bj][1] = *(const f32x4*)(sp + bj * HALF + 4); } }
#pragma unroll
        for (int ai = 0; ai < 2; ++ai) { if (ai == 1 && u.kind >= 2) break;
#pragma unroll
            for (int m = 0; m < 4; ++m) { bf16_t* rowp = base + (size_t)(ai * HALF + m * 16) * ldg;
                float rr = 1.f; if (FUSED) rr = __builtin_amdgcn_rsqf(nssq[u.pm * BM + (u.kind == 3 ? HALF : 0) + ai * HALF + wr * 64 + m * 16 + fr] * (1.0f / D) + EPS);
                u32x4 w;
#pragma unroll
                for (int bj = 0; bj < 2; ++bj) { f32x4 g = acc[ai][bj][m][0], up = acc[ai][bj][m][1]; f32x4 o;
                    if (FUSED) { g = g * rr + swv[bj][0]; up = up * rr + swv[bj][1]; }
#pragma unroll
                    for (int e = 0; e < 4; ++e) { const float sg = __builtin_amdgcn_rcpf(1.f + __builtin_amdgcn_exp2f(-1.4426950408889634f * g[e])); o[e] = g[e] * sg * up[e]; }
                    w[2 * bj] = cvt_pk_bf16(o[0], o[1]); w[2 * bj + 1] = cvt_pk_bf16(o[2], o[3]); }
                *(u32x4*)rowp = w; } }
    }
};

struct EpiF1 {
    static constexpr bool PERM = true;
    bf16_t* O;
    __device__ __forceinline__ void operator()(const f32x4 (&acc)[2][2][4][2], const Unit& u, int wr, int wc, int fr, int fq) const {
        bf16_t* base = O + u.o + (size_t)(wr * 64 + fr) * 256 + (size_t)(wc >> 1) * 262144 + 32 * (wc & 1) + 8 * fq;
#pragma unroll
        for (int ai = 0; ai < 2; ++ai)
#pragma unroll
            for (int m = 0; m < 4; ++m)
#pragma unroll
                for (int bj = 0; bj < 2; ++bj) { const f32x4 v0 = acc[ai][bj][m][0], v1 = acc[ai][bj][m][1];
                    u32x4 w; w.x = cvt_pk_bf16(v0[0], v0[1]); w.y = cvt_pk_bf16(v0[2], v0[3]); w.z = cvt_pk_bf16(v1[0], v1[1]); w.w = cvt_pk_bf16(v1[2], v1[3]);
                    *(u32x4*)(base + (size_t)(ai * HALF + m * 16) * 256 + (size_t)bj * 2 * 262144) = w; }
    }
};
struct EpiFA {
    static constexpr bool PERM = true;
    bf16_t* O;
    __device__ __forceinline__ void operator()(const f32x4 (&acc)[2][2][4][2], const Unit& u, int wr, int wc, int fr, int fq) const {
        const int t20 = 32 * wc + 8 * fq;
        bf16_t* base = O + u.o + (size_t)wr * 256 + t20;
#pragma unroll
        for (int m = 0; m < 4; ++m) { int k1 = 16 * m + fr; asm volatile("" : "+v"(k1));     u32x4 wre[2], wim[2];
#pragma unroll
            for (int e2 = 0; e2 < 4; ++e2) { float cs[2], sn[2];
#pragma unroll
                for (int q = 0; q < 2; ++q) { const float fr_ = (float)((k1 * (t20 + 2 * e2 + q)) & 8191) * (1.0f / 8192.0f); cs[q] = __builtin_amdgcn_cosf(fr_); sn[q] = __builtin_amdgcn_sinf(fr_); }
#pragma unroll
                for (int bj = 0; bj < 2; ++bj) { float zr[2], zi[2];
#pragma unroll
                    for (int q = 0; q < 2; ++q) { const int e = 2 * e2 + q; const float a = acc[0][bj][m][e >> 2][e & 3], b = acc[1][bj][m][e >> 2][e & 3];
                        zr[q] = a * cs[q] + b * sn[q]; zi[q] = b * cs[q] - a * sn[q]; }
                    wre[bj][e2] = cvt_pk_bf16(zr[0], zr[1]); wim[bj][e2] = cvt_pk_bf16(zi[0], zi[1]); }
                __builtin_amdgcn_sched_barrier(0); }
#pragma unroll
            for (int bj = 0; bj < 2; ++bj) { bf16_t* p = base + (size_t)k1 * 524288 + (size_t)bj * 512; *(u32x4*)p = wre[bj]; *(u32x4*)(p + 128) = wim[bj]; } }
    }
};
struct EpiFB {
    static constexpr bool PERM = true;
    bf16_t* O;
    __device__ __forceinline__ void operator()(const f32x4 (&acc)[2][2][4][2], const Unit& u, int wr, int wc, int fr, int fq) const {
        bf16_t* base = O + u.o + (size_t)(64 * wr + fr) * (64 * D) + wc * 32 + 8 * fq;
#pragma unroll
        for (int ai = 0; ai < 2; ++ai)
#pragma unroll
            for (int m = 0; m < 4; ++m)
#pragma unroll
                for (int bj = 0; bj < 2; ++bj) { const f32x4 v0 = acc[ai][bj][m][0], v1 = acc[ai][bj][m][1];
                    u32x4 w; w.x = cvt_pk_bf16(v0[0], v0[1]); w.y = cvt_pk_bf16(v0[2], v0[3]); w.z = cvt_pk_bf16(v1[0], v1[1]); w.w = cvt_pk_bf16(v1[2], v1[3]);
                    *(u32x4*)(base + (size_t)(16 * m) * (64 * D) + ai * 1024 + bj * HALF) = w; }
    }
};

struct EpiSlab {
    static constexpr bool PERM = true;
    slab_t* O; int ldc;
    __device__ __forceinline__ void operator()(const f32x4 (&acc)[2][2][4][2], const Unit& u, int wr, int wc, int fr, int fq) const {
        slab_t* base = O + u.o + (size_t)(wr * 64 + fr) * ldc + wc * 32 + 8 * fq;
#pragma unroll
        for (int ai = 0; ai < 2; ++ai)
#pragma unroll
            for (int m = 0; m < 4; ++m) { slab_t* rowp = base + (size_t)(ai * HALF + m * 16) * ldc;
#pragma unroll
                for (int bj = 0; bj < 2; ++bj) st8(rowp + bj * HALF, acc[ai][bj][m][0], acc[ai][bj][m][1]); }
    }
};
struct SchedSK {
    const char* A; const char* B; int lda, ldb, ns, nN, pn0, N, G, c; size_t aks, bks;
    __device__ __forceinline__ bool next(int i, Unit& u) const {
        const int L = i * G + c; if (L >= ns * 2 * nN) return false;
        const int s = L % ns, t = L / ns, pmc = t & 1, pn = pn0 + (t >> 1);
        u.a = A + (size_t)(ML + pmc * 256) * lda * 2 + (size_t)s * aks; u.b = B + (size_t)pn * 256 * ldb * 2 + (size_t)s * bks;
        u.o = ((long)s * MC + pmc * 256) * N + pn * 256; u.pm = 64 + pmc; u.pn = pn; u.nt = 0; u.kind = 0; return true;
    }
};

template <class EA, class EB> struct Epi2 {
    static constexpr bool PERM = EA::PERM; static_assert(EA::PERM == EB::PERM, "Epi2: layouts differ");
    EA ea; EB eb;
    __device__ __forceinline__ void operator()(const f32x4 (&acc)[2][2][4][2], const Unit& u, int wr, int wc, int fr, int fq) const { if (u.kind) eb(acc, u, wr, wc, fr, fq); else ea(acc, u, wr, wc, fr, fq); }
};
template <class SA  , class SB  > struct SchedMix {
    SA lat; SB sk; int nt_sk; bool has;
    __device__ __forceinline__ bool next(int i, Unit& u) const {
        if (has) { if (i == SK_POS) { sk.next(0, u); u.nt = nt_sk; u.kind = 1; return true; } return lat.next(i < SK_POS ? i : i - 1, u); }
        return lat.next(i, u);
    }
};

struct SchedRC {
    const char* A; const char* B; size_t atile, btile; long ldo, ocs; int ow, nM, nN, G, c, wgm, ocl2, pm0, pmsplit, pmjump, pnflip;
    __device__ __forceinline__ bool next(int i, Unit& u) const {
        const long L = (long)i * G + c; if (L >= (long)nM * nN) return false;
        int pm, pn; tile_of((int)L, nM, nN, pm, pn, wgm); pm += pm0 + (pm >= pmsplit ? pmjump : 0); if (pnflip) pn = nN - 1 - pn;
        u.a = A + (size_t)pm * atile; u.b = B + (size_t)pn * btile; u.o = (long)(pn >> ocl2) * ocs + (long)pm * BM * ldo + (long)(pn & ((1 << ocl2) - 1)) * ow; u.pm = pm; u.pn = pn; u.nt = 0; u.kind = 0; return true;
    }
};
struct SchedHalf {
    const char* A; const char* B; size_t btile; long ldo; int lda, ow, nN, nH, row0, G, c;
    __device__ __forceinline__ bool next(int i, Unit& u) const {
        const int L = i * G + c; if (L >= 4 * nN) return false;
        const int hp = L & 3, pn = L >> 2, r = row0 + 128 * hp;
        u.a = A + (size_t)r * lda * 2; u.b = B + (size_t)pn * btile; u.o = (long)r * ldo + (long)pn * ow; u.pm = r / BM; u.pn = pn; u.nt = 0; u.kind = 2 + ((r / HALF) & 1); return true;
    }
};
__device__ __forceinline__ SchedRC make_rc(const bf16_t* A, int lda, const bf16_t* B, int ldb, int nM, int nN, long ldo, int ow, int G, int c, int wgm = WGM) {
    SchedRC s; s.pnflip = 0; s.wgm = wgm; s.ocl2 = 24; s.ocs = 0; s.pm0 = 0; s.pmsplit = 1 << 20; s.pmjump = 0; s.A = (const char*)A; s.B = (const char*)B; s.atile = (size_t)BM * lda * 2; s.btile = (size_t)BM * ldb * 2; s.ldo = ldo; s.ow = ow; s.nM = nM; s.nN = nN; s.G = G; s.c = c; return s;
}
}
typedef GAS unsigned gu32;
#define RLX_AGENT __ATOMIC_RELAXED, __HIP_MEMORY_SCOPE_AGENT
#define XB_TMO      128
#define XB_XCNT(j)  (256  + 64 * (j))
#define XB_XSUB(j)  (1280 + 64 * (j))
#define XB_XGEN(j)  (2304 + 64 * (j))
#define XB_TOP      3328
#define XB_TOPGEN   3392
#define XCD_BAR_WORDS 3456
#define XB_SPIN_CAP (1u << 18)
__device__ __forceinline__ unsigned xb_ld(unsigned* p)              { return __hip_atomic_load(p, __ATOMIC_RELAXED, __HIP_MEMORY_SCOPE_AGENT); }
__device__ __forceinline__ unsigned xb_add(unsigned* p, unsigned v) { return __hip_atomic_fetch_add(p, v, __ATOMIC_RELAXED, __HIP_MEMORY_SCOPE_AGENT); }
__device__ __forceinline__ unsigned xb_xcc_id() { return (unsigned)__builtin_amdgcn_s_getreg((3 << 11) | 20) & 0xFu; }
#define XB_SPIN(cond, bar) do { unsigned _sp = 0; while (cond) { __builtin_amdgcn_s_sleep(1); \
    if ((++_sp & 255u) == 0u) { if (xb_ld(&(bar)[XB_TMO])) break; if (_sp > XB_SPIN_CAP) { atomicAdd(&(bar)[XB_TMO], 1u); break; } } } } while (0)
struct XcdBarrier { unsigned* bar; unsigned x; volatile LAS unsigned* st; };
__device__ __forceinline__ XcdBarrier xcd_barrier_post(unsigned* bar, volatile LAS unsigned* st) {
    XcdBarrier b; b.bar = bar; b.x = xb_xcc_id(); b.st = st;
    if (threadIdx.x == 0) (void)xb_add(&bar[XB_XCNT(b.x)], 1u);
    return b;
}
__device__ __forceinline__ void xcd_barrier_complete(unsigned* bar, unsigned x, unsigned& nloc, unsigned& nx) {
    const unsigned G = gridDim.x * gridDim.y * gridDim.z;
    unsigned sum, cnt, mine, sp = 0u;
    for (;;) {
        sum = 0u; cnt = 0u; mine = 0u;
#pragma unroll
        for (unsigned j = 0; j < 16; ++j) { const unsigned c = xb_ld(&bar[XB_XCNT(j)]); sum += c; cnt += (c > 0u) ? 1u : 0u; mine = (j == x) ? c : mine; }
        if (sum == G) break;
        __builtin_amdgcn_s_sleep(1);
        if ((++sp & 255u) == 0u) { if (xb_ld(&bar[XB_TMO])) break; if (sp > XB_SPIN_CAP) { atomicAdd(&bar[XB_TMO], 1u); break; } }
    }
    nloc = mine > 0u ? mine : 1u; nx = cnt > 0u ? cnt : 1u;
}
__device__ __forceinline__ void xcd_barrier(const XcdBarrier& b) {
    asm volatile("s_waitcnt vmcnt(0)" ::: "memory");
    __syncthreads();
    if (threadIdx.x == 0) {
        unsigned* bar = b.bar;
        __builtin_amdgcn_s_waitcnt(0);
        unsigned nloc = b.st[0], nx = b.st[1];
        if (nloc == 0u) { xcd_barrier_complete(bar, b.x, nloc, nx); b.st[0] = nloc; b.st[1] = nx; }
        const unsigned old = xb_add(&bar[XB_XSUB(b.x)], 1u);
        const unsigned gen = old / nloc;
        if (old + 1u == (gen + 1u) * nloc) {
            __builtin_amdgcn_fence(__ATOMIC_RELEASE, "agent");
            asm volatile("s_waitcnt vmcnt(0)" ::: "memory");
            const unsigned og = xb_add(&bar[XB_TOP], 1u);
            const unsigned tg = og / nx;
            if (og + 1u == (tg + 1u) * nx) xb_add(&bar[XB_TOPGEN], 1u);
            else XB_SPIN(xb_ld(&bar[XB_TOPGEN]) == tg, bar);
            __builtin_amdgcn_fence(__ATOMIC_ACQUIRE, "agent");
            xb_add(&bar[XB_XGEN(b.x)], 1u);
            asm volatile("s_waitcnt vmcnt(0)" ::: "memory");
        } else {
            XB_SPIN(xb_ld(&bar[XB_XGEN(b.x)]) == gen, bar);
            __builtin_amdgcn_fence(__ATOMIC_ACQUIRE, "agent");
            asm volatile("s_waitcnt vmcnt(0)" ::: "memory");
        }
    }
    __syncthreads();
}
#define LDS_WAIT() asm volatile("s_waitcnt lgkmcnt(0)" ::: "memory")
#define VM_WAIT() asm volatile("s_waitcnt vmcnt(0)" ::: "memory")
__device__ __forceinline__ float wave_sum(float v) {
#pragma unroll
    for (int o = 1; o < 64; o <<= 1) v += __shfl_xor(v, o);
    return v;
}
__device__ __forceinline__ float silu_f(float x) { return x / (1.f + __expf(-x)); }

template <class TX> __device__ __forceinline__ void modnorm_phase(const TX* xlat, const TX* xctx, xr_t* xr_out, bf16* H, const float* g, const float* mxl, const float* bl,
                                              int which, int nrows, int gw, int NGW, int lane, const slab_t* fin_slab = nullptr, int fin_ns = 0, const float* fin_gmx = nullptr, const float* fin_gb = nullptr, xr_t* fin_xr = nullptr) {
    asm volatile("" : "+v"(lane));
    int cur_bs = -1; f32x4 gs[8], sh[8];
    const int csh = (which * 3) * D, csc = (which * 3 + 1) * D;
    int row = gw;
    if (row < ML) {
        f32x4 v[8], vn[8];
#pragma unroll
        for (int j = 0; j < 8; ++j) v[j] = ld4(xlat + (size_t)row * D + 4 * lane + 256 * j);
        for (; row < ML; row += NGW) {
            const int nrow = row + NGW;
            if (nrow < ML) {
#pragma unroll
                for (int j = 0; j < 8; ++j) vn[j] = ld4(xlat + (size_t)nrow * D + 4 * lane + 256 * j);
            }
            const int bs = row < SEQ ? 0 : 1;
            if (bs != cur_bs) {
#pragma unroll
                for (int j = 0; j < 8; ++j) { const int col = 4 * lane + 256 * j;
                    const f32x4 gg = *(const f32x4*)(g + col);
                    const f32x4 sc = *(const f32x4*)(mxl + bs * NADA + csc + col) + *(const f32x4*)(bl + csc + col);
                    sh[j] = *(const f32x4*)(mxl + bs * NADA + csh + col) + *(const f32x4*)(bl + csh + col);
                    gs[j] = gg * (sc + 1.0f); }
                cur_bs = bs;
            }
            float s = 0.f;
#pragma unroll
            for (int j = 0; j < 8; ++j) s += (v[j].x * v[j].x + v[j].y * v[j].y) + (v[j].z * v[j].z + v[j].w * v[j].w);
            const float r = 1.0f / sqrtf(wave_sum(s) * (1.0f / D) + EPS);
            bf16* hrow = H + (size_t)row * D;
#pragma unroll
            for (int j = 0; j < 8; ++j) { const f32x4 o = v[j] * r * gs[j] + sh[j]; u32x2 w; w.x = cvt_pk_bf16(o.x, o.y); w.y = cvt_pk_bf16(o.z, o.w);
                *(u32x2*)(hrow + 4 * lane + 256 * j) = w; }
#pragma unroll
            for (int j = 0; j < 8; ++j) v[j] = vn[j];
        }
    }
    for (; row < nrows; row += NGW) {
        const int bs = row < SEQ ? 0 : (row < ML ? 1 : 2);
        if (bs != cur_bs) {
#pragma unroll
            for (int j = 0; j < 8; ++j) { const int col = 4 * lane + 256 * j;
                const f32x4 gg = *(const f32x4*)(g + col);
                const f32x4 sc = *(const f32x4*)(mxl + bs * NADA + csc + col) + *(const f32x4*)(bl + csc + col);
                sh[j] = *(const f32x4*)(mxl + bs * NADA + csh + col) + *(const f32x4*)(bl + csh + col);
                gs[j] = gg * (sc + 1.0f); }
            cur_bs = bs;
        }
        const TX* src = row < ML ? xlat + (size_t)row * D : xctx + (size_t)(row - ML) * D;
        f32x4 v[8]; float s = 0.f;
#pragma unroll
        for (int j = 0; j < 8; ++j) v[j] = ld4(src + 4 * lane + 256 * j);
        if (fin_slab && row >= ML) {
            f32x4 a[8];
#pragma unroll
            for (int j = 0; j < 8; ++j) a[j] = (f32x4){0.f, 0.f, 0.f, 0.f};
            const slab_t* sp = fin_slab + (size_t)(row - ML) * D + 4 * lane;
            for (int sidx = 0; sidx < fin_ns; ++sidx) {
                f32x4 t0[8];
#pragma unroll
                for (int j = 0; j < 8; ++j) t0[j] = ld4(sp + (size_t)sidx * MC * D + 256 * j);
#pragma unroll
                for (int j = 0; j < 8; ++j) a[j] += t0[j];
            }
#pragma unroll
            for (int j = 0; j < 8; ++j) { const int col = 4 * lane + 256 * j;
                const f32x4 gt = *(const f32x4*)(fin_gmx + 2 * NADA + col) + *(const f32x4*)(fin_gb + col);
                v[j] += gt * a[j]; st4(fin_xr + (size_t)row * D + col, v[j]); }
        }
#pragma unroll
        for (int j = 0; j < 8; ++j) s += (v[j].x * v[j].x + v[j].y * v[j].y) + (v[j].z * v[j].z + v[j].w * v[j].w);
        const float r = 1.0f / sqrtf(wave_sum(s) * (1.0f / D) + EPS);
        bf16* hrow = H + (size_t)row * D;
#pragma unroll
        for (int j = 0; j < 8; ++j) { const f32x4 o = v[j] * r * gs[j] + sh[j]; u32x2 w; w.x = cvt_pk_bf16(o.x, o.y); w.y = cvt_pk_bf16(o.z, o.w);
            *(u32x2*)(hrow + 4 * lane + 256 * j) = w; }
        if (xr_out && row >= ML) {
#pragma unroll
            for (int j = 0; j < 8; ++j) st4(xr_out + (size_t)row * D + 4 * lane + 256 * j, v[j]);
        }
    }
}

__device__ __forceinline__ void ctxfin_phase(const slab_t* slab, int ns, const float* gmx, const float* gb, xr_t* XR, bf16* H, const float* ng, const float* nmx, const float* nb, float* nssq, int gw, int NGW, int lane) {
    asm volatile("" : "+v"(lane));
    for (int it = gw; it < MC * 4; it += NGW) { const int r = it >> 2, q = it & 3, row = ML + r, c0 = q * 512 + 4 * lane;
        f32x4 a[2], v[2];
#pragma unroll
        for (int j = 0; j < 2; ++j) { a[j] = (f32x4){0.f, 0.f, 0.f, 0.f}; v[j] = ld4(XR + (size_t)row * D + c0 + 256 * j); }
        const slab_t* sp = slab + (size_t)r * D + c0;
        for (int s0 = 0; s0 < ns; s0 += 4) { f32x4 t0[4][2];
#pragma unroll
            for (int k = 0; k < 4; ++k) { const int sidx = s0 + k < ns ? s0 + k : s0;
#pragma unroll
                for (int j = 0; j < 2; ++j) t0[k][j] = ld4(sp + (size_t)sidx * MC * D + 256 * j); }
#pragma unroll
            for (int k = 0; k < 4; ++k) if (s0 + k < ns) { a[0] += t0[k][0]; a[1] += t0[k][1]; } }
        float s = 0.f;
#pragma unroll
        for (int j = 0; j < 2; ++j) { const int col = c0 + 256 * j;
            const f32x4 gt = *(const f32x4*)(gmx + 2 * NADA + col) + *(const f32x4*)(gb + col);
            v[j] += gt * a[j]; st4(XR + (size_t)row * D + col, v[j]);
            s += (v[j].x * v[j].x + v[j].y * v[j].y) + (v[j].z * v[j].z + v[j].w * v[j].w);
            const f32x4 h = v[j] * (*(const f32x4*)(ng + col) * (*(const f32x4*)(nmx + 2 * NADA + col) + *(const f32x4*)(nb + col) + 1.0f));
            u32x2 w; w.x = cvt_pk_bf16(h.x, h.y); w.y = cvt_pk_bf16(h.z, h.w); *(u32x2*)(H + (size_t)row * D + col) = w; }
        s = wave_sum(s); if (lane == 0) atomicAdd(nssq + row, s);
    }
}

__device__ __forceinline__ void qknorm_rope_phase(bf16* QKV, const float* qg, const float* kg, const f32x2* rope, int nrows, int gw, int NGW, int lane, const slab_t* slab = nullptr, int ns = 0, int ctx_it0 = 0, const float* fssq = nullptr, const float* fsw = nullptr, int row0 = 0) {
    asm volatile("" : "+v"(lane));
    const int hl = lane >> 4, dl = (lane & 15) * 8;
    if (row0 < ML) {
        const f32x4 gq0 = *(const f32x4*)(qg + dl), gq1 = *(const f32x4*)(qg + dl + 4), gk0 = *(const f32x4*)(kg + dl), gk1 = *(const f32x4*)(kg + dl + 4);
        u32x4 cur[5], nxt[5]; f32x4 ccs[4], ncs[4];
        int row = row0 + gw;
#define QK_LOAD(dst, dcs, r_) do { const bf16* rp_ = QKV + (size_t)(r_) * NQKV + hl * HD + dl; _Pragma("unroll") for (int it = 0; it < 5; ++it) dst[it] = *(const u32x4*)(rp_ + it * 4 * HD); \
            const f32x4* cp_ = (const f32x4*)(rope + (size_t)((r_) & (SEQ - 1)) * 64 + (dl & 63)); _Pragma("unroll") for (int e = 0; e < 4; ++e) dcs[e] = cp_[e]; } while (0)
        if (row < ML) QK_LOAD(cur, ccs, row);
        while (row < ML) {
            const int nrow = row + NGW; const bool more = nrow < ML;
            if (more) QK_LOAD(nxt, ncs, nrow);
            bf16* rp = QKV + (size_t)row * NQKV + hl * HD + dl;
#pragma unroll
            for (int it = 0; it < 5; ++it) { float v[8];
#pragma unroll
                for (int e = 0; e < 4; ++e) { v[2 * e] = __uint_as_float(cur[it][e] << 16); v[2 * e + 1] = __uint_as_float(cur[it][e] & 0xffff0000u); }
                float s = 0.f;
#pragma unroll
                for (int e = 0; e < 8; ++e) s += v[e] * v[e];
                s += __shfl_xor(s, 1); s += __shfl_xor(s, 2); s += __shfl_xor(s, 4); s += __shfl_xor(s, 8);
                const float r = __builtin_amdgcn_rsqf(s * (1.0f / HD) + EPS);
                const f32x4 g0 = it < 4 ? gq0 : gk0, g1 = it < 4 ? gq1 : gk1;
#pragma unroll
                for (int e = 0; e < 4; ++e) { v[e] *= r * g0[e]; v[4 + e] *= r * g1[e]; }
                float o[8];
#pragma unroll
                for (int e = 0; e < 8; ++e) { const float pr = __shfl_xor(v[e], 8); const float cc = ccs[e >> 1][(e & 1) * 2], ss = ccs[e >> 1][(e & 1) * 2 + 1]; o[e] = v[e] * cc + ((lane & 8) ? pr : -pr) * ss; }
                u32x4 w; w.x = cvt_pk_bf16(o[0], o[1]); w.y = cvt_pk_bf16(o[2], o[3]); w.z = cvt_pk_bf16(o[4], o[5]); w.w = cvt_pk_bf16(o[6], o[7]);
                *(u32x4*)(rp + it * 4 * HD) = w; }
            if (more) {
#pragma unroll
                for (int it = 0; it < 5; ++it) cur[it] = nxt[it];
#pragma unroll
                for (int e = 0; e < 4; ++e) ccs[e] = ncs[e]; }
            row = nrow;
        }
#undef QK_LOAD
    }
    for (int row = (row0 < ML ? ML : row0) + gw; row < nrows; row += NGW) {
        bf16* rp = QKV + (size_t)row * NQKV;
        const bool lat = row < ML; const int t = row & (SEQ - 1);
        const bool fin = (slab != nullptr) && !lat;
        if (fin) {
            const slab_t* sp = slab + (size_t)(row - ML) * NQKV + HQ + HKV + lane * 8; f32x4 t0[8], t1[8];
#pragma unroll
            for (int sidx = 0; sidx < 8; ++sidx) ld8(sp + (size_t)sidx * MC * NQKV, t0[sidx], t1[sidx]);
            f32x4 a0 = t0[0], a1 = t1[0];
#pragma unroll
            for (int sidx = 1; sidx < 8; ++sidx) { a0 += t0[sidx]; a1 += t1[sidx]; }
            if (fssq) { const float rr = __builtin_amdgcn_rsqf(fssq[row] * (1.0f / D) + EPS); const float* swp = fsw + HQ + HKV + lane * 8; a0 = a0 * rr + *(const f32x4*)swp; a1 = a1 * rr + *(const f32x4*)(swp + 4); }
            u32x4 w; w.x = cvt_pk_bf16(a0[0], a0[1]); w.y = cvt_pk_bf16(a0[2], a0[3]); w.z = cvt_pk_bf16(a1[0], a1[1]); w.w = cvt_pk_bf16(a1[2], a1[3]);
            *(u32x4*)(rp + HQ + HKV + lane * 8) = w;
        }
#pragma unroll
        for (int it = 0; it < 5; ++it) {
            if (fin && it < ctx_it0) continue;
            const int head = it * 4 + hl; bf16* p = rp + head * HD + dl;
            float v[8];
            if (fin) { const slab_t* sp = slab + (size_t)(row - ML) * NQKV + head * HD + dl; f32x4 t0[8], t1[8];
#pragma unroll
                for (int sidx = 0; sidx < 8; ++sidx) ld8(sp + (size_t)sidx * MC * NQKV, t0[sidx], t1[sidx]);
                f32x4 a0 = t0[0], a1 = t1[0];
#pragma unroll
                for (int sidx = 1; sidx < 8; ++sidx) { a0 += t0[sidx]; a1 += t1[sidx]; }
                if (fssq) { const float rr = __builtin_amdgcn_rsqf(fssq[row] * (1.0f / D) + EPS); const float* swp = fsw + head * HD + dl; a0 = a0 * rr + *(const f32x4*)swp; a1 = a1 * rr + *(const f32x4*)(swp + 4); }
#pragma unroll
                for (int e = 0; e < 4; ++e) { v[e] = a0[e]; v[4 + e] = a1[e]; }
            } else { const u32x4 raw = *(const u32x4*)p;
#pragma unroll
                for (int e = 0; e < 4; ++e) { v[2 * e] = __uint_as_float(raw[e] << 16); v[2 * e + 1] = __uint_as_float(raw[e] & 0xffff0000u); } }
            float s = 0.f;
#pragma unroll
            for (int e = 0; e < 8; ++e) s += v[e] * v[e];
            s += __shfl_xor(s, 1); s += __shfl_xor(s, 2); s += __shfl_xor(s, 4); s += __shfl_xor(s, 8);
            const float r = 1.0f / sqrtf(s * (1.0f / HD) + EPS);
            const float* gp = (it < 4 ? qg : kg) + dl;
            const f32x4 g0 = *(const f32x4*)gp, g1 = *(const f32x4*)(gp + 4);
#pragma unroll
            for (int e = 0; e < 4; ++e) { v[e] *= r * g0[e]; v[4 + e] *= r * g1[e]; }
            float o[8];
            if (lat) {
                const f32x2* cs = rope + (size_t)t * 64 + (dl & 63);
#pragma unroll
                for (int e = 0; e < 8; ++e) { const float pr = __shfl_xor(v[e], 8); const f32x2 c = cs[e]; o[e] = v[e] * c.x + ((lane & 8) ? pr : -pr) * c.y; }
            } else {
#pragma unroll
                for (int e = 0; e < 8; ++e) o[e] = v[e];
            }
            u32x4 w; w.x = cvt_pk_bf16(o[0], o[1]); w.y = cvt_pk_bf16(o[2], o[3]); w.z = cvt_pk_bf16(o[4], o[5]); w.w = cvt_pk_bf16(o[6], o[7]);
            *(u32x4*)p = w;
        }
    }
}

__device__ __forceinline__ int dst_row_map(int n, int mode) { if (mode == 0) return n; const int j = n & 127; return (n >> 7) * 256 + 128 * ((j >> 2) & 1) + 32 * (j >> 5) + 8 * ((j >> 3) & 3) + (j & 3) + (mode == 2 ? 4 : 0); }
__device__ __forceinline__ void transpose_item(const float* W, int K, int N, bf16* WT, int mode, LAS float* scr, int item, int lane, int kchunk = 0, f32x4* swacc = nullptr, const float* shmx = nullptr, const float* shb = nullptr, int ldk = 0) {
    const bool sw = swacc != nullptr;
    const int nblk = N / 32, nkb = K / 64, kb = sw ? item % nkb : item / nblk, nb = sw ? item / nkb : item % nblk, k0 = 64 * kb, n0 = 32 * nb;
    const int lr = lane >> 3, lc = (lane & 7) * 4;
    f32x4 t[8];
#pragma unroll
    for (int i = 0; i < 8; ++i) t[i] = *(const f32x4*)(W + (size_t)(k0 + 8 * i + lr) * N + n0 + lc);
#pragma unroll
    for (int i = 0; i < 8; ++i) { LAS float* s = scr + (8 * i + lr) * 33 + lc; s[0] = t[i].x; s[1] = t[i].y; s[2] = t[i].z; s[3] = t[i].w; }
    if (sw) { const float bq = shb[k0 + lane]; LAS float* shs = scr + 64 * 33;
        const int tp = (lane & 7) * 8 + (lane >> 3);
        shs[tp] = shmx[k0 + lane] + bq; shs[64 + tp] = shmx[NADA + k0 + lane] + bq; shs[128 + tp] = shmx[2 * NADA + k0 + lane] + bq; }
    LDS_WAIT(); asm volatile("" ::: "memory");
    if (sw) {
        const LAS float* shs = scr + 64 * 33 + lr * 8;
#pragma unroll
        for (int bs = 0; bs < 3; ++bs) { const f32x4 s0 = *(const LAS f32x4*)(shs + 64 * bs), s1 = *(const LAS f32x4*)(shs + 64 * bs + 4);
            swacc[bs] += t[0] * s0[0] + t[1] * s0[1] + t[2] * s0[2] + t[3] * s0[3] + t[4] * s1[0] + t[5] * s1[1] + t[6] * s1[2] + t[7] * s1[3]; }
    }
    const int c = lane & 7;
#pragma unroll
    for (int j = 0; j < 4; ++j) { const int n = (lane >> 3) + 8 * j; const LAS float* s = scr + (8 * c) * 33 + n;
        u32x4 o; o.x = cvt_pk_bf16(s[0 * 33], s[1 * 33]); o.y = cvt_pk_bf16(s[2 * 33], s[3 * 33]); o.z = cvt_pk_bf16(s[4 * 33], s[5 * 33]); o.w = cvt_pk_bf16(s[6 * 33], s[7 * 33]);
        const int dr = dst_row_map(n0 + n, mode);
        bf16* dp = kchunk ? WT + ((size_t)(k0 / kchunk) * N + dr) * kchunk + (k0 % kchunk) + 8 * c : WT + (size_t)dr * (ldk ? ldk : K) + k0 + 8 * c;
        *(u32x4*)dp = o; }
    LDS_WAIT(); asm volatile("" ::: "memory");
}
template <bool SW>
__device__ __forceinline__ void transpose_group(const float* W, int K, int N, bf16* WT, int mode, LAS float* scr, int item0, int lane, f32x4* swacc, const float* shmx, const float* shb, int ldk) {
    asm volatile("" : "+v"(lane));
    const int nblk = N / 32, nkb = K / 64, kb0 = SW ? item0 % nkb : item0 / nblk, nb0 = SW ? item0 / nkb : item0 % nblk;
    const int lr = lane >> 3, lc = (lane & 7) * 4, c = lane & 7;
    const float* src = W + (size_t)(64 * kb0 + lr) * N + 32 * nb0 + lc;
    const size_t istep = SW ? (size_t)64 * N : (size_t)32;
#define TRG_LOAD(T, i) do { const float* p_ = src + (size_t)(i) * istep; _Pragma("unroll") for (int e = 0; e < 8; ++e) T[e] = __builtin_nontemporal_load((const f32x4*)(p_ + (size_t)(8 * e) * N)); } while (0)
#define TRG_FIN(T, i) do { const int k0 = 64 * (kb0 + (SW ? (i) : 0)), n0 = 32 * (nb0 + (SW ? 0 : (i))); \
        _Pragma("unroll") for (int e = 0; e < 8; ++e) { LAS float* s_ = scr + (8 * e + lr) * 33 + lc; s_[0] = T[e].x; s_[1] = T[e].y; s_[2] = T[e].z; s_[3] = T[e].w; } \
        LDS_WAIT(); asm volatile("" ::: "memory"); \
        if (SW) { const LAS float* shs_ = scr + 64 * 33 + (i) * 192 + lr * 8; \
            _Pragma("unroll") for (int bs = 0; bs < 3; ++bs) { const f32x4 s0 = *(const LAS f32x4*)(shs_ + 64 * bs), s1 = *(const LAS f32x4*)(shs_ + 64 * bs + 4); \
                swacc[bs] += T[0] * s0[0] + T[1] * s0[1] + T[2] * s0[2] + T[3] * s0[3] + T[4] * s1[0] + T[5] * s1[1] + T[6] * s1[2] + T[7] * s1[3]; } } \
        _Pragma("unroll") for (int j = 0; j < 4; ++j) { const int n = (lane >> 3) + 8 * j; const LAS float* s_ = scr + (8 * c) * 33 + n; \
            u32x4 o; o.x = cvt_pk_bf16(s_[0 * 33], s_[1 * 33]); o.y = cvt_pk_bf16(s_[2 * 33], s_[3 * 33]); o.z = cvt_pk_bf16(s_[4 * 33], s_[5 * 33]); o.w = cvt_pk_bf16(s_[6 * 33], s_[7 * 33]); \
            __builtin_nontemporal_store(o, (u32x4*)(WT + (size_t)dst_row_map(n0 + n, mode) * ldk + k0 + 8 * c)); } \
        LDS_WAIT(); asm volatile("" ::: "memory"); } while (0)
    f32x4 ta[8], tb[8];
    if (SW) {
        float bq[8], h0[8], h1[8], h2[8];
#pragma unroll
        for (int i = 0; i < 8; ++i) { const int k = 64 * (kb0 + i) + lane; bq[i] = shb[k]; h0[i] = shmx[k]; h1[i] = shmx[NADA + k]; h2[i] = shmx[2 * NADA + k]; }
        TRG_LOAD(ta, 0); asm volatile("" ::: "memory");
        const int tp = (lane & 7) * 8 + (lane >> 3); LAS float* shs = scr + 64 * 33;
#pragma unroll
        for (int i = 0; i < 8; ++i) { shs[i * 192 + tp] = h0[i] + bq[i]; shs[i * 192 + 64 + tp] = h1[i] + bq[i]; shs[i * 192 + 128 + tp] = h2[i] + bq[i]; }
    } else { TRG_LOAD(ta, 0); }
#pragma unroll 1
    for (int i = 0; i < 8; i += 2) {
        TRG_LOAD(tb, i + 1);
        TRG_FIN(ta, i);
        if (i + 2 < 8) TRG_LOAD(ta, i + 2);
        TRG_FIN(tb, i + 1);
    }
#undef TRG_LOAD
#undef TRG_FIN
}
__device__ __forceinline__ void sw_flush(f32x4* swacc, float* sw, int swN, int n0, int mode, int lane) {
    const int lr = lane >> 3, lc = (lane & 7) * 4;
#pragma unroll
    for (int bs = 0; bs < 3; ++bs) { float pick = 0.f;
#pragma unroll
        for (int e = 0; e < 4; ++e) { float v = swacc[bs][e]; v += __shfl_xor(v, 8); v += __shfl_xor(v, 16); v += __shfl_xor(v, 32); if (lr == e) pick = v; }
        if (lr < 4) atomicAdd(sw + (size_t)bs * swN + dst_row_map(n0 + lc + lr, mode), pick);
        swacc[bs] = (f32x4){0.f, 0.f, 0.f, 0.f}; }
}
struct KArgs { const float* in[21]; float* out; unsigned char* ws; int ph_lo, ph_hi; };
enum { I_X = 0, I_C, I_CTX, I_CCTX, I_WADA, I_BADA, I_NORMG, I_WG, I_WU, I_WD, I_WQKV, I_WO, I_QG, I_KG, I_SINK, I_WF, I_WSI, I_SVG, I_WSS, I_BSS, I_WSOUT };
constexpr int CW_QUEUE = 64;
constexpr int TR_FFN = 5632;
constexpr float F_SCALE_LAT = 0.00069053396600248786f;
constexpr float F_SCALE_CTX = 0.00390625f;
constexpr int ITA_TR = 4 * TR_FFN + 3072 + 4096 + 2048 + 6144, IT_F = 384, IT_DC = 256, IT_FC = 256, IT_ROPE = 1024, ITA_TOTAL = ITA_TR + IT_F + IT_DC + IT_FC + IT_ROPE;
constexpr int ITB_TOTAL = 8 * TR_FFN + 12288 + 3072;

__device__ __forceinline__ void prologue_group_b(const KArgs& a, int r0, LAS float* scr, int lane) {
    unsigned char* ws = a.ws; const float* MX = (const float*)(ws + WS_MX); const float* BA = a.in[I_BADA];
    const float* W; bf16* WT; int N, mode; float* sw; int swN; const float* shmx; const float* shb; int r = r0;
    if (r < 8 * TR_FFN) { const int kind = r / (4 * TR_FFN), l = (r / TR_FFN) & 3; r = r % TR_FFN;
        W = a.in[kind ? I_WU : I_WG] + (size_t)l * D * DFF; WT = (bf16*)(ws + WS_WGU + (size_t)l * 44 * MiB); N = DFF; mode = kind ? 2 : 1;
        sw = (float*)(ws + WS_Z2 + Z2_SWGU) + (size_t)l * 3 * 2 * DFF; swN = 2 * DFF; shmx = MX + (size_t)l * 3 * NADA + 3 * D; shb = BA + (size_t)l * NADA + 3 * D; }
    else { r -= 8 * TR_FFN;
        if (r < 12288) { W = a.in[I_WSI]; WT = (bf16*)(ws + WS_WSI); N = 2 * SGH; mode = 0; sw = (float*)(ws + WS_Z2 + Z2_SWSI); swN = 2 * SGH; shmx = MX + (size_t)2 * 3 * NADA; shb = BA + (size_t)2 * NADA; }
        else { r -= 12288; W = a.in[I_WQKV] + (size_t)D * NQKV; WT = (bf16*)(ws + WS_WQKV + (size_t)12 * MiB); N = NQKV; mode = 0; sw = (float*)(ws + WS_Z2 + Z2_SWQ3); swN = NQKV; shmx = MX + (size_t)3 * 3 * NADA; shb = BA + (size_t)3 * NADA; } }
    f32x4 swacc[3] = {{0.f, 0.f, 0.f, 0.f}, {0.f, 0.f, 0.f, 0.f}, {0.f, 0.f, 0.f, 0.f}};
    const int gidx = r >> 3, nblk = N / 32, nb = gidx % nblk, kb8 = gidx / nblk;
    transpose_group<true>(W, D, N, WT, mode, scr, nb * 32 + kb8 * 8, lane, swacc, shmx, shb, D);
    sw_flush(swacc, sw, swN, 32 * nb, mode, lane);
}
__device__ __forceinline__ void prologue_group_a(const KArgs& a, int r, LAS float* scr, int lane) {
    unsigned char* ws = a.ws; const float* W; bf16* WT; int K, N, ldk;
    if (r < 4 * TR_FFN) { const int l = r / TR_FFN; r = r % TR_FFN; W = a.in[I_WD] + (size_t)l * DFF * D; K = DFF; N = D; WT = (bf16*)(ws + WS_WDN + (size_t)l * WDN_SLOT); ldk = LDG_PAD; }
    else { r -= 4 * TR_FFN;
        if (r < 3072) { W = a.in[I_WQKV]; K = D; N = NQKV; WT = (bf16*)(ws + WS_WQKV); ldk = D; }
        else { r -= 3072;
            if (r < 4096) { const int j = r / 2048; r = r % 2048; W = a.in[I_WO] + (size_t)j * HQ * D; K = HQ; N = D; WT = (bf16*)(ws + WS_WO + (size_t)j * 8 * MiB); ldk = HQ; }
            else { r -= 4096;
                if (r < 2048) { W = a.in[I_WF]; K = D; N = D; WT = (bf16*)(ws + WS_WF); ldk = D; }
                else { r -= 2048; W = a.in[I_WSOUT]; K = SGH; N = D; WT = (bf16*)(ws + WS_WSO); ldk = SGH; } } } }
    f32x4 dummy[3];
    transpose_group<false>(W, K, N, WT, 0, scr, r, lane, dummy, nullptr, nullptr, ldk);
}
__device__ __forceinline__ void prologue_item(const KArgs& a, int r, LAS float* scr, int lane) {
    unsigned char* ws = a.ws;
    r -= ITA_TR;
    if (r < IT_F) {
        float v[8];
        if (r < 128) {
            const int e0 = r * 512 + lane * 8, i = e0 >> 8, kk0 = e0 & 255, rp = i >> 7, cp = (i >> 6) & 1, k1 = i & 63;
#pragma unroll
            for (int e = 0; e < 8; ++e) { const int kk = kk0 + e, cpi = kk >> 7, re = (kk >> 6) & 1, t1 = kk & 63; const float fr = (float)((k1 * t1) & 63) * (1.0f / 64.0f);
                float c = (rp == re) ? __builtin_amdgcn_cosf(fr) : -__builtin_amdgcn_sinf(fr); if (rp == 1 && re == 1) c = -c; v[e] = (cp == cpi) ? c : 0.f; }
            u32x4 w; w.x = cvt_pk_bf16(v[0], v[1]); w.y = cvt_pk_bf16(v[2], v[3]); w.z = cvt_pk_bf16(v[4], v[5]); w.w = cvt_pk_bf16(v[6], v[7]);
            *(u32x4*)((bf16*)(ws + WS_DA) + e0) = w;
        } else {
            const int e0 = (r - 128) * 512 + lane * 8, i = e0 >> 9, kk0 = e0 & 511, cp = i >> 7, k2 = i & 127;
#pragma unroll
            for (int e = 0; e < 8; ++e) { const int kk = kk0 + e, cpi = kk >> 8, re = (kk >> 7) & 1, t2 = kk & 127; const float fr = (float)((k2 * t2) & 127) * (1.0f / 128.0f);
                const float c = re ? __builtin_amdgcn_sinf(fr) : __builtin_amdgcn_cosf(fr); v[e] = (cp == cpi) ? F_SCALE_LAT * c : 0.f; }
            u32x4 w; w.x = cvt_pk_bf16(v[0], v[1]); w.y = cvt_pk_bf16(v[2], v[3]); w.z = cvt_pk_bf16(v[4], v[5]); w.w = cvt_pk_bf16(v[6], v[7]);
            *(u32x4*)((bf16*)(ws + WS_DB) + e0) = w;
        }
        return; }
    r -= IT_F;
    if (r < IT_DC) {
        const int e0 = r * 512 + lane * 8, row = e0 >> 8, c0 = e0 & 255, m = row & 255, reim = row >> 8; float v[8];
#pragma unroll
        for (int e = 0; e < 8; ++e) { const float fr = (float)((m * (c0 + e)) & 255) * (1.0f / 256.0f); v[e] = reim ? __builtin_amdgcn_sinf(fr) : __builtin_amdgcn_cosf(fr); }
        u32x4 w; w.x = cvt_pk_bf16(v[0], v[1]); w.y = cvt_pk_bf16(v[2], v[3]); w.z = cvt_pk_bf16(v[4], v[5]); w.w = cvt_pk_bf16(v[6], v[7]);
        *(u32x4*)((bf16*)(ws + WS_DC2) + e0) = w; return; }
    r -= IT_DC;
    if (r < IT_FC) {
        const int e0 = r * 512 + lane * 8, k = e0 >> 9, c0 = e0 & 511, reim = c0 >> 8, l0 = c0 & 255; float v[8];
#pragma unroll
        for (int e = 0; e < 8; ++e) { const int idx = ((k * (l0 + e)) + reim * 64) & 255; v[e] = F_SCALE_CTX * __builtin_amdgcn_cosf((float)idx * (1.0f / 256.0f)); }
        u32x4 w; w.x = cvt_pk_bf16(v[0], v[1]); w.y = cvt_pk_bf16(v[2], v[3]); w.z = cvt_pk_bf16(v[4], v[5]); w.w = cvt_pk_bf16(v[6], v[7]);
        *(u32x4*)((bf16*)(ws + WS_FC) + e0) = w; return; }
    r -= IT_FC;
    {
        f32x2* dst = (f32x2*)(ws + WS_ROPE) + (size_t)r * 512 + lane * 8;
#pragma unroll
        for (int e = 0; e < 8; ++e) { const int idx = r * 512 + lane * 8 + e, t = idx >> 6, f = idx & 63;
            const float inv = __builtin_amdgcn_exp2f(-(float)(f & 31) * (13.287712379549449f / 32.0f));
            const float ang = (float)(f < 32 ? (t >> 6) : (t & 63)) * inv, rev = ang * 0.15915494309189535f;
            dst[e] = (f32x2){__builtin_amdgcn_cosf(rev), __builtin_amdgcn_sinf(rev)}; }
    }
}

template <int PART> __device__ __forceinline__ void prologue_phase(const KArgs& a, LAS unsigned char* lds, gu32* ctl, int tid, int lane, int wave) {
    asm volatile("" : "+v"(tid), "+v"(lane));
    if (PART == 0) {
        LAS float* sl = (LAS float*)lds;
        LAS float* part = (LAS float*)(lds + 24576);
        for (int i = tid; i < 3 * D; i += 512) { const int r = i / D, k = i % D; const float cv = r < 2 ? a.in[I_C][r * D + k] : a.in[I_CCTX][k]; sl[i] = silu_f(cv); }
        __syncthreads();
        const int sub = lane >> 4, lc = (lane & 15) * 4;
        for (int item = blockIdx.x; item < 4 * 192; item += gridDim.x) {
            const int l = item / 192, jb = item % 192;
            const float* wp = a.in[I_WADA] + ((size_t)l * D + wave * 256 + sub) * NADA + jb * 64 + lc;
            f32x4 a0 = {0.f, 0.f, 0.f, 0.f}, a1 = a0, a2 = a0;
            for (int k = 0; k < 256; k += 32) { f32x4 w[8];
#pragma unroll
                for (int e = 0; e < 8; ++e) w[e] = *(const f32x4*)(wp + (size_t)(k + 4 * e) * NADA);
#pragma unroll
                for (int e = 0; e < 8; ++e) { const int kk = wave * 256 + k + 4 * e + sub; a0 += w[e] * sl[kk]; a1 += w[e] * sl[D + kk]; a2 += w[e] * sl[2 * D + kk]; } }
#pragma unroll
            for (int e = 0; e < 4; ++e) { a0[e] += __shfl_xor(a0[e], 16); a0[e] += __shfl_xor(a0[e], 32); a1[e] += __shfl_xor(a1[e], 16); a1[e] += __shfl_xor(a1[e], 32); a2[e] += __shfl_xor(a2[e], 16); a2[e] += __shfl_xor(a2[e], 32); }
            if (sub == 0) { *(LAS f32x4*)(part + (wave * 3 + 0) * 64 + lc) = a0; *(LAS f32x4*)(part + (wave * 3 + 1) * 64 + lc) = a1; *(LAS f32x4*)(part + (wave * 3 + 2) * 64 + lc) = a2; }
            __syncthreads();
            if (tid < 192) { const int r = tid >> 6, j = tid & 63; float s = 0.f;
#pragma unroll
                for (int w = 0; w < 8; ++w) s += part[(w * 3 + r) * 64 + j];
                ((float*)(a.ws + WS_MX))[((size_t)l * 3 + r) * NADA + jb * 64 + j] = s; }
            __syncthreads();
        }
        return;
    }
    LAS float* scr = (LAS float*)(lds + wave * 16384);
    for (;;) {
        unsigned base = 0; if (lane == 0) base = __hip_atomic_fetch_add((unsigned*)(ctl + CW_QUEUE + 64), 8u, RLX_AGENT);
        base = (unsigned)__builtin_amdgcn_readfirstlane((int)base);
        if (base >= (unsigned)ITB_TOTAL) break;
        prologue_group_b(a, (int)base, scr, lane);
    }
    for (;;) {
        unsigned base = 0; if (lane == 0) base = __hip_atomic_fetch_add((unsigned*)(ctl + CW_QUEUE), 8u, RLX_AGENT);
        base = (unsigned)__builtin_amdgcn_readfirstlane((int)base);
        if (base >= (unsigned)ITA_TOTAL) break;
        if (base < (unsigned)ITA_TR) prologue_group_a(a, (int)base, scr, lane);
        else for (int i = 0; i < 8; ++i) { const int it = (int)base + i; if (it < ITA_TOTAL) prologue_item(a, it, scr, lane); }
    }
}
namespace attn {
constexpr float SCALE = 0.08838834764831845f;
constexpr float THR = 8.f;
constexpr int SHM_K = 64 * 128 * 2, SHM_V = 64 * 128 * 2;
constexpr int OFF_V = 0, OFF_K = 2 * SHM_V, OFF_WS = 2 * SHM_V + 2 * SHM_K, LDS_BYTES = OFF_WS + 8 * 64 * 4;
#define KSWZ(row, colB) ((row) * 256 + ((colB) ^ (((row) & 7) << 4)))
#define SBAR() __builtin_amdgcn_sched_barrier(0)
__device__ __forceinline__ int v_st(int k, int c) { const int kk = (k & ~0xC) | ((k & 4) << 1) | ((k & 8) >> 1); return ((kk >> 3) * 4 + (c >> 5)) * 512 + ((kk & 7) * 32 + (c & 31)) * 2; }
__device__ __forceinline__ int v_rd_base(int lane) { return ((lane & 3) << 3) | (((lane >> 2) & 3) << 6) | (((lane >> 4) & 1) << 5) | (((lane >> 5) & 1) << 8); }
__device__ __forceinline__ int crow(int r, int hi) { return (r & 3) + 8 * (r >> 2) + 4 * hi; }
__device__ __forceinline__ void mask_tile(f32x16& p0, f32x16& p1, int dq, unsigned W) {
    const float NEG = -__builtin_inff();
#pragma unroll
    for (int r = 0; r < 16; ++r) { const int c = (r & 3) + 8 * (r >> 2);
        if ((unsigned)(dq - c) >= W) p0[r] = NEG;
        if ((unsigned)(dq - c - 32) >= W) p1[r] = NEG; }
}
__device__ __forceinline__ void partialSM(f32x16& p0, f32x16& p1, float& m_reg, float& mn, float& alpha) {
    float pmax = p0[0];
#pragma unroll
    for (int r = 1; r < 16; ++r) pmax = fmaxf(pmax, p0[r]);
#pragma unroll
    for (int r = 0; r < 16; ++r) pmax = fmaxf(pmax, p1[r]);
    { auto rr = __builtin_amdgcn_permlane32_swap(__float_as_uint(pmax), __float_as_uint(pmax), false, false);
      pmax = fmaxf(__uint_as_float(rr[0]), __uint_as_float(rr[1])); }
    constexpr float C2 = 1.4426950408889634f * SCALE;
    if (__builtin_expect(__all((pmax - m_reg) * SCALE <= THR), 1)) { mn = m_reg; alpha = 1.f; }
    else { mn = fmaxf(m_reg, pmax); alpha = __builtin_amdgcn_exp2f((m_reg - mn) * C2); m_reg = mn; }
    const float mnL = -mn * C2;
#pragma unroll
    for (int r = 0; r < 16; ++r) p0[r] = fmaf(p0[r], C2, mnL);
#pragma unroll
    for (int r = 0; r < 16; ++r) p1[r] = fmaf(p1[r], C2, mnL);
#pragma unroll
    for (int r = 0; r < 16; ++r) p0[r] = __builtin_amdgcn_exp2f(p0[r]);
}
__device__ __forceinline__ void finishSM(f32x16& p0, f32x16& p1, float alpha, float& l_reg, bf16x8& pa0, bf16x8& pa1, bf16x8& pa2, bf16x8& pa3) {
#pragma unroll
    for (int r = 0; r < 16; ++r) p1[r] = __builtin_amdgcn_exp2f(p1[r]);
    float ps = 0;
#pragma unroll
    for (int r = 0; r < 16; ++r) ps += p0[r];
#pragma unroll
    for (int r = 0; r < 16; ++r) ps += p1[r];
    { auto rr = __builtin_amdgcn_permlane32_swap(__float_as_uint(ps), __float_as_uint(ps), false, false);
      ps = __uint_as_float(rr[0]) + __uint_as_float(rr[1]); }
    l_reg = l_reg * alpha + ps;
#define PK4(P, B_, OUT) do { unsigned a0 = cvt_pk_bf16(P[B_+0], P[B_+1]), a1 = cvt_pk_bf16(P[B_+2], P[B_+3]);                          \
        unsigned b0 = cvt_pk_bf16(P[B_+4], P[B_+5]), b1 = cvt_pk_bf16(P[B_+6], P[B_+7]);                                             \
        auto r0 = __builtin_amdgcn_permlane32_swap(a0, b0, false, false); auto r1 = __builtin_amdgcn_permlane32_swap(a1, b1, false, false); \
        u32x4 w = {r0[0], r1[0], r0[1], r1[1]}; OUT = *reinterpret_cast<bf16x8*>(&w); } while (0)
    PK4(p0, 0, pa0); PK4(p0, 8, pa1); PK4(p1, 0, pa2); PK4(p1, 8, pa3);
#undef PK4
}
template <int KB>
__device__ __forceinline__ void qkt(f32x16& p0, f32x16& p1, const char* K_lds, int r32, int hi, const bf16x8* qr) {
    p0 = f32x16{}; p1 = f32x16{};
    const char* kb[4];
#pragma unroll
    for (int dd = 0; dd < 4; ++dd) kb[dd] = K_lds + KB * SHM_K + KSWZ(r32, (dd * 16 + hi * 8) * 2);
#pragma unroll
    for (int d0 = 0; d0 < 8; ++d0) { const char* a = kb[d0 & 3] + (d0 >> 2) * 128;
        bf16x8 b0 = *reinterpret_cast<const bf16x8*>(a);
        bf16x8 b1 = *reinterpret_cast<const bf16x8*>(a + 32 * 256);
        p0 = __builtin_amdgcn_mfma_f32_32x32x16_bf16(b0, qr[d0], p0, 0, 0, 0);
        p1 = __builtin_amdgcn_mfma_f32_32x32x16_bf16(b1, qr[d0], p1, 0, 0, 0); }
}
#define TRRD(dst, off) asm volatile("ds_read_b64_tr_b16 %0, %1 offset:%2" : "=&v"(dst) : "v"(vb0), "i"(off) : "memory")
#define PV_D0(oacc, vbuf, d0, pa0, pa1, pa2, pa3) do { s16x4 l0, l1, l2, l3, h0, h1, h2, h3; constexpr int b_ = (vbuf) + (d0) * 512; \
        TRRD(l0, b_); TRRD(h0, b_ + 2048); TRRD(l1, b_ + 4096); TRRD(h1, b_ + 6144); TRRD(l2, b_ + 8192); TRRD(h2, b_ + 10240); TRRD(l3, b_ + 12288); TRRD(h3, b_ + 14336); \
        asm volatile("s_waitcnt lgkmcnt(0)" ::: "memory"); SBAR(); \
        oacc = __builtin_amdgcn_mfma_f32_32x32x16_bf16(pa0, (bf16x8){l0[0], l0[1], l0[2], l0[3], h0[0], h0[1], h0[2], h0[3]}, oacc, 0, 0, 0);   \
        oacc = __builtin_amdgcn_mfma_f32_32x32x16_bf16(pa1, (bf16x8){l1[0], l1[1], l1[2], l1[3], h1[0], h1[1], h1[2], h1[3]}, oacc, 0, 0, 0);   \
        oacc = __builtin_amdgcn_mfma_f32_32x32x16_bf16(pa2, (bf16x8){l2[0], l2[1], l2[2], l2[3], h2[0], h2[1], h2[2], h2[3]}, oacc, 0, 0, 0);   \
        oacc = __builtin_amdgcn_mfma_f32_32x32x16_bf16(pa3, (bf16x8){l3[0], l3[1], l3[2], l3[3], h3[0], h3[1], h3[2], h3[3]}, oacc, 0, 0, 0); } while (0)
template <int VB>
__device__ __forceinline__ void pv_tile(f32x16* o, int vb0, bf16x8 pa0, bf16x8 pa1, bf16x8 pa2, bf16x8 pa3) {
    PV_D0(o[0], VB * SHM_V, 0, pa0, pa1, pa2, pa3); PV_D0(o[1], VB * SHM_V, 1, pa0, pa1, pa2, pa3);
    PV_D0(o[2], VB * SHM_V, 2, pa0, pa1, pa2, pa3); PV_D0(o[3], VB * SHM_V, 3, pa0, pa1, pa2, pa3);
}

struct AUnit { int qrow0, klat0, kctx0, kh, tb; };

__device__ __forceinline__ void attn_unit(const bf16* QKV, bf16* AO, const float* sink, const AUnit u, char* lds) {
    int tid = threadIdx.x; asm volatile("" : "+v"(tid));
    const int wid = __builtin_amdgcn_readfirstlane(tid >> 6), lane = tid & 63, r32 = lane & 31, hi = lane >> 5;
    const int hq = u.kh * 4 + (wid >> 1), half = wid & 1;
    char* V_lds = lds + OFF_V; char* K_lds = lds + OFF_K;
    float* wsc = (float*)(lds + OFF_WS) + wid * 64; float* li_l = wsc; float* al_l = wsc + 32;
    const int sr = tid >> 4, sc = (tid & 15) * 8, vst0 = v_st(sr, sc), vst1 = v_st(32 + sr, sc), kws = KSWZ(sr, sc * 2);
    const int vb0 = (int)(uintptr_t)V_lds + v_rd_base(lane);
    int jlo = 0, nwin = 0;
    if (u.tb >= 0) { jlo = u.tb - 2 < 0 ? 0 : u.tb - 2; const int jhi = u.tb + 2 > SEQ / 64 - 1 ? SEQ / 64 - 1 : u.tb + 2; nwin = jhi - jlo + 1; }
    const int NT = 4 + nwin;
    const bf16* kvbase = QKV + HQ + u.kh * HD + sc;
    bf16x8 st_k0, st_k1, st_v0, st_v1;
#define A_KROW(t) ((t) < 4 ? u.kctx0 + 64 * (t) : u.klat0 + 64 * (jlo + (t) - 4))
#define A_LOADK(t) do { const bf16* p_ = kvbase + (size_t)(A_KROW(t) + sr) * NQKV; st_k0 = *(const bf16x8*)p_; st_k1 = *(const bf16x8*)(p_ + (size_t)32 * NQKV); } while (0)
#define A_LOADV(t) do { const bf16* p_ = kvbase + (size_t)(A_KROW(t) + sr) * NQKV + HKV; st_v0 = *(const bf16x8*)p_; st_v1 = *(const bf16x8*)(p_ + (size_t)32 * NQKV); } while (0)
#define A_WRITEK(bf) do { *(bf16x8*)(K_lds + (bf) * SHM_K + kws) = st_k0; *(bf16x8*)(K_lds + (bf) * SHM_K + kws + 32 * 256) = st_k1; } while (0)
#define A_WRITEV(bf) do { *(bf16x8*)(V_lds + (bf) * SHM_V + vst0) = st_v0; *(bf16x8*)(V_lds + (bf) * SHM_V + vst1) = st_v1; } while (0)
    A_LOADK(0); A_LOADV(0);
    bf16x8 qr[8];
    { const bf16* qp = QKV + (size_t)(u.qrow0 + 32 * half + r32) * NQKV + hq * HD + hi * 8;
#pragma unroll
      for (int d0 = 0; d0 < 8; ++d0) qr[d0] = *(const bf16x8*)(qp + d0 * 16); }
    float m_reg = sink[hq] * (1.0f / SCALE), l_reg = 1.0f; f32x16 o[4] = {};
    const int qpos128 = 64 * u.tb + 32 * half + r32 + 128 - 4 * hi;
    VM_WAIT(); A_WRITEK(0); A_WRITEV(0);
    A_LOADK(1); VM_WAIT(); A_WRITEK(1);
    __syncthreads();
    f32x16 pA0, pA1, pB0, pB1;
    qkt<0>(pA0, pA1, K_lds, r32, hi, qr);
    __syncthreads();
#define A_RESC(a) do { if (__any((a) < 1.f)) { if (hi == 0) al_l[r32] = (a); asm volatile("s_waitcnt lgkmcnt(0)" ::: "memory");              \
                     _Pragma("unroll") for (int d_ = 0; d_ < 4; ++d_) _Pragma("unroll") for (int r = 0; r < 16; ++r) o[d_][r] *= al_l[crow(r, hi)]; } } while (0)
#define A_STEP(PX0, PX1, PY0, PY1, t, KBN, VB) do { float mn, alpha; bf16x8 pa0, pa1, pa2, pa3; \
        if ((t) + 2 < NT) A_LOADK((t) + 2); if ((t) + 1 < NT) A_LOADV((t) + 1); \
        if ((t) + 1 < NT) qkt<KBN>(PY0, PY1, K_lds, r32, hi, qr); \
        if ((t) >= 4) { const int blk = jlo + (t) - 4; if (blk == u.tb - 2 || blk == u.tb + 2) mask_tile(PX0, PX1, qpos128 - 64 * blk, 257u); } \
        partialSM(PX0, PX1, m_reg, mn, alpha); A_RESC(alpha); finishSM(PX0, PX1, alpha, l_reg, pa0, pa1, pa2, pa3); SBAR(); \
        pv_tile<VB>(o, vb0, pa0, pa1, pa2, pa3); \
        VM_WAIT(); if ((t) + 2 < NT) A_WRITEK(VB); if ((t) + 1 < NT) A_WRITEV(KBN); \
        __syncthreads(); } while (0)
    for (int t = 0; t < NT; t += 2) {
        A_STEP(pA0, pA1, pB0, pB1, t, 1, 0);
        if (t + 1 >= NT) break;
        A_STEP(pB0, pB1, pA0, pA1, t + 1, 0, 1);
    }
    if (hi == 0) li_l[r32] = l_reg; asm volatile("s_waitcnt lgkmcnt(0)" ::: "memory");
    bf16* Ow = AO + (size_t)(u.qrow0 + 32 * half) * D + hq * HD;
    char* stg = lds + wid * 8192;
#pragma unroll
    for (int r = 0; r < 16; ++r) { const int orow = crow(r, hi); const float rl = __builtin_amdgcn_rcpf(li_l[orow]);
#pragma unroll
        for (int d0 = 0; d0 < 4; ++d0) { const float v = o[d0][r] * rl; const float vn = __shfl_xor(v, 1);
            if ((r32 & 1) == 0) *(unsigned*)(stg + orow * 256 + (d0 * 32 + r32) * 2) = cvt_pk_bf16(v, vn); } }
    asm volatile("s_waitcnt lgkmcnt(0)" ::: "memory");
#pragma unroll
    for (int i = 0; i < 8; ++i) { const int row = i * 4 + (lane >> 4), ch = lane & 15; const u32x4 v = *(const u32x4*)(stg + row * 256 + ch * 16); *(u32x4*)(Ow + (size_t)row * D + ch * 8) = v; }
    asm volatile("s_waitcnt lgkmcnt(0)" ::: "memory");
    __syncthreads();
#undef A_KROW
#undef A_LOADK
#undef A_LOADV
#undef A_WRITEK
#undef A_WRITEV
#undef A_RESC
#undef A_STEP
}

__device__ __forceinline__ void attn_phase(const bf16* QKV, bf16* AO, const float* sink, bool with_ctx, int vcu, int G, char* lds) {
    for (int uid = vcu * 4; uid < 1024; uid += G * 4) {
        for (int i = 0; i < 4; ++i) { const int id = uid + i, bk = id >> 7, b = bk >> 2; AUnit u; u.kh = bk & 3; u.tb = id & 127;
            u.qrow0 = b * SEQ + 64 * u.tb; u.klat0 = b * SEQ; u.kctx0 = ML + b * CTXL; attn_unit(QKV, AO, sink, u, lds); }
    }
    if (with_ctx) for (int id = vcu; id < 32; id += G) { AUnit u; const int b = id >> 4; u.kh = (id >> 2) & 3; u.tb = -1; u.qrow0 = ML + b * CTXL + 64 * (id & 3); u.klat0 = 0; u.kctx0 = ML + b * CTXL;
        attn_unit(QKV, AO, sink, u, lds); }
}

constexpr int SG_T = 2 * SHM_V, SG_TP = 132;
__device__ __forceinline__ void sgu_unit(bf16* Z, const float* ssq, const float* wsp, const float* bsp, const float* gvv, int chunk, int g, int db0, char* lds, long store_off = 0) {
    int tid = threadIdx.x; asm volatile("" : "+v"(tid));
    const int wid = __builtin_amdgcn_readfirstlane(tid >> 6), lane = tid & 63, r32 = lane & 31, hi = lane >> 5;
    const int pb = wid & 3, dh = wid >> 2, R0 = chunk * 128;
    char* V_lds = lds; float* T = (float*)(lds + SG_T);
    const int sr = tid >> 4, sc = (tid & 15) * 8, vst0 = v_st(sr, sc), vst1 = v_st(32 + sr, sc);
    const int vb0 = (int)(uintptr_t)V_lds + v_rd_base(lane);
    bf16x8 pa[8];
    { const float* wrow = wsp + ((size_t)(g * 128 + pb * 32 + r32)) * 128 + 8 * hi; const float* sq = ssq + R0 + 8 * hi;
#pragma unroll
      for (int ks = 0; ks < 8; ++ks) { const f32x4 w0 = *(const f32x4*)(wrow + ks * 16), w1 = *(const f32x4*)(wrow + ks * 16 + 4); const f32x4 s0 = *(const f32x4*)(sq + ks * 16), s1 = *(const f32x4*)(sq + ks * 16 + 4);
          float v[8];
#pragma unroll
          for (int e = 0; e < 4; ++e) { v[e] = w0[e] * __builtin_amdgcn_rsqf(s0[e] * (1.0f / SGH) + EPS); v[4 + e] = w1[e] * __builtin_amdgcn_rsqf(s1[e] * (1.0f / SGH) + EPS); }
          u32x4 w; w.x = cvt_pk_bf16(v[0], v[1]); w.y = cvt_pk_bf16(v[2], v[3]); w.z = cvt_pk_bf16(v[4], v[5]); w.w = cvt_pk_bf16(v[6], v[7]); pa[ks] = *reinterpret_cast<bf16x8*>(&w); } }
    float bias[16];
#pragma unroll
    for (int r = 0; r < 16; ++r) bias[r] = bsp[g * 128 + pb * 32 + crow(r, hi)];
#if KCHUNK
#define ZADDR(row, col) (((size_t)((col) >> 9) * MT + (row)) * 512 + ((col) & 511))
#define ZLD 512
#else
#define ZADDR(row, col) ((size_t)(row) * (2 * SGH) + (col))
#define ZLD (2 * SGH)
#endif
    bf16x8 s00, s01, s10, s11;
#define S_LOAD(db) do { const bf16* p_ = Z + ZADDR(R0 + sr, SGH + g * SGG + (db) * 128 + sc); s00 = *(const bf16x8*)p_; s01 = *(const bf16x8*)(p_ + (size_t)32 * ZLD); \
                        s10 = *(const bf16x8*)(p_ + (size_t)64 * ZLD); s11 = *(const bf16x8*)(p_ + (size_t)96 * ZLD); } while (0)
#define S_WRITE() do { *(bf16x8*)(V_lds + vst0) = s00; *(bf16x8*)(V_lds + vst1) = s01; *(bf16x8*)(V_lds + SHM_V + vst0) = s10; *(bf16x8*)(V_lds + SHM_V + vst1) = s11; } while (0)
    S_LOAD(db0);
    for (int db = db0; db < db0 + 2; ++db) {
        VM_WAIT(); S_WRITE();
        __syncthreads();
        u32x4 ur[4]; bf16* usrc = Z + ZADDR(R0 + sr, g * SGG + db * 128 + sc);
#pragma unroll
        for (int ps = 0; ps < 4; ++ps) ur[ps] = *(const u32x4*)(usrc + (size_t)32 * ps * ZLD);
        if (db + 1 < db0 + 2) S_LOAD(db + 1);
        f32x16 o0 = {}, o1 = {};
        if (dh == 0) { PV_D0(o0, 0, 0, pa[0], pa[1], pa[2], pa[3]); PV_D0(o0, SHM_V, 0, pa[4], pa[5], pa[6], pa[7]); PV_D0(o1, 0, 1, pa[0], pa[1], pa[2], pa[3]); PV_D0(o1, SHM_V, 1, pa[4], pa[5], pa[6], pa[7]); }
        else         { PV_D0(o0, 0, 2, pa[0], pa[1], pa[2], pa[3]); PV_D0(o0, SHM_V, 2, pa[4], pa[5], pa[6], pa[7]); PV_D0(o1, 0, 3, pa[0], pa[1], pa[2], pa[3]); PV_D0(o1, SHM_V, 3, pa[4], pa[5], pa[6], pa[7]); }
        { const int colb = g * SGG + db * 128 + dh * 64 + r32; const float gv0 = gvv[colb], gv1 = gvv[colb + 32];
          float* tp = T + (size_t)(pb * 32) * SG_TP + dh * 64 + r32;
#pragma unroll
          for (int r = 0; r < 16; ++r) { const int p = crow(r, hi); tp[p * SG_TP] = gv0 * o0[r] + bias[r]; tp[p * SG_TP + 32] = gv1 * o1[r] + bias[r]; } }
        __syncthreads();
#pragma unroll
        for (int ps = 0; ps < 4; ++ps) { const float* tr = T + (size_t)(32 * ps + sr) * SG_TP + sc; const f32x4 t0 = *(const f32x4*)tr, t1 = *(const f32x4*)(tr + 4); const u32x4 u = ur[ps];
            u32x4 w; w.x = cvt_pk_bf16(__uint_as_float(u.x << 16) * t0[0], __uint_as_float(u.x & 0xffff0000u) * t0[1]); w.y = cvt_pk_bf16(__uint_as_float(u.y << 16) * t0[2], __uint_as_float(u.y & 0xffff0000u) * t0[3]);
            w.z = cvt_pk_bf16(__uint_as_float(u.z << 16) * t1[0], __uint_as_float(u.z & 0xffff0000u) * t1[1]); w.w = cvt_pk_bf16(__uint_as_float(u.w << 16) * t1[2], __uint_as_float(u.w & 0xffff0000u) * t1[3]);
            *(u32x4*)(usrc + store_off + (size_t)32 * ps * ZLD) = w; }
    }
    __syncthreads();
#undef S_LOAD
#undef S_WRITE
#undef ZADDR
#undef ZLD
}
#undef TRRD
}
constexpr int NWAVES = 8;
constexpr int RING_BYTES = 131072, LDSCTL_OFF = RING_BYTES, LDS_BYTES = 147456;
constexpr int NPH = 32;

struct Ctx { KArgs a; LAS unsigned char* lds; gu32* ctl; XcdBarrier bar; int tid, lane, wave, vcu, G, gw, NGW, lo, hi; unsigned long long tlast; };
#define PH_IN(k) (C.lo <= (k) && (k) < C.hi)
#define PH_SEAM(k) do { if (PROBE_PH) { if (C.wave == 0) { const unsigned long long n_ = __builtin_amdgcn_s_memrealtime(), d_ = n_ - C.tlast; if ((PROBE_PH >> (k)) & 1ull) { while (__builtin_amdgcn_s_memrealtime() - n_ < d_) __builtin_amdgcn_s_sleep(8); } } } \
    if (!MK_PER_PHASE && (k) + 1 < C.hi) xcd_barrier(C.bar); if (PROBE_PH) C.tlast = __builtin_amdgcn_s_memrealtime(); } while (0)
#define WSP(T, off) ((T*)(C.a.ws + (off)))

struct SchedF {
    const char* A; const char* B; int mode, G, c;
    __device__ __forceinline__ bool next(int i, pg8::Unit& u) const {
        const int L = i * G + c; u.pm = 0; u.pn = 0; u.nt = 0; u.kind = 0;
        if (mode == 0) { if (L >= 1024) return false; const int b = L >> 9, rem = L & 511, gr = rem & 15, tq = rem >> 4, g = gr >> 1, reim = gr & 1;
            u.a = A + (size_t)reim * 256 * 256 * 2; u.b = B + ((size_t)(b * SEQ + 4 * tq) * D + g * 256) * 2;
            u.o = ((((long)(b * 128 + 4 * tq) * 1024 + (g & 3) * 256) * 2 + (g >> 2)) * 2 + reim) * 64; return true; }
        if (mode == 1) { if (L >= 32) return false; const int b = L >> 4, gr = L & 15, g = gr >> 1, reim = gr & 1;
            u.a = A + (size_t)reim * 256 * 256 * 2; u.b = B + ((size_t)(ML + b * CTXL) * D + g * 256) * 2; u.o = (long)(b * D + g * 256) * 512 + reim * 256; return true; }
        if (mode == 2) { if (L >= 1024) return false; const int b = L >> 9, cp = L & 511;
            u.a = A; u.b = B + ((size_t)b * 33554432 + (size_t)cp * 512) * 2; u.o = (long)b * 33554432 + (long)cp * 1024; return true; }
        if (mode == 3) { if (L >= 512) return false; const int b = L >> 8, k1 = (L >> 2) & 63, cb = L & 3;
            u.a = A; u.b = B + ((size_t)(b * 64 + k1) * 1024 + cb * 256) * 512 * 2; u.o = (long)(b * SEQ + k1) * D + cb * 256; return true; }
        if (L >= 16) return false; { const int b = L >> 3, pn = L & 7;
            u.a = A; u.b = B + (size_t)(b * D + pn * 256) * 512 * 2; u.o = (long)(ML + b * CTXL) * D + pn * 256; return true; }
    }
};

__device__ __forceinline__ void ctx_splitk(Ctx& C, const bf16* A, int lda, const bf16* B, int ldb, int Ks, int ns, int nN, int pn0, int N, size_t aks = 0, size_t bks = 0, int gsub = 0) {
    const int cr = C.G - 1 - (int)blockIdx.x; const int Gs = gsub ? gsub : C.G; const int cs = (cr < Gs) ? cr : (1 << 28);
    const pg8::SchedSK S{(const char*)A, (const char*)B, lda, ldb, ns, nN, pn0, N, Gs, cs, aks ? aks : (size_t)Ks * 2, bks ? bks : (size_t)Ks * 2};
    const pg8::EpiSlab E{WSP(slab_t, WS_SLAB), N};
    pg8::gemm_phase<pg8::EpiSlab, pg8::SchedSK>(C.lds, pg8::mk_gemm(lda, ldb, Ks), S, E);
}
#define MXL(l) (WSP(const float, WS_MX) + (size_t)(l) * 3 * NADA)
#define BAL(l) (C.a.in[I_BADA] + (size_t)(l) * NADA)
#define SSQX(site) (WSP(float, WS_Z2 + Z2_SSQX) + (size_t)(site) * MT)
#define NORMG(l, w) (C.a.in[I_NORMG] + (size_t)((l) * 2 + (w)) * D)

template <bool NEXT, bool KCH, class TIN = xr_t, class TOUT = xr_t> __device__ __forceinline__ void residual_gemm(Ctx& C, const bf16* A, int lda, const bf16* Bt, int ldb, int K, pg8::Gemm g, int l, int gchunk, TOUT* rout, int nl, int nw, int site,
                                                                              bool ctx, int ns, int Ks, size_t aks, size_t bks, int pm0 = 0, int npan = 64, const TIN* rin = nullptr) {
    const TIN* XR = rin ? rin : (const TIN*)WSP(const xr_t, WS_XR);
    pg8::SchedRC S = pg8::make_rc(A, lda, Bt, ldb, npan, 8, D, 256, C.G, (int)blockIdx.x); S.pm0 = pm0;
    const pg8::EpiRes<NEXT, TIN, TOUT> E{XR, rout, MXL(l) + gchunk * D, BAL(l) + gchunk * D, WSP(bf16, WS_H), NORMG(nl, nw), MXL(nl) + (nw * 3 + 1) * D, BAL(nl) + (nw * 3 + 1) * D, SSQX(site)};
    if (ctx && !KCH) {
        const int cr = C.G - 1 - (int)blockIdx.x;
        const pg8::SchedSK SK{(const char*)A, (const char*)Bt, lda, ldb, ns, 8, 0, D, C.G, cr, aks ? aks : (size_t)Ks * 2, bks ? bks : (size_t)Ks * 2};
        const pg8::SchedMix<pg8::SchedRC, pg8::SchedSK> SM{S, SK, Ks / 64, cr < ns * 2 * 8};
        const pg8::Epi2<pg8::EpiRes<NEXT, TIN, TOUT>, pg8::EpiSlab> E2{E, pg8::EpiSlab{WSP(slab_t, WS_SLAB), D}};
        pg8::gemm_phase<pg8::Epi2<pg8::EpiRes<NEXT, TIN, TOUT>, pg8::EpiSlab>, pg8::SchedMix<pg8::SchedRC, pg8::SchedSK>, false>(C.lds, g, SM, E2);
    } else {
        if (ctx) ctx_splitk(C, A, lda, Bt, ldb, Ks, ns, 8, 0, D, aks, bks, STAGGER_G);
        pg8::gemm_phase<pg8::EpiRes<NEXT, TIN, TOUT>, pg8::SchedRC, KCH>(C.lds, g, S, E);
    }
}
__device__ __forceinline__ void ctxfin(Ctx& C, int ns, int l, int gchunk, int nl, int nw, int site) {
    ctxfin_phase(WSP(const slab_t, WS_SLAB), ns, MXL(l) + gchunk * D, BAL(l) + gchunk * D, WSP(xr_t, WS_XR), WSP(bf16, WS_H), NORMG(nl, nw), MXL(nl) + (nw * 3 + 1) * D, BAL(nl) + (nw * 3 + 1) * D, SSQX(site), C.gw, C.NGW, C.lane);
}
__device__ __forceinline__ void gateup_gemm(Ctx& C, int l, int nM, int site) {
    constexpr size_t GCS = (size_t)MT * 512;
    const pg8::EpiSwiGLU<true> E{WSP(bf16, WS_AR + AR_G), KCHUNK ? 512 : LDG_PAD, SSQX(site), WSP(const float, WS_Z2 + Z2_SWGU) + (size_t)l * 3 * 2 * DFF};
    { pg8::SchedRC S = pg8::make_rc(WSP(const bf16, WS_H), D, WSP(const bf16, WS_WGU + (size_t)l * 44 * MiB), D, 64, 44, KCHUNK ? 512 : LDG_PAD, 128, C.G, (int)blockIdx.x); S.pnflip = 1; if (KCHUNK) { S.ocl2 = 2; S.ocs = (long)GCS; }
      pg8::gemm_phase<pg8::EpiSwiGLU<true>, pg8::SchedRC>(C.lds, pg8::mk_gemm(D, D, D), S, E); }
    if (nM == 66) { const pg8::SchedHalf S{(const char*)WSP(const bf16, WS_H), (const char*)WSP(const bf16, WS_WGU + (size_t)l * 44 * MiB), (size_t)256 * D * 2, (long)LDG_PAD, D, 128, 44, 4, ML, C.G, C.G - 1 - (int)blockIdx.x};
      pg8::gemm_phase<pg8::EpiSwiGLU<true>, pg8::SchedHalf>(C.lds, pg8::mk_gemm(D, D, D), S, E); }
}
template <bool NEXT, bool LAST = false> __device__ __forceinline__ void down_gemm(Ctx& C, int l, bool ctx, int nl, int site, int pm0 = 0, int npan = 64) {
    constexpr size_t GCS = (size_t)MT * 512; constexpr int LDG = KCHUNK ? 512 : LDG_PAD;
    pg8::Gemm gd = pg8::mk_gemm(LDG, LDG, DFF); if (KCHUNK) { gd.kcl2 = 3; gd.acs = GCS * 2; gd.bcs = (size_t)D * 512 * 2; }
    if constexpr (LAST) residual_gemm<NEXT, KCHUNK != 0, xr_t, float>(C, WSP(const bf16, WS_AR + AR_G), LDG, WSP(const bf16, WS_WDN + (size_t)l * WDN_SLOT), LDG, DFF, gd, l, 5, C.a.out, nl, 0, site,
                                     ctx, 11, 512, KCHUNK ? GCS * 2 : 0, KCHUNK ? (size_t)D * 512 * 2 : 0, pm0, npan);
    else residual_gemm<NEXT, KCHUNK != 0>(C, WSP(const bf16, WS_AR + AR_G), LDG, WSP(const bf16, WS_WDN + (size_t)l * WDN_SLOT), LDG, DFF, gd, l, 5, WSP(xr_t, WS_XR), nl, 0, site,
                                     ctx, 11, 512, KCHUNK ? GCS * 2 : 0, KCHUNK ? (size_t)D * 512 * 2 : 0, pm0, npan);
}

__global__ void __launch_bounds__(NWAVES * 64, 2) mega(KArgs args) {
    extern __shared__ __attribute__((aligned(16))) unsigned char lds_raw[];
    Ctx C; C.a = args; C.lds = (LAS unsigned char*)lds_raw; C.ctl = (gu32*)(args.ws + WS_CTL);
    C.tid = threadIdx.x; C.lane = C.tid & 63; C.wave = __builtin_amdgcn_readfirstlane(C.tid >> 6);
    C.G = gridDim.x; { const int bx = blockIdx.x; C.vcu = (C.G % 8 == 0) ? (bx % 8) * (C.G / 8) + bx / 8 : bx; }
    C.gw = C.vcu * NWAVES + C.wave; C.NGW = C.G * NWAVES; C.lo = args.ph_lo; C.hi = args.ph_hi;
    volatile LAS unsigned* MISC = (volatile LAS unsigned*)(C.lds + LDSCTL_OFF);
    for (int u = C.tid; u < (LDS_BYTES - LDSCTL_OFF) / 4; u += NWAVES * 64) ((LAS unsigned*)(C.lds + LDSCTL_OFF))[u] = 0u;
    __syncthreads();
    C.bar.bar = (unsigned*)(C.ctl + CW_BAR); C.bar.x = 0; C.bar.st = nullptr;
    if (!MK_PER_PHASE) C.bar = xcd_barrier_post((unsigned*)(C.ctl + CW_BAR), MISC + 8);
    C.tlast = PROBE_PH ? __builtin_amdgcn_s_memrealtime() : 0ull;

    xr_t* XR = WSP(xr_t, WS_XR); bf16* H = WSP(bf16, WS_H);
    bf16* QKV = WSP(bf16, WS_AR + AR_QKV); bf16* AO = WSP(bf16, WS_AR + AR_AO);
    if (PH_IN(0)) { prologue_phase<0>(C.a, C.lds, C.ctl, C.tid, C.lane, C.wave); PH_SEAM(0); }
    if (PH_IN(1)) { prologue_phase<1>(C.a, C.lds, C.ctl, C.tid, C.lane, C.wave);
        if (!MK_PER_PHASE || true) { asm volatile("s_waitcnt vmcnt(0) lgkmcnt(0)" ::: "memory"); __syncthreads(); modnorm_phase(C.a.in[I_X], C.a.in[I_CTX], XR, H, NORMG(0, 0), MXL(0), BAL(0), 0, MT, C.gw, C.NGW, C.lane); }
        PH_SEAM(1); }

    if (PH_IN(3)) { const bf16* Wq = WSP(const bf16, WS_WQKV);
        { const pg8::SchedRC S = pg8::make_rc(H, D, Wq, D, 64, 12, NQKV, 256, C.G, (int)blockIdx.x);
          const pg8::EpiBf16<0, false, false> E{QKV, NQKV, nullptr, 0, nullptr, nullptr, 0};
          const int cr = C.G - 1 - (int)blockIdx.x;
          const pg8::SchedSK SK{(const char*)H, (const char*)Wq, D, D, 8, 12, 0, NQKV, C.G, cr, (size_t)256 * 2, (size_t)256 * 2};
          const pg8::SchedMix<pg8::SchedRC, pg8::SchedSK> SM{S, SK, 4, cr < 8 * 2 * 12};
          const pg8::Epi2<pg8::EpiBf16<0, false, false>, pg8::EpiSlab> E2{E, pg8::EpiSlab{WSP(slab_t, WS_SLAB), NQKV}};
          pg8::gemm_phase<pg8::Epi2<pg8::EpiBf16<0, false, false>, pg8::EpiSlab>, pg8::SchedMix<pg8::SchedRC, pg8::SchedSK>>(C.lds, pg8::mk_gemm(D, D, D), SM, E2); }
        PH_SEAM(3); }
    if (PH_IN(4)) { qknorm_rope_phase(QKV, C.a.in[I_QG], C.a.in[I_KG], WSP(const f32x2, WS_ROPE), MT, C.gw, C.NGW, C.lane, WSP(const slab_t, WS_SLAB), 8, 0); PH_SEAM(4); }
    if (PH_IN(5)) { attn::attn_phase(QKV, AO, C.a.in[I_SINK], true, C.vcu, C.G, (char*)C.lds); PH_SEAM(5); }
    if (PH_IN(6)) { residual_gemm<true, false, float, xr_t>(C, AO, D, WSP(const bf16, WS_WO), D, D, pg8::mk_gemm(D, D, D), 0, 2, XR, 0, 1, 0, true, 8, 256, 0, 0, 0, 64, C.a.in[I_X]); PH_SEAM(6); }
    if (PH_IN(7)) { ctxfin(C, 8, 0, 2, 0, 1, 0); PH_SEAM(7); }
    if (PH_IN(8)) { gateup_gemm(C, 0, 66, 0); PH_SEAM(8); }
    if (PH_IN(9)) { down_gemm<false>(C, 0, true, 0, 0); PH_SEAM(9); }

    {
        bf16* XA = WSP(bf16, WS_AR + AR_XA); bf16* XB = WSP(bf16, WS_AR + AR_XB); bf16* XTC = WSP(bf16, WS_AR + AR_XTC); bf16* Y = WSP(bf16, WS_AR + AR_Y);
        if (PH_IN(10)) { modnorm_phase(XR, XR + (size_t)ML * D, nullptr, H, NORMG(1, 0), MXL(1), BAL(1), 0, MT, C.gw, C.NGW, C.lane, WSP(const slab_t, WS_SLAB), 11, MXL(0) + 5 * D, BAL(0) + 5 * D, XR); PH_SEAM(10); }
        if (PH_IN(11)) {
            { const SchedF S{(const char*)WSP(bf16, WS_DC2), (const char*)H, 0, C.G, (int)blockIdx.x}; const pg8::EpiF1 E{XA};
              pg8::Gemm g = pg8::mk_gemm(256, 128 * D, 256); g.bs_log2 = 6; g.ldb_hi = D; g.hsB = 2 * D;
              pg8::gemm_phase<pg8::EpiF1, SchedF>(C.lds, g, S, E); }
            { const SchedF S{(const char*)WSP(bf16, WS_DC2), (const char*)H, 1, C.G, C.G - 1 - (int)blockIdx.x}; const pg8::EpiBf16<0, false, false> E{XTC, 512, nullptr, 0, nullptr, nullptr, 0};
              pg8::gemm_phase<pg8::EpiBf16<0, false, false>, SchedF>(C.lds, pg8::mk_gemm(256, D, 256), S, E); }
            PH_SEAM(11); }
        if (PH_IN(12)) {
            { const SchedF S{(const char*)WSP(bf16, WS_DA), (const char*)XA, 2, C.G, (int)blockIdx.x}; const pg8::EpiFA E{XB};
              pg8::Gemm g = pg8::mk_gemm(256, 262144, 256); g.hsB = 256;
              pg8::gemm_phase<pg8::EpiFA, SchedF>(C.lds, g, S, E); }
            { const SchedF S{(const char*)WSP(bf16, WS_FC), (const char*)XTC, 4, C.G, C.G - 1 - (int)blockIdx.x}; const pg8::EpiBf16<0, false, false> E{Y, D, nullptr, 0, nullptr, nullptr, 0};
              pg8::gemm_phase<pg8::EpiBf16<0, false, false>, SchedF>(C.lds, pg8::mk_gemm(512, 512, 512), S, E); }
            PH_SEAM(12); }
        if (PH_IN(13)) {
            const SchedF S{(const char*)WSP(bf16, WS_DB), (const char*)XB, 3, C.G, (int)blockIdx.x}; const pg8::EpiFB E{Y};
            pg8::gemm_phase<pg8::EpiFB, SchedF>(C.lds, pg8::mk_gemm(512, 512, 512), S, E);
            PH_SEAM(13); }
        if (PH_IN(14)) { residual_gemm<true, false>(C, Y, D, WSP(const bf16, WS_WF), D, D, pg8::mk_gemm(D, D, D), 1, 2, XR, 1, 1, 1, true, 8, 256, 0, 0); PH_SEAM(14); }
    }
    if (PH_IN(15)) { ctxfin(C, 8, 1, 2, 1, 1, 1); PH_SEAM(15); }
    if (PH_IN(16)) { gateup_gemm(C, 1, 66, 1); PH_SEAM(16); }
    if (PH_IN(17)) { down_gemm<true>(C, 1, true, 2, 2); PH_SEAM(17); }
    if (PH_IN(18)) { ctxfin(C, 11, 1, 5, 2, 0, 2); PH_SEAM(18); }

    {
        bf16* Z = WSP(bf16, WS_AR + AR_Z); float* SSQ = (float*)(C.a.ws + WS_CTL) + CW_SSQ;
        constexpr size_t ZCS = (size_t)MT * 512; constexpr int LDZ = KCHUNK ? 512 : 2 * SGH;
        if (PH_IN(19)) { const pg8::EpiBf16<1, true, true> E{Z, LDZ, SSQ, 24, SSQX(2), WSP(const float, WS_Z2 + Z2_SWSI), 2 * SGH};
            { pg8::SchedRC S = pg8::make_rc(H, D, WSP(const bf16, WS_WSI), D, 64, 48, LDZ, 256, C.G, (int)blockIdx.x); if (KCHUNK) { S.ocl2 = 1; S.ocs = (long)ZCS; }
              pg8::gemm_phase<pg8::EpiBf16<1, true, true>, pg8::SchedRC>(C.lds, pg8::mk_gemm(D, D, D), S, E); }
            { const pg8::SchedHalf S{(const char*)H, (const char*)WSP(const bf16, WS_WSI), (size_t)256 * D * 2, (long)LDZ, D, 256, 48, 4, ML, C.G, C.G - 1 - (int)blockIdx.x};
              pg8::gemm_phase<pg8::EpiBf16<1, true, true>, pg8::SchedHalf>(C.lds, pg8::mk_gemm(D, D, D), S, E); }
            PH_SEAM(19); }
        if (PH_IN(20)) { for (int uid = C.vcu; uid < (MT / 128) * 24; uid += C.G) { const int cg = uid / 3; attn::sgu_unit(Z, SSQ, C.a.in[I_WSS], C.a.in[I_BSS], C.a.in[I_SVG], cg >> 3, cg & 7, 2 * (uid - 3 * cg), (char*)C.lds); } PH_SEAM(20); }
        if (PH_IN(21)) { pg8::Gemm go = pg8::mk_gemm(LDZ, KCHUNK ? 512 : SGH, SGH); if (KCHUNK) { go.kcl2 = 3; go.acs = ZCS * 2; go.bcs = (size_t)D * 512 * 2; }
            residual_gemm<true, KCHUNK != 0>(C, Z, LDZ, WSP(const bf16, WS_WSO), KCHUNK ? 512 : SGH, SGH, go, 2, 2, XR, 2, 1, 3, true, 12, 512, KCHUNK ? ZCS * 2 : 0, KCHUNK ? (size_t)D * 512 * 2 : 0); PH_SEAM(21); }
    }
    if (PH_IN(22)) { ctxfin(C, 12, 2, 2, 2, 1, 3); PH_SEAM(22); }
    if (PH_IN(23)) { gateup_gemm(C, 2, 66, 3); PH_SEAM(23); }
    if (PH_IN(24)) { down_gemm<true>(C, 2, true, 3, 4); PH_SEAM(24); }
    if (PH_IN(25)) { ctxfin(C, 11, 2, 5, 3, 0, 4); PH_SEAM(25); }

    if (PH_IN(26)) { const bf16* Wq = WSP(const bf16, WS_WQKV + (size_t)12 * MiB);
        { const pg8::SchedRC S = pg8::make_rc(H, D, Wq, D, 64, 12, NQKV, 256, C.G, (int)blockIdx.x);
          const pg8::EpiBf16<0, false, true> E{QKV, NQKV, nullptr, 0, SSQX(4), WSP(const float, WS_Z2 + Z2_SWQ3), NQKV};
          const int cr = C.G - 1 - (int)blockIdx.x;
          const pg8::SchedSK SK{(const char*)H, (const char*)Wq, D, D, 8, 4, 8, NQKV, C.G, cr, (size_t)256 * 2, (size_t)256 * 2};
          const pg8::SchedMix<pg8::SchedRC, pg8::SchedSK> SM{S, SK, 4, cr < 8 * 2 * 4};
          const pg8::Epi2<pg8::EpiBf16<0, false, true>, pg8::EpiSlab> E2{E, pg8::EpiSlab{WSP(slab_t, WS_SLAB), NQKV}};
          pg8::gemm_phase<pg8::Epi2<pg8::EpiBf16<0, false, true>, pg8::EpiSlab>, pg8::SchedMix<pg8::SchedRC, pg8::SchedSK>>(C.lds, pg8::mk_gemm(D, D, D), SM, E2); }
        PH_SEAM(26); }
    if (PH_IN(27)) { qknorm_rope_phase(QKV, C.a.in[I_QG] + HD, C.a.in[I_KG] + HD, WSP(const f32x2, WS_ROPE), MT, C.gw, C.NGW, C.lane, WSP(const slab_t, WS_SLAB), 8, 4, SSQX(4), WSP(const float, WS_Z2 + Z2_SWQ3) + 2 * NQKV); PH_SEAM(27); }
    if (PH_IN(28)) { attn::attn_phase(QKV, AO, C.a.in[I_SINK] + NH, false, C.vcu, C.G, (char*)C.lds); PH_SEAM(28); }
    if (PH_IN(29)) { residual_gemm<true, false>(C, AO, D, WSP(const bf16, WS_WO + (size_t)8 * MiB), D, D, pg8::mk_gemm(D, D, D), 3, 2, XR, 3, 1, 5, false, 0, 0, 0, 0); PH_SEAM(29); }
    if (PH_IN(30)) { gateup_gemm(C, 3, 64, 5); PH_SEAM(30); }
    if (PH_IN(31)) { down_gemm<false, true>(C, 3, false, 0, 0); PH_SEAM(31); }
}

extern "C" void kernel_launch(void* const* d_in, const int* in_sizes, int n_in, void* d_out, int out_size, void* d_ws, size_t ws_size, hipStream_t stream) {
    static int grid = 0;
    if (grid == 0) {
        if (n_in != 21 || in_sizes[0] != ML * D || out_size != ML * D || ws_size < WS_END) { fprintf(stderr, "kernel_launch: unexpected shapes (n_in %d, in0 %d, out %d, ws %zu < %zu)\n", n_in, n_in > 0 ? in_sizes[0] : -1, out_size, ws_size, (size_t)WS_END); grid = -1; return; }
        int dev = 0, cus = 0, per_cu = 0;
        if (hipGetDevice(&dev) != hipSuccess || hipDeviceGetAttribute(&cus, hipDeviceAttributeMultiprocessorCount, dev) != hipSuccess) { grid = -1; return; }
        if (hipFuncSetAttribute((const void*)mega, hipFuncAttributeMaxDynamicSharedMemorySize, LDS_BYTES) != hipSuccess) { fprintf(stderr, "kernel_launch: hipFuncSetAttribute failed\n"); grid = -1; return; }
        if (hipOccupancyMaxActiveBlocksPerMultiprocessor(&per_cu, (const void*)mega, NWAVES * 64, LDS_BYTES) != hipSuccess || per_cu < 1) fprintf(stderr, "kernel_launch: occupancy query says %d\n", per_cu);
        (void)hipGetLastError();
        grid = cus;
    }
    if (grid < 0) return;
    if (hipMemsetAsync((char*)d_ws + WS_CTL, 0, CTL_ZERO_BYTES, stream) != hipSuccess) return;
    KArgs a{};
    for (int i = 0; i < 21; ++i) a.in[i] = (const float*)d_in[i];
    a.out = (float*)d_out; a.ws = (unsigned char*)d_ws;
#if MK_PER_PHASE
    for (int ph = 0; ph < NPH; ++ph) { a.ph_lo = ph; a.ph_hi = ph + 1; hipLaunchKernelGGL(mega, dim3(grid), dim3(NWAVES * 64), LDS_BYTES, stream, a); }
#else
    a.ph_lo = 0; a.ph_hi = NPH; hipLaunchKernelGGL(mega, dim3(grid), dim3(NWAVES * 64), LDS_BYTES, stream, a);
#endif
}
```
